# Optimizing an MI355X kernel written in HIP

```python
import jax, jax.numpy as jnp
from jax import lax
import numpy as np

D_MODEL = 1024
BATCH = 32
SEQ = 2048
DEPTH = 1

GRID_W = 64
CTX_LEN = 256
NA_HEADS = 8
NA_HEAD_DIM = 64
NA_WIDTH = NA_HEADS * NA_HEAD_DIM
WIN_H = 8
WIN_W = 16
NA_KEY_COLS = 2 * WIN_W
ML_HEADS = 4
ML_QK_DIM = 64
ML_V_DIM = 128
ML_QK_WIDTH = ML_HEADS * ML_QK_DIM
ML_WIDTH = ML_HEADS * ML_V_DIM
ML_CHUNK = 64
GATE_SOFTCAP = 15.0
ROPE_BASE = 10000.0
N_EXPERTS = 32
TOP_K = 4
D_EXPERT = D_MODEL
SWIGLU_ALPHA = 1.702
SWIGLU_LIMIT = 7.0
EXPERT_BLOCK = 128
NORM_EPS = 1e-6
NEG_INF = -1e30
CTX_SPLITS = (NA_WIDTH, NA_WIDTH, ML_QK_WIDTH, ML_WIDTH, 4 * ML_HEADS)
LAT_SPLITS = (NA_WIDTH, ML_QK_WIDTH, ML_WIDTH, D_MODEL, D_MODEL)
IN_SPLITS = CTX_SPLITS + LAT_SPLITS
N_CTX_COLS = 2 * NA_WIDTH + ML_QK_WIDTH + ML_WIDTH + 4 * ML_HEADS
N_IN_COLS = N_CTX_COLS + NA_WIDTH + ML_QK_WIDTH + ML_WIDTH + 2 * D_MODEL

kernel_name = 'hybrid_natten_mlstm_moe_dit_layer'


def _rmsnorm(x, g):
    xf = x.astype(jnp.float32)
    y = xf * lax.rsqrt(jnp.mean(xf * xf, axis=-1, keepdims=True) + NORM_EPS)
    return (y * g.astype(jnp.float32)).astype(x.dtype)


def _split(a, sizes):
    return jnp.split(a, np.cumsum(sizes)[:-1].tolist(), axis=-1)


def _na_column_tables():
    n_qb = GRID_W // WIN_W
    qcol = np.arange(GRID_W).reshape(n_qb, WIN_W)
    kstart = np.clip(np.arange(n_qb) * WIN_W - WIN_W // 2, 0, GRID_W - NA_KEY_COLS)
    kcol = kstart[:, None] + np.arange(NA_KEY_COLS)
    cs = np.clip(qcol - WIN_W // 2, 0, GRID_W - WIN_W)
    kc = kcol[:, None, :]
    mask = (kc >= cs[:, :, None]) & (kc < cs[:, :, None] + WIN_W)
    dc = np.clip(kc - qcol[:, :, None], -(WIN_W - 1), WIN_W - 1) + (WIN_W - 1)
    return kcol, mask, dc


def _neighbourhood_attention(q, k, v, k_ctx, v_ctx, rpb):
    B, S, _ = q.shape
    rows = S // GRID_W
    wr = min(WIN_H, rows)
    n_qb = GRID_W // WIN_W
    kcol, mask, dc = _na_column_tables()
    grid = (B, rows, GRID_W, NA_HEADS, NA_HEAD_DIM)
    q = q.reshape(grid) * NA_HEAD_DIM ** -0.5
    k = k.reshape(grid)
    v = v.reshape(grid)
    k_ctx = k_ctx.reshape(B, -1, NA_HEADS, NA_HEAD_DIM)
    v_ctx = v_ctx.reshape(B, -1, NA_HEADS, NA_HEAD_DIM)
    n_loc = wr * NA_KEY_COLS

    def one_row(r):
        rs = jnp.clip(r - WIN_H // 2, 0, rows - wr)
        qb = lax.dynamic_index_in_dim(q, r, axis=1, keepdims=False).reshape(B, n_qb, WIN_W, NA_HEADS, NA_HEAD_DIM)
        kb = lax.dynamic_slice_in_dim(k, rs, wr, axis=1)[:, :, kcol]
        vb = lax.dynamic_slice_in_dim(v, rs, wr, axis=1)[:, :, kcol]
        dr = rs + jnp.arange(wr) - r + (WIN_H - 1)
        bias = rpb[:, dr[None, None, :, None], dc[:, :, None, :]].astype(jnp.float32)
        s_loc = jnp.einsum('bjqhd,brjkhd->bhjqrk', qb, kb).astype(jnp.float32) + bias
        s_loc = jnp.where(mask[:, :, None, :], s_loc, NEG_INF).reshape(B, NA_HEADS, n_qb, WIN_W, n_loc)
        s_ctx = jnp.einsum('bjqhd,bchd->bhjqc', qb, k_ctx).astype(jnp.float32)
        p = jax.nn.softmax(jnp.concatenate([s_loc, s_ctx], axis=-1), axis=-1).astype(v.dtype)
        p_loc = p[..., :n_loc].reshape(B, NA_HEADS, n_qb, WIN_W, wr, NA_KEY_COLS)
        o = (jnp.einsum('bhjqrk,brjkhd->bjqhd', p_loc, vb)
             + jnp.einsum('bhjqc,bchd->bjqhd', p[..., n_loc:], v_ctx))
        return o.reshape(B, GRID_W, NA_WIDTH)

    o = lax.map(one_row, jnp.arange(rows, dtype=jnp.int32))
    return jnp.moveaxis(o, 0, 1).reshape(B, S, NA_WIDTH)


def _axial_rope(x, row, col):
    n_freq = ML_QK_DIM // 4
    inv_freq = ROPE_BASE ** (-jnp.arange(n_freq, dtype=jnp.float32) / n_freq)

    def rotate(xh, pos):
        ang = pos[:, None] * inv_freq
        cos = jnp.cos(ang)[:, None, :]
        sin = jnp.sin(ang)[:, None, :]
        x1, x2 = xh[..., :n_freq], xh[..., n_freq:]
        return jnp.concatenate([x1 * cos - x2 * sin, x2 * cos + x1 * sin], axis=-1)

    half = ML_QK_DIM // 2
    return jnp.concatenate([rotate(x[..., :half], row), rotate(x[..., half:], col)], axis=-1)


def _to_chunks(a):
    B, H, T = a.shape[:3]
    a = a.reshape((B, H, T // ML_CHUNK, ML_CHUNK) + a.shape[3:])
    return jnp.moveaxis(a, 2, 0)


def _mlstm_chunkwise(q, k, v, log_i, log_f, state):
    tril = np.tril(np.ones((ML_CHUNK, ML_CHUNK), dtype=bool))
    with_out = q is not None

    def step(carry, inp):
        C, n, m = carry
        if with_out:
            qc, kc, vc, li, lf = inp
        else:
            kc, vc, li, lf = inp
        b = jnp.cumsum(lf, axis=-1)
        bL = b[..., -1]
        dec = bL[..., None] - b + li
        m_new = jnp.maximum(bL + m, jnp.max(dec, axis=-1))
        w_s = jnp.exp(dec - m_new[..., None])
        w_c = jnp.exp(bL + m - m_new)
        C_new = w_c[..., None, None] * C + jnp.einsum('bhs,bhsd,bhse->bhde', w_s, kc, vc)
        n_new = w_c[..., None] * n + jnp.einsum('bhs,bhsd->bhd', w_s, kc)
        if not with_out:
            return (C_new, n_new, m_new), None
        d_mat = jnp.where(tril, b[..., :, None] - b[..., None, :] + li[..., None, :], -jnp.inf)
        m_inter = b + m[..., None]
        m_t = jnp.maximum(m_inter, jnp.max(d_mat, axis=-1))
        w_intra = jnp.exp(d_mat - m_t[..., None])
        w_inter = jnp.exp(m_inter - m_t)
        s = jnp.einsum('bhtd,bhsd->bhts', qc, kc) * w_intra
        num = (w_inter[..., None] * jnp.einsum('bhtd,bhde->bhte', qc, C)
               + jnp.einsum('bhts,bhse->bhte', s, vc))
        den = w_inter * jnp.einsum('bhtd,bhd->bht', qc, n) + jnp.sum(s, axis=-1)
        h = num / jnp.maximum(jnp.abs(den), jnp.exp(-m_t))[..., None]
        return (C_new, n_new, m_new), h

    if with_out:
        xs = (_to_chunks(q), _to_chunks(k), _to_chunks(v), _to_chunks(log_i), _to_chunks(log_f))
    else:
        xs = (_to_chunks(k), _to_chunks(v), _to_chunks(log_i), _to_chunks(log_f))
    final, hs = lax.scan(step, state, xs)
    if not with_out:
        return final
    hs = jnp.moveaxis(hs, 0, 2)
    return hs.reshape(hs.shape[0], hs.shape[1], -1, hs.shape[-1])


def _mlstm_branch(q, k, v, o_pre, gates, k_ctx, v_ctx, gates_ctx, b_gates, g_head, row, col):
    B, S, _ = q.shape
    n_ctx = k_ctx.shape[1]
    f32 = jnp.float32
    qk_scale = ML_QK_DIM ** -0.5

    def heads_first(a):
        return jnp.swapaxes(a, 1, 2)

    def flip(a):
        return jnp.flip(a, axis=2)

    q = heads_first(_axial_rope(q.reshape(B, S, ML_HEADS, ML_QK_DIM).astype(f32), row, col))
    k = heads_first(_axial_rope(k.reshape(B, S, ML_HEADS, ML_QK_DIM).astype(f32), row, col) * qk_scale)
    v = heads_first(v.reshape(B, S, ML_HEADS, ML_V_DIM).astype(f32))
    k_ctx = heads_first(k_ctx.reshape(B, n_ctx, ML_HEADS, ML_QK_DIM).astype(f32) * qk_scale)
    v_ctx = heads_first(v_ctx.reshape(B, n_ctx, ML_HEADS, ML_V_DIM).astype(f32))

    def gate_logs(g):
        t = g.shape[1]
        g = g.reshape(B, t, 4, ML_HEADS).astype(f32) + b_gates.astype(f32)
        g = GATE_SOFTCAP * jnp.tanh(g / GATE_SOFTCAP)
        g = jnp.transpose(g, (2, 0, 3, 1))
        return g[0], jax.nn.log_sigmoid(g[1]), g[2], jax.nn.log_sigmoid(g[3])

    li_f, lf_f, li_b, lf_b = gate_logs(gates)
    lic_f, lfc_f, lic_b, lfc_b = gate_logs(gates_ctx)
    state0 = (jnp.zeros((B, ML_HEADS, ML_QK_DIM, ML_V_DIM), f32),
              jnp.zeros((B, ML_HEADS, ML_QK_DIM), f32),
              jnp.zeros((B, ML_HEADS), f32))
    st_f = _mlstm_chunkwise(None, k_ctx, v_ctx, lic_f, lfc_f, state0)
    h_f = _mlstm_chunkwise(q, k, v, li_f, lf_f, st_f)
    st_b = _mlstm_chunkwise(None, flip(k_ctx), flip(v_ctx), flip(lic_b), flip(lfc_b), state0)
    h_b = flip(_mlstm_chunkwise(flip(q), flip(k), flip(v), flip(li_b), flip(lf_b), st_b))
    h = heads_first(h_f + h_b)
    h = h * lax.rsqrt(jnp.mean(h * h, axis=-1, keepdims=True) + NORM_EPS) * g_head.reshape(ML_HEADS, ML_V_DIM).astype(f32)
    return (jax.nn.sigmoid(o_pre.astype(f32)) * h.reshape(B, S, ML_WIDTH)).astype(o_pre.dtype)


def _clamped_swiglu(g, l):
    g = jnp.minimum(g, SWIGLU_LIMIT)
    l = jnp.clip(l, -SWIGLU_LIMIT, SWIGLU_LIMIT)
    return g * jax.nn.sigmoid(SWIGLU_ALPHA * g) * (l + 1.0)


def _moe_ffn(h, w_router, b_router, w_gate, b_gate, w_lin, b_lin, w_down, b_down):
    B, S, D = h.shape
    n_tok = B * S
    n_assign = n_tok * TOP_K
    xf = h.reshape(n_tok, D)
    logits = (xf @ w_router + b_router).astype(jnp.float32)
    top_logit, top_e = lax.top_k(logits, TOP_K)
    top_w = jax.nn.softmax(top_logit, axis=-1)
    e_flat = top_e.reshape(-1)
    order = jnp.argsort(e_flat)
    e_sorted = e_flat[order]
    counts = jnp.bincount(e_flat, length=N_EXPERTS)
    padded = (counts + EXPERT_BLOCK - 1) // EXPERT_BLOCK * EXPERT_BLOCK
    pad_end = jnp.cumsum(padded)
    pad_start = pad_end - padded
    start = jnp.cumsum(counts) - counts
    dest = pad_start[e_sorted] + jnp.arange(n_assign) - start[e_sorted]
    n_rows = -(-n_assign // EXPERT_BLOCK) * EXPERT_BLOCK + N_EXPERTS * EXPERT_BLOCK
    n_blocks = n_rows // EXPERT_BLOCK
    row_tok = jnp.full((n_rows,), n_tok, jnp.int32).at[dest].set((order // TOP_K).astype(jnp.int32))
    row_w = jnp.zeros((n_rows,), jnp.float32).at[dest].set(top_w.reshape(-1)[order])
    blk_start = jnp.arange(n_blocks) * EXPERT_BLOCK
    blk_e = jnp.minimum(jnp.sum(blk_start[:, None] >= pad_end[None, :], axis=1), N_EXPERTS - 1)
    x_pad = jnp.concatenate([xf, jnp.zeros((1, D), xf.dtype)], axis=0)

    def expert_block(args):
        idx, wts, e = args
        xb = x_pad[idx]
        a = _clamped_swiglu(xb @ w_gate[e] + b_gate[e], xb @ w_lin[e] + b_lin[e])
        y = a @ w_down[e] + b_down[e]
        return (y * wts[:, None]).astype(h.dtype)

    y = lax.map(expert_block, (row_tok.reshape(n_blocks, EXPERT_BLOCK),
                               row_w.reshape(n_blocks, EXPERT_BLOCK), blk_e))
    out = jnp.zeros((n_tok + 1, D), h.dtype).at[row_tok].add(y.reshape(n_rows, D))
    return out[:n_tok].reshape(B, S, D)


def setup_inputs(seed: int = 0) -> dict:
    key = jax.random.key(seed)
    ks = jax.random.split(key, 28)
    f32 = jnp.float32
    D, E, F = D_MODEL, N_EXPERTS, D_EXPERT

    def nrm(k, shape, scale):
        return scale * jax.random.normal(k, shape, f32)

    def gain(k, shape):
        return 1.0 + 0.02 * jax.random.normal(k, shape, f32)

    f_bias = 3.0 + 3.0 * jax.random.uniform(ks[11], (DEPTH, 2, ML_HEADS), f32)
    i_bias = nrm(ks[12], (DEPTH, 2, ML_HEADS), 0.1)
    b_mlstm_gates = jnp.stack([i_bias[:, 0], f_bias[:, 0], i_bias[:, 1], f_bias[:, 1]], axis=1)
    return {
        'x': jax.random.normal(ks[0], (BATCH, SEQ, D), f32),
        'c': jax.random.normal(ks[1], (BATCH, D), f32),
        'ctx': jax.random.normal(ks[2], (BATCH, CTX_LEN, D), f32),
        'c_ctx': jax.random.normal(ks[3], (D,), f32),
        'w_ada': nrm(ks[4], (DEPTH, D, 6 * D), 0.5 * D ** -0.5),
        'b_ada': nrm(ks[5], (DEPTH, 6 * D), 0.02),
        'g_mix_pre': gain(ks[6], (DEPTH, D)),
        'g_mix_post': gain(ks[7], (DEPTH, D)),
        'g_ffn_pre': gain(ks[8], (DEPTH, D)),
        'g_ffn_post': gain(ks[9], (DEPTH, D)),
        'w_in': nrm(ks[10], (DEPTH, D, N_IN_COLS), D ** -0.5),
        'b_mlstm_gates': b_mlstm_gates,
        'rpb': nrm(ks[13], (DEPTH, NA_HEADS, 2 * WIN_H - 1, 2 * WIN_W - 1), 0.1),
        'g_mlstm_head': gain(ks[14], (DEPTH, ML_WIDTH)),
        'w_branch_na': nrm(ks[15], (DEPTH, NA_WIDTH, D), NA_WIDTH ** -0.5),
        'w_branch_ml': nrm(ks[16], (DEPTH, ML_WIDTH, D), ML_WIDTH ** -0.5),
        'w_out': nrm(ks[17], (DEPTH, D, D), D ** -0.5),
        'w_router': nrm(ks[18], (DEPTH, D, E), D ** -0.5),
        'b_router': nrm(ks[19], (DEPTH, E), 0.01),
        'w_gate': nrm(ks[20], (DEPTH, E, D, F), D ** -0.5),
        'b_gate': nrm(ks[21], (DEPTH, E, F), 0.01),
        'w_lin': nrm(ks[22], (DEPTH, E, D, F), D ** -0.5),
        'b_lin': nrm(ks[23], (DEPTH, E, F), 0.01),
        'w_down': nrm(ks[24], (DEPTH, E, F, D), F ** -0.5),
        'b_down': nrm(ks[25], (DEPTH, E, D), 0.01),
    }


def reference(x, c, ctx, c_ctx, w_ada, b_ada, g_mix_pre, g_mix_post, g_ffn_pre, g_ffn_post,
              w_in, b_mlstm_gates, rpb, g_mlstm_head, w_branch_na, w_branch_ml, w_out,
              w_router, b_router, w_gate, b_gate, w_lin, b_lin, w_down, b_down):
    B, S, D = x.shape
    t = jnp.arange(S)
    row = (t // GRID_W).astype(jnp.float32)
    col = (t % GRID_W).astype(jnp.float32)
    silu_c = jax.nn.silu(c)
    silu_cc = jax.nn.silu(c_ctx)
    for layer in range(DEPTH):
        mod = silu_c @ w_ada[layer] + b_ada[layer]
        sh_m, sc_m, gt_m, sh_f, sc_f, gt_f = jnp.split(mod, 6, axis=-1)
        mod_c = silu_cc @ w_ada[layer][:, :2 * D] + b_ada[layer][:2 * D]
        sh_c, sc_c = jnp.split(mod_c, 2, axis=-1)

        h = _rmsnorm(x, g_mix_pre[layer]) * (1.0 + sc_m[:, None]) + sh_m[:, None]
        hc = _rmsnorm(ctx, g_mix_pre[layer]) * (1.0 + sc_c) + sh_c
        (na_k, na_v, ml_k, ml_v, ml_g, na_q, ml_q, ml_o, gate_na, gate_ml) = _split(h @ w_in[layer], IN_SPLITS)
        (na_kc, na_vc, ml_kc, ml_vc, ml_gc) = _split(hc @ w_in[layer][:, :N_CTX_COLS], CTX_SPLITS)
        o_na = _neighbourhood_attention(na_q, na_k, na_v, na_kc, na_vc, rpb[layer])
        o_ml = _mlstm_branch(ml_q, ml_k, ml_v, ml_o, ml_g, ml_kc, ml_vc, ml_gc,
                             b_mlstm_gates[layer], g_mlstm_head[layer], row, col)
        merged = (jax.nn.sigmoid(gate_na) * (o_na @ w_branch_na[layer])
                  + jax.nn.sigmoid(gate_ml) * (o_ml @ w_branch_ml[layer]))
        x = x + gt_m[:, None] * _rmsnorm(merged @ w_out[layer], g_mix_post[layer])

        h2 = _rmsnorm(x, g_ffn_pre[layer]) * (1.0 + sc_f[:, None]) + sh_f[:, None]
        ffn = _moe_ffn(h2, w_router[layer], b_router[layer], w_gate[layer], b_gate[layer],
                       w_lin[layer], b_lin[layer], w_down[layer], b_down[layer])
        x = x + gt_f[:, None] * _rmsnorm(ffn, g_ffn_post[layer])
    return x
```

```cpp
#include <hip/hip_runtime.h>
#include <cstdio>
#include <cstdint>

#ifndef MK_ONE_LAUNCH
#define MK_ONE_LAUNCH 1
#endif

#define LAS __attribute__((address_space(3)))
typedef unsigned short bf16_t;
typedef short bf16x8 __attribute__((ext_vector_type(8)));
typedef float f32x4 __attribute__((ext_vector_type(4)));
typedef float f32x2 __attribute__((ext_vector_type(2)));
typedef float f32x16 __attribute__((ext_vector_type(16)));
typedef unsigned u32x4 __attribute__((ext_vector_type(4)));
typedef unsigned u32x2 __attribute__((ext_vector_type(2)));
typedef int i32x4 __attribute__((ext_vector_type(4)));
typedef int i32x8 __attribute__((ext_vector_type(8)));
typedef long i64x2 __attribute__((ext_vector_type(2)));

constexpr int D = 1024, NB = 32, SEQ = 2048, NTOK = NB * SEQ, CTXL = 256, NCTX = NB * CTXL;
constexpr int NEXP = 32, TOPK = 4;
constexpr int LDP = 5120, LDPC = 1792;
constexpr int PC_NAK = 0, PC_MLK = 1024, PC_MLV = 1280, PC_NAQ = 1792, PC_MLQ = 2304, PC_MLO = 2560, PC_GNA = 3072, PC_GML = 4096;
constexpr int N_IN = 5376;
constexpr int W_IN_COLS = 5136;
constexpr float EPS = 1e-6f;
constexpr int NPHASE = 11;
constexpr float FP8_SHI = 16.f;
constexpr int N_IN16 = 2816, N_IN8 = 2560;
#ifndef INCFG
#define INCFG 3
#endif
#if INCFG == 0
constexpr int NT_IN16 = 11, NT_IN8 = 10;
__device__ __forceinline__ int in_map16(int i) { return i; }
__device__ __forceinline__ int in_map8(int i) { return i + 11; }
__device__ __forceinline__ bool in_is8(int t) { return t >= 11; }
#elif INCFG == 1
constexpr int NT_IN16 = 7, NT_IN8 = 14;
__device__ __forceinline__ int in_map16(int i) { return i + (i >= 2 ? 2 : 0) + (i >= 3 ? 2 : 0); }
__device__ __forceinline__ int in_map8(int i) { return i + 2 + (i >= 2 ? 1 : 0) + (i >= 4 ? 4 : 0); }
__device__ __forceinline__ bool in_is8(int t) { return t >= 11 || t == 2 || t == 3 || t == 5 || t == 6; }
#elif INCFG == 3
constexpr int NT_IN16 = 3, NT_IN8 = 18;
__device__ __forceinline__ int in_map16(int i) { return 4 + 3 * i; }
__device__ __forceinline__ int in_map8(int i) { return i + (i >= 4 ? 1 : 0) + (i >= 6 ? 1 : 0) + (i >= 8 ? 1 : 0); }
__device__ __forceinline__ bool in_is8(int t) { return t != 4 && t != 7 && t != 10; }
#else
constexpr int NT_IN16 = 1, NT_IN8 = 20;
__device__ __forceinline__ int in_map16(int i) { return 7; }
__device__ __forceinline__ int in_map8(int i) { return i + (i >= 7 ? 1 : 0); }
__device__ __forceinline__ bool in_is8(int t) { return t != 7; }
#endif
constexpr float FP8_SG = 256.f;
constexpr float FP8_SY = 32.f;
constexpr float FP8_SW = 64.f, FP8_SH = 8.f, FP8_SA = 8.f;
constexpr int LDS_BYTES = 147456;
constexpr int LDS_MISC = 131072;
constexpr int LDS_BARW = LDS_BYTES - 16;

constexpr size_t MiB = (size_t)1 << 20;
constexpr size_t WS_CTL = 0, CTL_ZERO_BYTES = 65536;
constexpr size_t WS_MODV = 1 * MiB;
constexpr size_t WS_BTIN = 2 * MiB;
constexpr size_t WS_BTBR = 13 * MiB;
constexpr size_t WS_BTOUT = 15 * MiB;
constexpr size_t WS_GATES = 17 * MiB;
constexpr size_t WS_ROPE = 21 * MiB + 512 * 1024;
constexpr size_t WS_COMB = 22 * MiB;
constexpr size_t WS_LTOK = 24 * MiB;
constexpr size_t WS_LW = 32 * MiB;
constexpr size_t WS_H = 40 * MiB;
constexpr size_t WS_ONA = 40 * MiB;
constexpr size_t WS_Y = 40 * MiB;
constexpr size_t WS_PLAT = 184 * MiB;
constexpr size_t WS_PCTX = 824 * MiB;
constexpr size_t WS_VTL = 852 * MiB;
constexpr size_t WS_VTC = 916 * MiB;
constexpr size_t WS_H8 = 924 * MiB;
constexpr size_t WS_BTIN8 = 996 * MiB;
constexpr size_t DO_WD0 = 240 * MiB;
constexpr size_t WS_WD1 = 1002 * MiB;
constexpr size_t DO_WD = 160 * MiB;
constexpr size_t WS_AHI = 232 * MiB;
constexpr size_t WS_YS = 504 * MiB;
constexpr size_t WS_H2 = 504 * MiB;
constexpr size_t WS_WGL = 924 * MiB;
constexpr size_t WS_END = 1020 * MiB;
constexpr size_t DO_MKT = 132 * MiB, DO_MKTC = 164 * MiB, DO_MVT = 168 * MiB, DO_MVTC = 232 * MiB;
constexpr int PA_HID = 1152;
constexpr int A_LO_ROWS = 131072;
constexpr int CW_GCNT = 4096;

__device__ __forceinline__ unsigned cvt_pk_bf16(float lo, float hi) { unsigned r; asm volatile("v_cvt_pk_bf16_f32 %0, %1, %2" : "=v"(r) : "v"(lo), "v"(hi)); return r; }
__device__ __forceinline__ bf16_t f2bf(float f) { return (bf16_t)(cvt_pk_bf16(f, 0.f) & 0xffffu); }
__device__ __forceinline__ float bf_lo(unsigned u) { return __uint_as_float(u << 16); }
__device__ __forceinline__ float bf_hi(unsigned u) { return __uint_as_float(u & 0xffff0000u); }
__device__ __forceinline__ float bf2f(bf16_t b) { return __uint_as_float(((unsigned)b) << 16); }
__device__ __forceinline__ unsigned pack_fp8x4(float a, float b, float c, float d) {
    a = __builtin_amdgcn_fmed3f(a, -448.f, 448.f); b = __builtin_amdgcn_fmed3f(b, -448.f, 448.f); c = __builtin_amdgcn_fmed3f(c, -448.f, 448.f); d = __builtin_amdgcn_fmed3f(d, -448.f, 448.f);
    unsigned p = 0u; p = __builtin_amdgcn_cvt_pk_fp8_f32(a, b, p, false); p = __builtin_amdgcn_cvt_pk_fp8_f32(c, d, p, true); return p;
}
template <int N> __device__ __forceinline__ float dpp_ror(float v) { return __builtin_bit_cast(float, __builtin_amdgcn_update_dpp(0, __builtin_bit_cast(int, v), 0x120 + N, 0xf, 0xf, false)); }
__device__ __forceinline__ float wave_sum(float v) {
    v += dpp_ror<8>(v); v += dpp_ror<4>(v); v += dpp_ror<2>(v); v += dpp_ror<1>(v);
    v += __shfl_xor(v, 16); v += __shfl_xor(v, 32);
    return v;
}
__device__ __forceinline__ float sigmoidf_(float x) { return __builtin_amdgcn_rcpf(1.f + __builtin_amdgcn_exp2f(x * -1.4426950408889634f)); }

#define XB_TMO      128
#define XB_XCNT(j)  (256  + 64 * (j))
#define XB_XSUB(j)  (1280 + 64 * (j))
#define XB_XGEN(j)  (2304 + 64 * (j))
#define XB_TOP      3328
#define XB_TOPGEN   3392
#define XCD_BAR_WORDS 3456
#define XB_SPIN_CAP (1u << 18)
__device__ __forceinline__ unsigned xb_ld(unsigned* p)              { return __hip_atomic_load(p, __ATOMIC_RELAXED, __HIP_MEMORY_SCOPE_AGENT); }
__device__ __forceinline__ unsigned xb_add(unsigned* p, unsigned v) { return __hip_atomic_fetch_add(p, v, __ATOMIC_RELAXED, __HIP_MEMORY_SCOPE_AGENT); }
__device__ __forceinline__ unsigned xb_xcc_id() { return (unsigned)__builtin_amdgcn_s_getreg((3 << 11) | 20) & 0xFu; }
#define XB_SPIN(cond, bar) do { unsigned _sp = 0; while (cond) { __builtin_amdgcn_s_sleep(1); \
    if ((++_sp & 255u) == 0u) { if (xb_ld(&(bar)[XB_TMO])) break; if (_sp > XB_SPIN_CAP) { atomicAdd(&(bar)[XB_TMO], 1u); break; } } } } while (0)
struct XcdBarrier { unsigned* bar; unsigned x; volatile LAS unsigned* st; };
__device__ __forceinline__ XcdBarrier xcd_barrier_post(unsigned* bar, volatile LAS unsigned* st) {
    XcdBarrier b; b.bar = bar; b.x = xb_xcc_id(); b.st = st;
    if (threadIdx.x == 0) (void)xb_add(&bar[XB_XCNT(b.x)], 1u);
    return b;
}
__device__ __forceinline__ void xcd_barrier_complete(unsigned* bar, unsigned x, unsigned& nloc, unsigned& nx) {
    const unsigned G = gridDim.x * gridDim.y * gridDim.z;
    unsigned sum, cnt, mine, sp = 0u;
    for (;;) {
        sum = 0u; cnt = 0u; mine = 0u;
#pragma unroll
        for (unsigned j = 0; j < 16; ++j) { const unsigned c = xb_ld(&bar[XB_XCNT(j)]); sum += c; cnt += (c > 0u) ? 1u : 0u; mine = (j == x) ? c : mine; }
        if (sum == G) break;
        __builtin_amdgcn_s_sleep(1);
        if ((++sp & 255u) == 0u) { if (xb_ld(&bar[XB_TMO])) break; if (sp > XB_SPIN_CAP) { atomicAdd(&bar[XB_TMO], 1u); break; } }
    }
    nloc = mine > 0u ? mine : 1u; nx = cnt > 0u ? cnt : 1u;
}
__device__ __forceinline__ void xcd_barrier(const XcdBarrier& b) {
    asm volatile("s_waitcnt vmcnt(0)" ::: "memory");
    __syncthreads();
    if (threadIdx.x == 0) {
        unsigned* bar = b.bar;
        __builtin_amdgcn_s_waitcnt(0);
        unsigned nloc = b.st[0], nx = b.st[1];
        if (nloc == 0u) { xcd_barrier_complete(bar, b.x, nloc, nx); b.st[0] = nloc; b.st[1] = nx; }
        const unsigned old = xb_add(&bar[XB_XSUB(b.x)], 1u);
        const unsigned gen = old / nloc;
        if (old + 1u == (gen + 1u) * nloc) {
            __builtin_amdgcn_fence(__ATOMIC_RELEASE, "agent");
            asm volatile("s_waitcnt vmcnt(0)" ::: "memory");
            const unsigned og = xb_add(&bar[XB_TOP], 1u);
            const unsigned tg = og / nx;
            if (og + 1u == (tg + 1u) * nx) xb_add(&bar[XB_TOPGEN], 1u);
            else XB_SPIN(xb_ld(&bar[XB_TOPGEN]) == tg, bar);
            __builtin_amdgcn_fence(__ATOMIC_ACQUIRE, "agent");
            xb_add(&bar[XB_XGEN(b.x)], 1u);
            asm volatile("s_waitcnt vmcnt(0)" ::: "memory");
        } else {
            XB_SPIN((int)(xb_ld(&bar[XB_XGEN(b.x)]) - gen) <= 0, bar);
            __builtin_amdgcn_fence(__ATOMIC_ACQUIRE, "agent");
            asm volatile("s_waitcnt vmcnt(0)" ::: "memory");
        }
    }
    __syncthreads();
}

struct XbTok { unsigned role, gen, tg; };
__device__ __forceinline__ XbTok xcd_arrive(const XcdBarrier& b) {
    asm volatile("s_waitcnt vmcnt(0)" ::: "memory");
    __syncthreads();
    XbTok t; t.role = 0u; t.gen = 0u; t.tg = 0u;
    if (threadIdx.x == 0) {
        unsigned* bar = b.bar;
        __builtin_amdgcn_s_waitcnt(0);
        unsigned nloc = b.st[0], nx = b.st[1];
        if (nloc == 0u) { xcd_barrier_complete(bar, b.x, nloc, nx); b.st[0] = nloc; b.st[1] = nx; }
        const unsigned old = xb_add(&bar[XB_XSUB(b.x)], 1u);
        t.gen = old / nloc;
        if (old + 1u == (t.gen + 1u) * nloc) {
            __builtin_amdgcn_fence(__ATOMIC_RELEASE, "agent");
            asm volatile("s_waitcnt vmcnt(0)" ::: "memory");
            const unsigned og = xb_add(&bar[XB_TOP], 1u);
            t.tg = og / nx; t.role = 1u;
            if (og + 1u == (t.tg + 1u) * nx) { xb_add(&bar[XB_TOPGEN], 1u); t.role = 3u; }
        }
    }
    return t;
}
__device__ __forceinline__ void xcd_wait(const XcdBarrier& b, const XbTok& t) {
    if (threadIdx.x == 0) {
        unsigned* bar = b.bar;
        if (t.role != 0u) {
            if (t.role == 1u) XB_SPIN(xb_ld(&bar[XB_TOPGEN]) == t.tg, bar);
            __builtin_amdgcn_fence(__ATOMIC_ACQUIRE, "agent");
            xb_add(&bar[XB_XGEN(b.x)], 1u);
            asm volatile("s_waitcnt vmcnt(0)" ::: "memory");
        } else {
            XB_SPIN(xb_ld(&bar[XB_TOPGEN]) == t.gen, bar);
            __builtin_amdgcn_fence(__ATOMIC_ACQUIRE, "agent");
            asm volatile("s_waitcnt vmcnt(0)" ::: "memory");
        }
    }
    __syncthreads();
}

namespace pg8 {
constexpr int BM = 256, BK = 64, HALF = 128, HTB = HALF * BK * 2, STAGE_BYTES = 8 * HTB, NXCD = 8, WGM = 8;
__host__ __device__ __forceinline__ int lds_byte(int r, int c) { const int st = (r >> 4) * 2 + (c >> 5), rr = r & 15, cc = c & 31, ob = rr * 64 + cc * 2; return st * 1024 + (ob ^ (((ob >> 9) & 1) << 5)); }
__host__ __device__ __forceinline__ void stage_rc(int b, int& R, int& C) { const int st = b / 1024, sb = b % 1024, swz = sb ^ (((sb >> 9) & 1) << 5); R = (st >> 1) * 16 + swz / 64; C = (st & 1) * 32 + (swz % 64) / 2; }
__host__ __device__ __forceinline__ int perm32(int rho) { const int n = rho >> 4, i = rho & 15; return 8 * (i >> 2) + 4 * n + (i & 3); }

struct Unit { int pm, pn, e, tile, rb; };

struct PlainSched {
    static constexpr bool GATHER = false, ROWDMA = false, VARK = false;
    const void* A; const void* Bt; int Kb;
    int nM, nN, nwg, G, c;
    __device__ void init(const void* A_, const void* Bt_, int M, int N, int Kb_, int G_, int c_) { A = A_; Bt = Bt_; Kb = Kb_; nM = M / BM; nN = N / BM; nwg = nM * nN; G = G_; c = c_; }
    __device__ bool next(int i, Unit& u) const {
        const long L = (long)i * G + c; if (L >= nwg) return false;
        int wgid = (int)L; { const int q = nwg / NXCD, r = nwg % NXCD, xcd = wgid % NXCD, off = wgid / NXCD; wgid = (xcd < r ? xcd * (q + 1) : r * (q + 1) + (xcd - r) * q) + off; }
        const int nig = WGM * nN, gid = wgid / nig, fm = gid * WGM, gsz = (nM - fm) < WGM ? (nM - fm) : WGM;
        u.pm = fm + ((wgid % nig) % gsz); u.pn = (wgid % nig) / gsz; u.e = 0; u.tile = u.pm; u.rb = 0; return true;
    }
    __device__ __forceinline__ const char* a_ptr(const Unit& u) const { return (const char*)A + (size_t)u.pm * ((size_t)BM * Kb); }
    __device__ __forceinline__ const char* b_ptr(const Unit& u) const { return (const char*)Bt + (size_t)u.pn * ((size_t)BM * Kb); }
    __device__ __forceinline__ void a_offsets(const Unit&, unsigned (&v)[2][2]) const {
#pragma unroll
        for (int h = 0; h < 2; ++h)
#pragma unroll
            for (int i = 0; i < 2; ++i) { int R, C; stage_rc((int)threadIdx.x * 16 + i * 8192, R, C); v[h][i] = (unsigned)((R + HALF * h) * Kb + C * 2); }
    }
};

struct PlainSchedO : PlainSched {
    static constexpr bool GATHER = true, ROWDMA = false;
    __device__ __forceinline__ void a_offsets_h(const Unit&, int h, unsigned (&v)[2]) const {
#pragma unroll
        for (int i = 0; i < 2; ++i) { int R, C; stage_rc((int)threadIdx.x * 16 + i * 8192, R, C); unsigned o = (unsigned)((R + HALF * h) * Kb + C * 2); asm volatile("" : "+v"(o)); v[i] = o; }
    }
    __device__ __forceinline__ void a_offsets(const Unit& u, unsigned (&v)[2][2]) const { a_offsets_h(u, 0, v[0]); a_offsets_h(u, 1, v[1]); }
};
struct InSched16 : PlainSched {
    __device__ bool next(int i, Unit& u) const { if (!PlainSched::next(i, u)) return false; u.pn = in_map16(u.pn); return true; }
};
struct InSched8 : PlainSchedO {
    __device__ bool next(int i, Unit& u) const { if (!PlainSched::next(i, u)) return false; u.pn = in_map8(u.pn); return true; }
};
struct MixSched {
    static constexpr bool GATHER = false, ROWDMA = false, VARK = true;
    const char* O; const char* Wbr; const char* M; const char* Wout; int Kb, nM, G, c;
    __device__ bool next(int i, Unit& u) const {
        const int rt = i / 12, j = i - rt * 12, pm = c + rt * G; if (pm >= nM) return false;
        u.pm = pm; u.tile = pm; u.rb = 0;
        if (j < 8) { u.pn = j >> 1; u.e = j & 1; } else { u.pn = j - 8; u.e = 2; }
        return true;
    }
    __device__ __forceinline__ int nt(const Unit& u) const { return u.e == 2 ? 16 : 8; }
    __device__ __forceinline__ const char* a_ptr(const Unit& u) const { return (u.e == 2 ? M : O + u.e * 1024) + (size_t)u.pm * ((size_t)BM * 2048); }
    __device__ __forceinline__ const char* b_ptr(const Unit& u) const { return (u.e == 2 ? Wout : Wbr + u.e * 1024) + (size_t)u.pn * ((size_t)BM * 2048); }
    __device__ __forceinline__ void a_offsets(const Unit&, unsigned (&v)[2][2]) const {
#pragma unroll
        for (int h = 0; h < 2; ++h)
#pragma unroll
            for (int i = 0; i < 2; ++i) { int R, C; stage_rc((int)threadIdx.x * 16 + i * 8192, R, C); v[h][i] = (unsigned)((R + HALF * h) * 2048 + C * 2); }
    }
};
constexpr int MOE_TEXP = 2560;
struct MoeSched {
    static constexpr bool VARK = false;
    const LAS int* tstart;
    const LAS int* cnt;
    const char* Abase; const char* Abase_hi;
    const char* Bbase; size_t bstride;
    const char* Bbase2 = nullptr;
    int Kb, T0, T1, slot, nslot, pn;
    __device__ void deal(int NT, int npn, int G, int blk) {
        const int X = (G % (8 * npn) == 0) ? 8 : 1, per = G / X, x = blk % X, c = blk / X;
        T0 = (int)((long)x * NT / X); T1 = (int)((long)(x + 1) * NT / X); pn = c % npn; slot = c / npn; nslot = per / npn;
    }
    __device__ bool next(int i, Unit& u) const {
        const int T = T0 + slot + nslot * i; if (T >= T1) return false;
        u.pn = pn; u.tile = T; u.rb = i & 1;
        const int e = __builtin_amdgcn_readfirstlane(tstart[MOE_TEXP + T]);
        u.e = e; u.pm = __builtin_amdgcn_readfirstlane(T - tstart[e]); return true;
    }
    __device__ __forceinline__ const char* b_ptr(const Unit& u) const { const char* eb = (Bbase2 != nullptr && u.e >= 16) ? Bbase2 + (size_t)(u.e - 16) * bstride : Bbase + (size_t)u.e * bstride;
        return eb + (size_t)u.pn * ((size_t)BM * Kb); }
};
struct MoeSchedG : MoeSched {
    static constexpr bool GATHER = true, ROWDMA = true;
    const int* ltok; LAS int* rowtok;
    const float* bgate; const float* blin; LAS float* biasl;
    __device__ __forceinline__ const char* a_ptr(const Unit&) const { return Abase; }
    __device__ __forceinline__ void prefetch_rows(const Unit& u, int wid, int lane) const {
        if (wid < 4) __builtin_amdgcn_global_load_lds((const __attribute__((address_space(1))) unsigned*)(ltok + (size_t)u.e * NTOK + u.pm * BM + wid * 64) + lane, (LAS unsigned*)(rowtok + u.rb * BM + wid * 64), 4, 0, 0);
        else { const float* src = (wid < 6 ? bgate : blin) + (size_t)u.e * D + u.pn * 128 + (wid & 1) * 64;
            __builtin_amdgcn_global_load_lds((const __attribute__((address_space(1))) unsigned*)src + lane, (LAS unsigned*)(biasl + u.rb * 256 + (wid - 4) * 64), 4, 0, 0); }
    }
    __device__ __forceinline__ void a_offsets_h(const Unit& u, int h, unsigned (&v)[2]) const {
        const int n = cnt[u.e];
#pragma unroll
        for (int i = 0; i < 2; ++i) { int R, C; stage_rc((int)threadIdx.x * 16 + i * 8192, R, C); const int r = R + HALF * h; const int val = rowtok[u.rb * BM + r];
            const int tok = (u.pm * BM + r < n) ? (val >> 2) : 0; v[i] = (unsigned)(tok * Kb + C * 2); }
    }
    __device__ __forceinline__ void a_offsets(const Unit& u, unsigned (&v)[2][2]) const { a_offsets_h(u, 0, v[0]); a_offsets_h(u, 1, v[1]); }
};
struct MoeSchedD : MoeSched {
    static constexpr bool GATHER = true, ROWDMA = true;
    const int* ltok; const float* lw; const float* bdown; LAS unsigned* edl;
    __device__ __forceinline__ void prefetch_rows(const Unit& u, int wid, int lane) const {
        const size_t ro = (size_t)u.e * NTOK + u.pm * BM + (wid & 3) * 64;
        if (wid < 4) { __builtin_amdgcn_global_load_lds((const __attribute__((address_space(1))) unsigned*)(ltok + ro) + lane, edl + u.rb * 768 + wid * 64, 4, 0, 0);
            __builtin_amdgcn_global_load_lds((const __attribute__((address_space(1))) unsigned*)(bdown + (size_t)u.e * D + u.pn * 256 + wid * 64) + lane, edl + u.rb * 768 + 512 + wid * 64, 4, 0, 0); }
        else __builtin_amdgcn_global_load_lds((const __attribute__((address_space(1))) unsigned*)(lw + ro) + lane, edl + u.rb * 768 + 256 + (wid - 4) * 64, 4, 0, 0);
    }
    __device__ __forceinline__ const char* a_ptr(const Unit& u) const { const int r0 = __builtin_amdgcn_readfirstlane(u.tile) * BM; const bool lo_ = r0 < A_LO_ROWS;
        const char* base = lo_ ? Abase : Abase_hi; const int rr = lo_ ? r0 : r0 - A_LO_ROWS; return base + (size_t)rr * PA_HID; }
    __device__ __forceinline__ void a_offsets_h(const Unit&, int h, unsigned (&v)[2]) const {
#pragma unroll
        for (int i = 0; i < 2; ++i) { int R, C; stage_rc((int)threadIdx.x * 16 + i * 8192, R, C); unsigned o = (unsigned)((R + HALF * h) * PA_HID + C * 2); asm volatile("" : "+v"(o)); v[i] = o; }
    }
    __device__ __forceinline__ void a_offsets(const Unit& u, unsigned (&v)[2][2]) const { a_offsets_h(u, 0, v[0]); a_offsets_h(u, 1, v[1]); }
};

typedef f32x4 Acc[2][2][4][2];
template <class Epi, class Sched, bool FP8 = false>
__device__ __forceinline__ void gemm_phase(LAS unsigned char* lds, const int Kb, const Sched& S, const Epi& E) {
    const int tid = threadIdx.x, wid = __builtin_amdgcn_readfirstlane(tid >> 6), lane = tid & 63, wr = wid >> 2, wc = wid & 3, fr = lane & 15, fq = lane >> 4;
    const int nt = Kb / (BK * 2);
    unsigned voffB[2];
#pragma unroll
    for (int i = 0; i < 2; ++i) { int R, C; stage_rc(tid * 16 + i * 8192, R, C); const int Rb = (R & ~31) + perm32(R & 31);
        voffB[i] = (unsigned)(Rb * Kb + C * 2); }
    const size_t kstep = (size_t)(BK * 2);
    const size_t hstep = (size_t)HALF * Kb;
    const unsigned ldsw = (unsigned)wid * 1024u;
    const int aoff = lds_byte(wr * 64 + fr, fq * 8), boff = lds_byte(wc * 32 + fr, fq * 8);
#define PG8_SA(b, h) (((b) * 2 + (h)) * HTB)
#define PG8_SB(b, h) ((4 + (b) * 2 + (h)) * HTB)
#define PG8_GP(gbase, v) ((const __attribute__((address_space(1))) unsigned*)((const __attribute__((address_space(1))) char*)(gbase) + (v)))
#define PG8_STAGE(bufoff, gbase, voff) do { _Pragma("unroll") for (int _i = 0; _i < 2; ++_i) \
        __builtin_amdgcn_global_load_lds(PG8_GP(gbase, (voff)[_i]), (LAS unsigned*)(lds + (bufoff) + ldsw + _i * 8192), 16, 0, 0); } while (0)
#define PG8_STAGE2(bufoff, gbase, v0, v1) do { \
        __builtin_amdgcn_global_load_lds(PG8_GP(gbase, v0), (LAS unsigned*)(lds + (bufoff) + ldsw), 16, 0, 0); \
        __builtin_amdgcn_global_load_lds(PG8_GP(gbase, v1), (LAS unsigned*)(lds + (bufoff) + ldsw + 8192), 16, 0, 0); } while (0)
#define PG8_LDA(dst, b, h) do { _Pragma("unroll") for (int m = 0; m < 4; ++m) _Pragma("unroll") for (int k = 0; k < 2; ++k) dst[m][k] = *(const LAS bf16x8*)(lds + PG8_SA(b, h) + aoff + m * 2048 + k * 1024); } while (0)
#define PG8_LDB(dst, b, h) do { _Pragma("unroll") for (int n = 0; n < 2; ++n) _Pragma("unroll") for (int k = 0; k < 2; ++k) dst[n][k] = *(const LAS bf16x8*)(lds + PG8_SB(b, h) + boff + n * 2048 + k * 1024); } while (0)
#define PG8_MMA(ai, bj, At, Bt) do { __builtin_amdgcn_s_setprio(1); _Pragma("unroll") for (int m = 0; m < 4; ++m) _Pragma("unroll") for (int n = 0; n < 2; ++n) { \
        if constexpr (FP8) { const i32x8 a8 = __builtin_shufflevector(__builtin_bit_cast(i32x4, At[m][0]), __builtin_bit_cast(i32x4, At[m][1]), 0, 1, 2, 3, 4, 5, 6, 7); \
            const i32x8 b8 = __builtin_shufflevector(__builtin_bit_cast(i32x4, Bt[n][0]), __builtin_bit_cast(i32x4, Bt[n][1]), 0, 1, 2, 3, 4, 5, 6, 7); \
            acc[ai][bj][m][n] = __builtin_amdgcn_mfma_scale_f32_16x16x128_f8f6f4(b8, a8, acc[ai][bj][m][n], 0, 0, 0, 0x7f7f7f7f, 0, 0x7f7f7f7f); } \
        else { _Pragma("unroll") for (int k = 0; k < 2; ++k) acc[ai][bj][m][n] = __builtin_amdgcn_mfma_f32_16x16x32_bf16(Bt[n][k], At[m][k], acc[ai][bj][m][n], 0, 0, 0); } } \
        __builtin_amdgcn_s_setprio(0); } while (0)
#define PG8_WAIT_V(n) asm volatile("s_waitcnt vmcnt(" #n ")" ::: "memory")
#define PG8_WAIT_L(n) asm volatile("s_waitcnt lgkmcnt(" #n ")" ::: "memory")
#define PG8_BAR __builtin_amdgcn_s_barrier()
#define PG8_SCHED __builtin_amdgcn_sched_barrier(0)
    Unit cur, nxt; int ui = 0;
    if (!S.next(0, cur)) return;
    int ntu = nt; if constexpr (Sched::VARK) ntu = S.nt(cur);
    Acc acc;
#pragma unroll
    for (int a = 0; a < 2; ++a)
#pragma unroll
        for (int b = 0; b < 2; ++b)
#pragma unroll
            for (int m = 0; m < 4; ++m)
#pragma unroll
                for (int n = 0; n < 2; ++n) acc[a][b][m][n] = (f32x4){0.f, 0.f, 0.f, 0.f};
    bf16x8 At[4][2], B0[2][2], B1[2][2];
    unsigned vA[2][2];
    if constexpr (Sched::ROWDMA) { S.prefetch_rows(cur, wid, lane); PG8_WAIT_V(0); PG8_BAR; }
    S.a_offsets(cur, vA);
    const char* cA = S.a_ptr(cur); const char* cB = S.b_ptr(cur);
    PG8_STAGE(PG8_SB(0, 0), cB, voffB); PG8_STAGE(PG8_SB(0, 1), cB + hstep, voffB); PG8_STAGE2(PG8_SA(0, 0), cA, vA[0][0], vA[0][1]); PG8_STAGE2(PG8_SA(0, 1), cA, vA[1][0], vA[1][1]);
    if (wr == 1) PG8_BAR;
    PG8_WAIT_V(2); PG8_BAR;
    PG8_STAGE(PG8_SB(1, 0), cB + kstep, voffB); PG8_STAGE2(PG8_SA(1, 0), cA + kstep, vA[0][0], vA[0][1]); PG8_STAGE(PG8_SB(1, 1), cB + hstep + kstep, voffB);
    PG8_WAIT_V(6); PG8_BAR;
    for (;;) {
        const bool has_next = S.next(ui + 1, nxt);
        const char* nA = has_next ? S.a_ptr(nxt) : cA; const char* nB = has_next ? S.b_ptr(nxt) : cB;
        const bool newrows = has_next && nxt.tile != cur.tile;
        if constexpr (Sched::ROWDMA) { if (newrows) S.prefetch_rows(nxt, wid, lane); }
#pragma unroll 1
        for (int t = 0; t < ntu; t += 2) {
            const bool last = (t == ntu - 2);
            const char* a1 = cA + (size_t)(t + 1) * kstep;
            const char* a2 = last ? nA : cA + (size_t)(t + 2) * kstep; const char* b2 = last ? nB : cB + (size_t)(t + 2) * kstep;
            const char* a3 = a2 + kstep; const char* b3 = b2 + kstep;
            if constexpr (Sched::GATHER) { if (last && newrows) S.a_offsets_h(nxt, 0, vA[0]); }
            PG8_LDB(B0, 0, 0); PG8_LDB(B1, 0, 1); PG8_SCHED; PG8_LDA(At, 0, 0); PG8_STAGE2(PG8_SA(1, 1), a1, vA[1][0], vA[1][1]);
            if constexpr (Sched::GATHER) { if (last && newrows) S.a_offsets_h(nxt, 1, vA[1]); }
            PG8_WAIT_V(8); PG8_WAIT_L(0); PG8_BAR; PG8_MMA(0, 0, At, B0); PG8_MMA(0, 1, At, B1); PG8_BAR; PG8_SCHED;
            PG8_LDA(At, 0, 1); PG8_STAGE(PG8_SB(0, 0), b2, voffB); PG8_STAGE(PG8_SB(0, 1), b2 + hstep, voffB); PG8_STAGE2(PG8_SA(0, 0), a2, vA[0][0], vA[0][1]);
            PG8_WAIT_V(8); PG8_WAIT_L(0); PG8_BAR; PG8_MMA(1, 0, At, B0); PG8_MMA(1, 1, At, B1); PG8_BAR; PG8_SCHED;
            PG8_LDB(B0, 1, 0); PG8_LDB(B1, 1, 1); PG8_SCHED; PG8_LDA(At, 1, 0); PG8_STAGE2(PG8_SA(0, 1), a2, vA[1][0], vA[1][1]);
            PG8_WAIT_V(8); PG8_WAIT_L(0); PG8_BAR; PG8_MMA(0, 0, At, B0); PG8_MMA(0, 1, At, B1); PG8_BAR; PG8_SCHED;
            PG8_LDA(At, 1, 1); PG8_STAGE(PG8_SB(1, 0), b3, voffB); PG8_STAGE(PG8_SB(1, 1), b3 + hstep, voffB); PG8_STAGE2(PG8_SA(1, 0), a3, vA[0][0], vA[0][1]);
            PG8_WAIT_V(8); PG8_WAIT_L(0); PG8_BAR; PG8_MMA(1, 0, At, B0); PG8_MMA(1, 1, At, B1); PG8_BAR; PG8_SCHED;
        }
        if (wr == 0) PG8_BAR;
        { int tl = (int)threadIdx.x; asm volatile("" : "+v"(tl));
          E(acc, cur, wr, wc, tl & 15, (tl & 63) >> 4); }
        if (!has_next) break;
#pragma unroll
        for (int a = 0; a < 2; ++a)
#pragma unroll
            for (int b = 0; b < 2; ++b)
#pragma unroll
                for (int m = 0; m < 4; ++m)
#pragma unroll
                    for (int n = 0; n < 2; ++n) acc[a][b][m][n] = (f32x4){0.f, 0.f, 0.f, 0.f};
        cur = nxt; cA = nA; cB = nB; ++ui;
        if constexpr (Sched::VARK) ntu = S.nt(cur);
        if (wr == 1) PG8_BAR;
    }
    PG8_WAIT_V(0);
    PG8_BAR;
#undef PG8_SA
#undef PG8_SB
#undef PG8_STAGE
#undef PG8_STAGE2
#undef PG8_LDA
#undef PG8_LDB
#undef PG8_MMA
#undef PG8_WAIT_V
#undef PG8_WAIT_L
#undef PG8_BAR
#undef PG8_SCHED
}
}

struct Args { const float* in[25]; float* out; unsigned char* ws; int ph_lo, ph_hi; };
struct Frame {
    LAS unsigned char* lds; int wave, G, blk;
    static __device__ __forceinline__ int tid() { return (int)threadIdx.x; }
    static __device__ __forceinline__ int lane() { return (int)(threadIdx.x & 63u); }
    static __device__ __forceinline__ const __attribute__((address_space(4))) Args* ka() { return (const __attribute__((address_space(4))) Args*)__builtin_amdgcn_kernarg_segment_ptr(); }
    __device__ __forceinline__ const float* x() const { return ka()->in[0]; }
    __device__ __forceinline__ const float* c() const { return ka()->in[1]; }
    __device__ __forceinline__ const float* ctx() const { return ka()->in[2]; }
    __device__ __forceinline__ const float* c_ctx() const { return ka()->in[3]; }
    __device__ __forceinline__ const float* w_ada() const { return ka()->in[4]; }
    __device__ __forceinline__ const float* b_ada() const { return ka()->in[5]; }
    __device__ __forceinline__ const float* g_mix_pre() const { return ka()->in[6]; }
    __device__ __forceinline__ const float* g_mix_post() const { return ka()->in[7]; }
    __device__ __forceinline__ const float* g_ffn_pre() const { return ka()->in[8]; }
    __device__ __forceinline__ const float* g_ffn_post() const { return ka()->in[9]; }
    __device__ __forceinline__ const float* w_in() const { return ka()->in[10]; }
    __device__ __forceinline__ const float* b_gates() const { return ka()->in[11]; }
    __device__ __forceinline__ const float* rpb() const { return ka()->in[12]; }
    __device__ __forceinline__ const float* g_head() const { return ka()->in[13]; }
    __device__ __forceinline__ const float* w_br_na() const { return ka()->in[14]; }
    __device__ __forceinline__ const float* w_br_ml() const { return ka()->in[15]; }
    __device__ __forceinline__ const float* w_out() const { return ka()->in[16]; }
    __device__ __forceinline__ const float* w_router() const { return ka()->in[17]; }
    __device__ __forceinline__ const float* b_router() const { return ka()->in[18]; }
    __device__ __forceinline__ const float* w_gate() const { return ka()->in[19]; }
    __device__ __forceinline__ const float* b_gate() const { return ka()->in[20]; }
    __device__ __forceinline__ const float* w_lin() const { return ka()->in[21]; }
    __device__ __forceinline__ const float* b_lin() const { return ka()->in[22]; }
    __device__ __forceinline__ const float* w_down() const { return ka()->in[23]; }
    __device__ __forceinline__ const float* b_down() const { return ka()->in[24]; }
    float* out_; unsigned char* ws_;
    __device__ __forceinline__ float* out() const { return out_; }
    __device__ __forceinline__ unsigned char* ws() const { return ws_; }
    __device__ __forceinline__ unsigned* ctl() const { return (unsigned*)(ws_ + WS_CTL); }
};
#define WSP(T, off) ((T*)(F.ws() + (off)))

template <bool F8>
struct EpiInProj {
    static constexpr bool MID = false;
    static constexpr float DSC = F8 ? 1.f / (FP8_SHI * FP8_SW) : 1.f;
    bf16_t* P; int ldp; bf16_t* Vt; int S; float* gates; LAS bf16_t* scr_base;
    bf16_t* Kt; bf16_t* Mvt; const float* rope; bool lat;
    __device__ __forceinline__ void store_t(LAS bf16_t* scr, const float (&v)[8], bf16_t* dst, int lane, int fr, int fq) const {
#pragma unroll
        for (int j = 0; j < 8; ++j) scr[(8 * fq + j) * 24 + fr] = f2bf(v[j]);
        const int rdim = lane >> 1, rhalf = lane & 1;
        const u32x4 tv = *(const LAS u32x4*)(scr + rdim * 24 + 8 * rhalf);
        *(u32x4*)(dst + (size_t)rdim * S + 8 * rhalf) = tv;
    }
    __device__ __forceinline__ void operator()(const pg8::Acc& acc, const pg8::Unit& u, int wr, int wc, int fr, int fq) const {
        const int row0 = u.pm * 256 + wr * 64 + fr, pn = u.pn;
        const int lane = fr + 16 * fq; LAS bf16_t* scr = scr_base + (wr * 4 + wc) * (32 * 24);
        if (pn == 2 || pn == 3 || pn == 5 || pn == 6) {
            const bool na = pn < 4;
#pragma unroll
            for (int ai = 0; ai < 2; ++ai)
#pragma unroll
                for (int m = 0; m < 4; ++m) { const int rowb = u.pm * 256 + wr * 64 + ai * 128 + m * 16; const int b = rowb / S, tin = rowb - b * S;
#pragma unroll
                    for (int bj = 0; bj < 2; ++bj) { float v[8];
#pragma unroll
                        for (int n = 0; n < 2; ++n)
#pragma unroll
                            for (int i = 0; i < 4; ++i) v[4 * n + i] = acc[ai][bj][m][n][i] * DSC;
                        if (na) { const int col0 = (pn - 2) * 256 + bj * 128 + wc * 32; const int head = col0 >> 6, dim0 = col0 & 63;
                            store_t(scr, v, Vt + ((size_t)(b * 8 + head) * 64 + dim0) * S + tin, lane, fr, fq); }
                        else { const int head = 2 * (pn - 5) + bj;
                            store_t(scr, v, Mvt + ((size_t)(b * 4 + head) * 128 + wc * 32) * S + tin, lane, fr, fq); } } }
        } else if (!F8 && pn == 7) {
            if (wc == 0 && fq < 2) {
#pragma unroll
                for (int ai = 0; ai < 2; ++ai)
#pragma unroll
                    for (int m = 0; m < 4; ++m) { const int row = row0 + ai * 128 + m * 16; float* dst = gates + (size_t)row * 16 + 8 * fq;
                        *(f32x4*)dst = acc[ai][0][m][0]; *(f32x4*)(dst + 4) = acc[ai][0][m][1]; }
            }
        } else if (pn == 4 || pn == 10) {
            const int cb = (pn < 7 ? pn : pn - 1) * 256 + wc * 32 + 8 * fq; const bool isk = pn == 4; const float ksc = (isk ? 0.125f : 1.f) * DSC;
#pragma unroll
            for (int am = 0; am < 4; ++am) { const int ai = am >> 1, m0 = 2 * (am & 1);
                f32x4 csv[4][2], snv[4][2];
#pragma unroll
                for (int m = m0; m < m0 + 2; ++m) { const int rowb = u.pm * 256 + wr * 64 + ai * 128 + m * 16; const int b = rowb / S, tin = rowb - b * S, tinl = tin + fr;
                    const int pos = (wc & 1) ? 32 + (tinl & 63) : (tinl >> 6);
                    csv[m][0] = (f32x4){1.f, 1.f, 1.f, 1.f}; csv[m][1] = csv[m][0]; snv[m][0] = (f32x4){0.f, 0.f, 0.f, 0.f}; snv[m][1] = snv[m][0];
                    if (lat) { const float* tp = rope + pos * 16 + 8 * (fq & 1); csv[m][0] = *(const f32x4*)tp; csv[m][1] = *(const f32x4*)(tp + 4); snv[m][0] = *(const f32x4*)(tp + 96 * 16); snv[m][1] = *(const f32x4*)(tp + 96 * 16 + 4); } }
#pragma unroll
                for (int m = m0; m < m0 + 2; ++m) { asm volatile("" : "+v"(csv[m][0])); asm volatile("" : "+v"(csv[m][1])); asm volatile("" : "+v"(snv[m][0])); asm volatile("" : "+v"(snv[m][1])); }
#pragma unroll
                for (int m = m0; m < m0 + 2; ++m) { const int rowb = u.pm * 256 + wr * 64 + ai * 128 + m * 16; const int b = rowb / S, tin = rowb - b * S;
                    bf16_t* rowp = P + (size_t)(row0 + ai * 128 + m * 16) * ldp + cb;
                    f32x4 cs0 = csv[m][0], cs1 = csv[m][1], sn0 = snv[m][0], sn1 = snv[m][1];
                    if (lat && fq < 2) { sn0 = -sn0; sn1 = -sn1; }
#pragma unroll
                    for (int bj = 0; bj < 2; ++bj) { float v[8];
#pragma unroll
                        for (int n = 0; n < 2; ++n)
#pragma unroll
                            for (int i = 0; i < 4; ++i) { float own = acc[ai][bj][m][n][i];
                                if (lat) { const float oth = __shfl_xor(own, 32); own = own * (n ? cs1[i] : cs0[i]) + oth * (n ? sn1[i] : sn0[i]); }
                                v[4 * n + i] = own * ksc; }
                        u32x4 pk; pk[0] = cvt_pk_bf16(v[0], v[1]); pk[1] = cvt_pk_bf16(v[2], v[3]); pk[2] = cvt_pk_bf16(v[4], v[5]); pk[3] = cvt_pk_bf16(v[6], v[7]);
                        *(u32x4*)(rowp + bj * 128) = pk;
                        if (isk) { const int head = 2 * bj + (wc >> 1); store_t(scr, v, Kt + ((size_t)(b * 4 + head) * 64 + 32 * (wc & 1)) * S + tin, lane, fr, fq); } } }
            }
        } else if (pn >= 13) {
            const int gb = 2 * PC_GNA + (pn - 13) * 256 + wc * 32 + 8 * fq;
#pragma unroll
            for (int ai = 0; ai < 2; ++ai)
#pragma unroll
                for (int m = 0; m < 4; ++m) { unsigned char* rowp = (unsigned char*)(P + (size_t)(row0 + ai * 128 + m * 16) * ldp) + gb;
#pragma unroll
                    for (int bj = 0; bj < 2; ++bj) { float g[8];
#pragma unroll
                        for (int n = 0; n < 2; ++n)
#pragma unroll
                            for (int i = 0; i < 4; ++i) g[4 * n + i] = FP8_SG * __builtin_amdgcn_rcpf(1.f + __builtin_amdgcn_exp2f(acc[ai][bj][m][n][i] * (-1.4426950408889634f * DSC)));
                        *(u32x2*)(rowp + bj * 128) = (u32x2){pack_fp8x4(g[0], g[1], g[2], g[3]), pack_fp8x4(g[4], g[5], g[6], g[7])}; } }
        } else {
            const int cb = (pn < 7 ? pn : pn - 1) * 256 + wc * 32 + 8 * fq;
#pragma unroll
            for (int ai = 0; ai < 2; ++ai)
#pragma unroll
                for (int m = 0; m < 4; ++m) { bf16_t* rowp = P + (size_t)(row0 + ai * 128 + m * 16) * ldp + cb;
#pragma unroll
                    for (int bj = 0; bj < 2; ++bj) { const f32x4 v0 = acc[ai][bj][m][0] * DSC, v1 = acc[ai][bj][m][1] * DSC;
                        u32x4 pk; pk[0] = cvt_pk_bf16(v0[0], v0[1]); pk[1] = cvt_pk_bf16(v0[2], v0[3]); pk[2] = cvt_pk_bf16(v1[0], v1[1]); pk[3] = cvt_pk_bf16(v1[2], v1[3]);
                        *(u32x4*)(rowp + bj * 128) = pk; } }
        }
    }
};
struct EpiBranchA {
    static constexpr bool MID = false;
    const bf16_t* P; bf16_t* T;
    __device__ __forceinline__ void operator()(const pg8::Acc& acc, const pg8::Unit& u, int wr, int wc, int fr, int fq) const {
        const int row0 = u.pm * 256 + wr * 64 + fr, cb = u.pn * 256 + wc * 32 + 8 * fq;
#pragma unroll
        for (int ai = 0; ai < 2; ++ai)
#pragma unroll
            for (int m = 0; m < 4; ++m) { const size_t row = (size_t)(row0 + ai * 128 + m * 16);
#pragma unroll
                for (int bj = 0; bj < 2; ++bj) { const u32x4 gm = *(const u32x4*)(P + row * LDP + cb + PC_GNA + bj * 128);
                    float v[8];
#pragma unroll
                    for (int q = 0; q < 4; ++q) { const f32x2 gq = (f32x2){bf_lo(gm[q]), bf_hi(gm[q])} * -1.4426950408889634f; f32x2 e; e[0] = __builtin_amdgcn_exp2f(gq[0]); e[1] = __builtin_amdgcn_exp2f(gq[1]);
                        const f32x2 dn = e + 1.f; f32x2 r; r[0] = __builtin_amdgcn_rcpf(dn[0]); r[1] = __builtin_amdgcn_rcpf(dn[1]);
                        const f32x2 o = (f32x2){acc[ai][bj][m][q >> 1][(q & 1) * 2], acc[ai][bj][m][q >> 1][(q & 1) * 2 + 1]} * r; v[2 * q] = o[0]; v[2 * q + 1] = o[1]; }
                    u32x4 pk; pk[0] = cvt_pk_bf16(v[0], v[1]); pk[1] = cvt_pk_bf16(v[2], v[3]); pk[2] = cvt_pk_bf16(v[4], v[5]); pk[3] = cvt_pk_bf16(v[6], v[7]);
                    *(u32x4*)(T + row * D + cb + bj * 128) = pk; } }
    }
};
struct EpiBranchB {
    static constexpr bool MID = false;
    const bf16_t* P; const bf16_t* T; bf16_t* O;
    __device__ __forceinline__ void operator()(const pg8::Acc& acc, const pg8::Unit& u, int wr, int wc, int fr, int fq) const {
        const int row0 = u.pm * 256 + wr * 64 + fr, cb = u.pn * 256 + wc * 32 + 8 * fq;
#pragma unroll
        for (int ai = 0; ai < 2; ++ai)
#pragma unroll
            for (int m = 0; m < 4; ++m) { const size_t row = (size_t)(row0 + ai * 128 + m * 16);
#pragma unroll
                for (int bj = 0; bj < 2; ++bj) { const u32x4 gm = *(const u32x4*)(P + row * LDP + cb + PC_GML + bj * 128); const u32x4 tv = *(const u32x4*)(T + row * D + cb + bj * 128);
                    float v[8];
#pragma unroll
                    for (int q = 0; q < 4; ++q) { const f32x2 gq = (f32x2){bf_lo(gm[q]), bf_hi(gm[q])} * -1.4426950408889634f; f32x2 e; e[0] = __builtin_amdgcn_exp2f(gq[0]); e[1] = __builtin_amdgcn_exp2f(gq[1]);
                        const f32x2 dn = e + 1.f; f32x2 r; r[0] = __builtin_amdgcn_rcpf(dn[0]); r[1] = __builtin_amdgcn_rcpf(dn[1]);
                        const f32x2 o = (f32x2){acc[ai][bj][m][q >> 1][(q & 1) * 2], acc[ai][bj][m][q >> 1][(q & 1) * 2 + 1]} * r + (f32x2){bf_lo(tv[q]), bf_hi(tv[q])}; v[2 * q] = o[0]; v[2 * q + 1] = o[1]; }
                    u32x4 pk; pk[0] = cvt_pk_bf16(v[0], v[1]); pk[1] = cvt_pk_bf16(v[2], v[3]); pk[2] = cvt_pk_bf16(v[4], v[5]); pk[3] = cvt_pk_bf16(v[6], v[7]);
                    *(u32x4*)(O + row * D + cb + bj * 128) = pk; } }
    }
};
struct EpiMix {
    static constexpr bool MID = false;
    const bf16_t* P; bf16_t* Tw; bf16_t* M; bf16_t* Y;
    __device__ __forceinline__ void operator()(const pg8::Acc& acc, const pg8::Unit& u, int wr, int wc, int fr, int fq) const {
        const int rl0 = wr * 64 + fr, cl = wc * 32 + 8 * fq, row0 = u.pm * 256 + rl0, cb = u.pn * 256 + cl;
        if (u.e == 2) {
#pragma unroll
            for (int ai = 0; ai < 2; ++ai)
#pragma unroll
                for (int m = 0; m < 4; ++m) { bf16_t* rowp = Y + (size_t)(row0 + ai * 128 + m * 16) * D + cb;
#pragma unroll
                    for (int bj = 0; bj < 2; ++bj) { const f32x4 v0 = acc[ai][bj][m][0], v1 = acc[ai][bj][m][1];
                        u32x4 pk; pk[0] = cvt_pk_bf16(v0[0], v0[1]); pk[1] = cvt_pk_bf16(v0[2], v0[3]); pk[2] = cvt_pk_bf16(v1[0], v1[1]); pk[3] = cvt_pk_bf16(v1[2], v1[3]);
                        *(u32x4*)(rowp + bj * 128) = pk; } }
        } else {
            const bool second = u.e != 0; const int gc = 2 * PC_GNA + (second ? 1024 : 0);
            u32x2 gmv[2][4][2];
#pragma unroll
            for (int m = 0; m < 4; ++m)
#pragma unroll
                for (int bj = 0; bj < 2; ++bj) gmv[0][m][bj] = *(const u32x2*)((const unsigned char*)(P + (size_t)(u.pm * 256 + rl0 + m * 16) * LDP) + gc + cb + bj * 128);
#pragma unroll
            for (int ai = 0; ai < 2; ++ai) {
                u32x4 tvv[4][2];
#pragma unroll
                for (int m = 0; m < 4; ++m) { const int rl = rl0 + ai * 128 + m * 16;
#pragma unroll
                    for (int bj = 0; bj < 2; ++bj) { tvv[m][bj] = (u32x4){0u, 0u, 0u, 0u}; if (second) tvv[m][bj] = *(const u32x4*)(Tw + rl * 256 + cl + bj * 128); } }
                if (ai == 0) {
#pragma unroll
                    for (int m = 0; m < 4; ++m)
#pragma unroll
                        for (int bj = 0; bj < 2; ++bj) gmv[1][m][bj] = *(const u32x2*)((const unsigned char*)(P + (size_t)(u.pm * 256 + rl0 + 128 + m * 16) * LDP) + gc + cb + bj * 128); }
#pragma unroll
                for (int m = 0; m < 4; ++m)
#pragma unroll
                    for (int bj = 0; bj < 2; ++bj) { asm volatile("" : "+v"(gmv[ai][m][bj])); asm volatile("" : "+v"(tvv[m][bj])); }
#pragma unroll
                for (int m = 0; m < 4; ++m) { const int rl = rl0 + ai * 128 + m * 16; const size_t row = (size_t)(u.pm * 256 + rl);
#pragma unroll
                    for (int bj = 0; bj < 2; ++bj) { const u32x2 gm = gmv[ai][m][bj]; const u32x4 tv = tvv[m][bj];
                        bf16_t* tp = Tw + rl * 256 + cl + bj * 128;
                        float v[8];
#pragma unroll
                        for (int q = 0; q < 4; ++q) { const f32x2 r = ((q & 1) ? __builtin_amdgcn_cvt_pk_f32_fp8((int)gm[q >> 1], true) : __builtin_amdgcn_cvt_pk_f32_fp8((int)gm[q >> 1], false)) * (1.f / FP8_SG);
                            const f32x2 o = (f32x2){acc[ai][bj][m][q >> 1][(q & 1) * 2], acc[ai][bj][m][q >> 1][(q & 1) * 2 + 1]} * r + (f32x2){bf_lo(tv[q]), bf_hi(tv[q])}; v[2 * q] = o[0]; v[2 * q + 1] = o[1]; }
                        u32x4 pk; pk[0] = cvt_pk_bf16(v[0], v[1]); pk[1] = cvt_pk_bf16(v[2], v[3]); pk[2] = cvt_pk_bf16(v[4], v[5]); pk[3] = cvt_pk_bf16(v[6], v[7]);
                        if (second) *(u32x4*)(M + row * D + cb + bj * 128) = pk; else *(u32x4*)tp = pk; } }
            }
            if (second) asm volatile("s_waitcnt vmcnt(0)" ::: "memory");
        }
    }
};
struct EpiPlain {
    static constexpr bool MID = false;
    bf16_t* O; int ldc;
    __device__ __forceinline__ void operator()(const pg8::Acc& acc, const pg8::Unit& u, int wr, int wc, int fr, int fq) const {
        const int row0 = u.pm * 256 + wr * 64 + fr, cb = u.pn * 256 + wc * 32 + 8 * fq;
#pragma unroll
        for (int ai = 0; ai < 2; ++ai)
#pragma unroll
            for (int m = 0; m < 4; ++m) { bf16_t* rowp = O + (size_t)(row0 + ai * 128 + m * 16) * ldc + cb;
#pragma unroll
                for (int bj = 0; bj < 2; ++bj) { const f32x4 v0 = acc[ai][bj][m][0], v1 = acc[ai][bj][m][1];
                    u32x4 pk; pk[0] = cvt_pk_bf16(v0[0], v0[1]); pk[1] = cvt_pk_bf16(v0[2], v0[3]); pk[2] = cvt_pk_bf16(v1[0], v1[1]); pk[3] = cvt_pk_bf16(v1[2], v1[3]);
                    *(u32x4*)(rowp + bj * 128) = pk; } }
    }
};
struct EpiSwiglu {
    static constexpr bool MID = false;
    unsigned char* Alo; unsigned char* Ahi; const LAS float* biasl;
    __device__ __forceinline__ void operator()(const pg8::Acc& acc, const pg8::Unit& u, int wr, int wc, int fr, int fq) const {
        constexpr float dsc = 1.f / (FP8_SW * FP8_SH);
        const int r0 = u.tile * 256; unsigned char* base = r0 < A_LO_ROWS ? Alo + (size_t)r0 * PA_HID : Ahi + (size_t)(r0 - A_LO_ROWS) * PA_HID;
        const int rl0 = wr * 64 + fr, cb = u.pn * 128 + wc * 32 + 8 * fq;
        const LAS float* pg = biasl + u.rb * 256 + wc * 32 + 8 * fq; const LAS float* pl = pg + 128;
        const f32x4 g0 = *(const LAS f32x4*)pg * FP8_SA, g1 = *(const LAS f32x4*)(pg + 4) * FP8_SA, l0 = *(const LAS f32x4*)pl + 1.f, l1 = *(const LAS f32x4*)(pl + 4) + 1.f;
        constexpr float dg = dsc * FP8_SA, ce = -2.4554669595930157f / FP8_SA;
#pragma unroll
        for (int ai = 0; ai < 2; ++ai)
#pragma unroll
            for (int m = 0; m < 4; ++m) { float v[8];
#pragma unroll
                for (int n = 0; n < 2; ++n)
#pragma unroll
                    for (int p = 0; p < 2; ++p) { const f32x4 bgv = n ? g1 : g0, blv = n ? l1 : l0;
                        f32x2 G = (f32x2){acc[ai][0][m][n][2 * p], acc[ai][0][m][n][2 * p + 1]} * dg + (f32x2){bgv[2 * p], bgv[2 * p + 1]};
                        f32x2 L = (f32x2){acc[ai][1][m][n][2 * p], acc[ai][1][m][n][2 * p + 1]} * dsc + (f32x2){blv[2 * p], blv[2 * p + 1]};
                        G[0] = fminf(G[0], 7.f * FP8_SA); G[1] = fminf(G[1], 7.f * FP8_SA); L[0] = __builtin_amdgcn_fmed3f(L[0], -6.f, 8.f); L[1] = __builtin_amdgcn_fmed3f(L[1], -6.f, 8.f);
                        const f32x2 T = G * ce; f32x2 E; E[0] = __builtin_amdgcn_exp2f(T[0]); E[1] = __builtin_amdgcn_exp2f(T[1]);
                        const f32x2 Dn = E + 1.f; f32x2 R; R[0] = __builtin_amdgcn_rcpf(Dn[0]); R[1] = __builtin_amdgcn_rcpf(Dn[1]);
                        const f32x2 O = (G * R) * L; v[4 * n + 2 * p] = O[0]; v[4 * n + 2 * p + 1] = O[1]; }
                unsigned p0 = 0u, p1 = 0u;
                p0 = __builtin_amdgcn_cvt_pk_fp8_f32(v[0], v[1], p0, false); p0 = __builtin_amdgcn_cvt_pk_fp8_f32(v[2], v[3], p0, true);
                p1 = __builtin_amdgcn_cvt_pk_fp8_f32(v[4], v[5], p1, false); p1 = __builtin_amdgcn_cvt_pk_fp8_f32(v[6], v[7], p1, true);
                *(u32x2*)(base + (size_t)(rl0 + ai * 128 + m * 16) * PA_HID + cb) = (u32x2){p0, p1}; }
    }
};
struct EpiDown {
    static constexpr bool MID = false;
    unsigned char* Ys; const LAS unsigned* edl; const LAS int* cnt;
    __device__ __forceinline__ void operator()(const pg8::Acc& acc, const pg8::Unit& u, int wr, int wc, int fr, int fq) const {
        constexpr float dsc = 1.f / (FP8_SW * FP8_SA);
        const int n = __builtin_amdgcn_readfirstlane(cnt[u.e]), li0 = u.pm * 256 + wr * 64 + fr, cb = u.pn * 256 + wc * 32 + 8 * fq;
        const LAS unsigned* ed = edl + u.rb * 768; const LAS float* pb = (const LAS float*)(ed + 512) + wc * 32 + 8 * fq;
        f32x4 bv[2][2];
#pragma unroll
        for (int bj = 0; bj < 2; ++bj) { bv[bj][0] = *(const LAS f32x4*)(pb + bj * 128); bv[bj][1] = *(const LAS f32x4*)(pb + bj * 128 + 4); }
        int slv[2][4]; float wvv[2][4];
#pragma unroll
        for (int ai = 0; ai < 2; ++ai)
#pragma unroll
            for (int m = 0; m < 4; ++m) { const int rl = wr * 64 + fr + ai * 128 + m * 16; slv[ai][m] = (int)ed[rl]; wvv[ai][m] = __uint_as_float(ed[256 + rl]); }
#pragma unroll
        for (int ai = 0; ai < 2; ++ai)
#pragma unroll
            for (int m = 0; m < 4; ++m) { const int li = li0 + ai * 128 + m * 16;
                if (li < n) { const int slot = slv[ai][m]; const float w = wvv[ai][m];
                    unsigned char* rowp = Ys + (size_t)slot * D + cb;
#pragma unroll
                    for (int bj = 0; bj < 2; ++bj) { const float ws = w * FP8_SY; f32x4 v0 = (acc[ai][bj][m][0] * dsc + bv[bj][0]) * ws, v1 = (acc[ai][bj][m][1] * dsc + bv[bj][1]) * ws;
#pragma unroll
                        for (int i = 0; i < 4; ++i) { v0[i] = __builtin_amdgcn_fmed3f(v0[i], -448.f, 448.f); v1[i] = __builtin_amdgcn_fmed3f(v1[i], -448.f, 448.f); }
                        unsigned p0 = 0u, p1 = 0u;
                        p0 = __builtin_amdgcn_cvt_pk_fp8_f32(v0[0], v0[1], p0, false); p0 = __builtin_amdgcn_cvt_pk_fp8_f32(v0[2], v0[3], p0, true);
                        p1 = __builtin_amdgcn_cvt_pk_fp8_f32(v1[0], v1[1], p1, false); p1 = __builtin_amdgcn_cvt_pk_fp8_f32(v1[2], v1[3], p1, true);
                        *(u32x2*)(rowp + bj * 128) = (u32x2){p0, p1}; } } }
    }
};

__device__ __forceinline__ void phase_ada(const Frame& F) {
    LAS float* tab = (LAS float*)F.lds;
    float* modv = WSP(float, WS_MODV);
    for (int cg = F.blk; cg < 256; cg += F.G) {
        const int j0 = cg * 24, cc = F.tid() % 24, kg = F.tid() / 24;
        float acc[33];
#pragma unroll
        for (int b = 0; b < 33; ++b) acc[b] = 0.f;
        for (int half = 0; half < 2; ++half) {
            __syncthreads();
            {
                float vv[33]; const int k = F.tid();
#pragma unroll
                for (int b = 0; b < 33; ++b) vv[b] = (b < 32) ? F.c()[b * D + half * 512 + k] : F.c_ctx()[half * 512 + k];
#pragma unroll
                for (int b = 0; b < 33; ++b) tab[k * 36 + b] = vv[b] * sigmoidf_(vv[b]); }
            __syncthreads();
            if (kg < 21) {
                float wv[25];
#pragma unroll
                for (int i = 0; i < 25; ++i) { const int k = kg + 21 * i; wv[i] = (k < 512) ? F.w_ada()[(size_t)(half * 512 + k) * 6144 + j0 + cc] : 0.f; }
#pragma unroll
                for (int i = 0; i < 25; ++i) { const int k = (kg + 21 * i < 512) ? kg + 21 * i : 0; const float w = wv[i];
                    const LAS f32x4* tp = (const LAS f32x4*)(tab + k * 36);
#pragma unroll
                    for (int q = 0; q < 8; ++q) { const f32x4 sv = tp[q]; acc[4 * q] += sv[0] * w; acc[4 * q + 1] += sv[1] * w; acc[4 * q + 2] += sv[2] * w; acc[4 * q + 3] += sv[3] * w; }
                    acc[32] += tab[k * 36 + 32] * w;
                }
            }
        }
        __syncthreads();
        LAS float* part = (LAS float*)F.lds;
        if (kg < 21) {
#pragma unroll
            for (int b = 0; b < 33; ++b) part[(kg * 24 + cc) * 33 + b] = acc[b];
        }
        __syncthreads();
        for (int o = F.tid(); o < 24 * 33; o += 512) { const int c2 = o / 33, b = o % 33; float s = F.b_ada()[j0 + c2];
            for (int g = 0; g < 21; ++g) s += part[(g * 24 + c2) * 33 + b];
            modv[(size_t)b * 6144 + j0 + c2] = s; }
        __syncthreads();
    }
}

__device__ __forceinline__ void cvt_tile(const Frame& F, LAS bf16_t* t, const float* src, int ld, int valid, bf16_t* dst, int dld) {
    const int tid = F.tid();
    __syncthreads();
    f32x4 vq[4];
#pragma unroll
    for (int p = 0; p < 4; ++p) { const int k = (tid >> 4) + 32 * p, c = 4 * (tid & 15); const int cc = c < valid ? c : 0;
        vq[p] = *(const f32x4*)(src + (size_t)k * ld + cc); }
#pragma unroll
    for (int p = 0; p < 4; ++p) asm volatile("" : "+v"(vq[p]));
#pragma unroll
    for (int p = 0; p < 4; ++p) { const int k = (tid >> 4) + 32 * p, c = 4 * (tid & 15);
        const f32x4 v = (c < valid) ? vq[p] : (f32x4){0.f, 0.f, 0.f, 0.f};
        *(LAS unsigned*)(t + k * 66 + c) = cvt_pk_bf16(v[0], v[1]); *(LAS unsigned*)(t + k * 66 + c + 2) = cvt_pk_bf16(v[2], v[3]); }
    __syncthreads();
    const int n = tid >> 3, kg = tid & 7;
    unsigned pk[8];
#pragma unroll
    for (int q = 0; q < 8; ++q) { const unsigned lo = t[(16 * kg + 2 * q) * 66 + n], hi = t[(16 * kg + 2 * q + 1) * 66 + n]; pk[q] = lo | (hi << 16); }
    u32x4* d = (u32x4*)(dst + (size_t)n * dld + 16 * kg);
    d[0] = (u32x4){pk[0], pk[1], pk[2], pk[3]}; d[1] = (u32x4){pk[4], pk[5], pk[6], pk[7]};
}
__device__ __forceinline__ void cvt_tile8(const Frame& F, LAS float* t, const float* src, int ld, unsigned char* dst, int dld, float scale) {
    const int tid = F.tid();
    __syncthreads();
#pragma unroll
    for (int p = 0; p < 4; ++p) { const int k = (tid >> 4) + 32 * p, c = 4 * (tid & 15);
        const f32x4 v = *(const f32x4*)(src + (size_t)k * ld + c);
        t[k * 65 + c] = v[0]; t[k * 65 + c + 1] = v[1]; t[k * 65 + c + 2] = v[2]; t[k * 65 + c + 3] = v[3]; }
    __syncthreads();
    const int n = tid >> 3, kg = tid & 7;
    u32x4 pk;
#pragma unroll
    for (int q = 0; q < 4; ++q) pk[q] = pack_fp8x4(t[(16 * kg + 4 * q) * 65 + n] * scale, t[(16 * kg + 4 * q + 1) * 65 + n] * scale, t[(16 * kg + 4 * q + 2) * 65 + n] * scale, t[(16 * kg + 4 * q + 3) * 65 + n] * scale);
    *(u32x4*)(dst + (size_t)n * dld + 16 * kg) = pk;
}
__device__ __forceinline__ void phase_cvt_small(const Frame& F) {
    if (F.blk == 0) { float* rope = WSP(float, WS_ROPE);
        for (int i = F.tid(); i < 96 * 16; i += 512) { const int p = i >> 4, j = i & 15; const float pos = (p < 32) ? (float)p : (float)(p - 32);
            const float inv = powf(10000.f, -(float)j / 16.f); float sn, cs; sincosf(pos * inv, &sn, &cs); rope[i] = cs; rope[96 * 16 + i] = sn; } }
    LAS bf16_t* t = (LAS bf16_t*)F.lds;
    bf16_t* btin = WSP(bf16_t, WS_BTIN); bf16_t* btbr = WSP(bf16_t, WS_BTBR); bf16_t* btout = WSP(bf16_t, WS_BTOUT);
    for (int task = F.blk; task < 928; task += F.G) {
        if (task < 672) { const int nc = task >> 3, kt = task & 7, n0 = nc * 64; int c0, valid;
            if (n0 < 1792) { c0 = n0; valid = 64; } else if (n0 == 1792) { c0 = 1792; valid = 16; } else if (n0 < 2048) { c0 = 0; valid = 0; } else { c0 = n0 - 240; valid = 64; }
            if (n0 < N_IN16) cvt_tile(F, t, F.w_in() + (size_t)(kt * 128) * W_IN_COLS + c0, W_IN_COLS, valid, btin + (size_t)n0 * D + kt * 128, D);
            if (in_is8(n0 >> 8)) cvt_tile8(F, (LAS float*)F.lds, F.w_in() + (size_t)(kt * 128) * W_IN_COLS + c0, W_IN_COLS, WSP(unsigned char, WS_BTIN8) + (size_t)n0 * D + kt * 128, D, FP8_SW);
        } else if (task < 800) { const int q = task - 672, nc = q >> 3, kt = q & 7;
            const float* src = (kt < 4) ? F.w_br_na() + (size_t)(kt * 128) * D + nc * 64 : F.w_br_ml() + (size_t)((kt - 4) * 128) * D + nc * 64;
            cvt_tile(F, t, src, D, 64, btbr + (size_t)(nc * 64) * D + kt * 128, D);
        } else { const int q = task - 800, nc = q >> 3, kt = q & 7;
            cvt_tile(F, t, F.w_out() + (size_t)(kt * 128) * D + nc * 64, D, 64, btout + (size_t)(nc * 64) * D + kt * 128, D); }
    }
    __syncthreads();
}
__device__ __forceinline__ void cvt_exp_task(const Frame& F, int task, const float*& src, unsigned char*& dst) {
    unsigned char* wgl = WSP(unsigned char, WS_WGL);
    if (task < NEXP * 256) { const int e = task >> 8, q = task & 255; const int nc = q >> 3, kt = q & 7, n0 = nc * 64;
        const int pn = n0 >> 8, bj = (n0 >> 7) & 1, j = 128 * pn + (n0 & 127);
        src = (bj ? F.w_lin() : F.w_gate()) + (size_t)e * D * D + (size_t)(kt * 128) * D + j; dst = wgl + (size_t)e * 2048 * D + (size_t)n0 * D + kt * 128;
    } else { const int t2 = task - NEXP * 256; const int e = t2 >> 7, q2 = t2 & 127, nc = q2 >> 3, kt = q2 & 7;
        src = F.w_down() + (size_t)e * D * D + (size_t)(kt * 128) * D + nc * 64; unsigned char* wd = e < 16 ? (unsigned char*)F.out() + DO_WD0 + (size_t)e * D * D : WSP(unsigned char, WS_WD1) + (size_t)(e - 16) * D * D;
        dst = wd + (size_t)(nc * 64) * D + kt * 128; }
}
__device__ __forceinline__ void phase_cvt_experts(const Frame& F, const int T0, const int NTASK) {
    LAS float* t = (LAS float*)F.lds;
    const int tid = F.tid(), k0 = tid >> 4, c = 4 * (tid & 15), n = tid >> 3, kg = tid & 7;
#define CVT_LOAD(r, task_) do { const float* src_; unsigned char* dst_; cvt_exp_task(F, (task_), src_, dst_); (void)dst_; \
        _Pragma("unroll") for (int p = 0; p < 4; ++p) (r)[p] = __builtin_nontemporal_load((const f32x4*)(src_ + (size_t)(k0 + 32 * p) * D + c)); } while (0)
#define CVT_EMIT(r, task_) do { __syncthreads(); \
        _Pragma("unroll") for (int p = 0; p < 4; ++p) { LAS float* tp = t + (k0 + 32 * p) * 65 + c; tp[0] = (r)[p][0]; tp[1] = (r)[p][1]; tp[2] = (r)[p][2]; tp[3] = (r)[p][3]; } \
        const float* src_; unsigned char* dcur; cvt_exp_task(F, (task_), src_, dcur); (void)src_; \
        { const int tn_ = ((task_) + 2 * F.G < NTASK) ? (task_) + 2 * F.G : (task_); CVT_LOAD(r, tn_); }     \
        __syncthreads(); u32x4 pk; \
        _Pragma("unroll") for (int q = 0; q < 4; ++q) pk[q] = pack_fp8x4(t[(16 * kg + 4 * q) * 65 + n] * FP8_SW, t[(16 * kg + 4 * q + 1) * 65 + n] * FP8_SW, t[(16 * kg + 4 * q + 2) * 65 + n] * FP8_SW, t[(16 * kg + 4 * q + 3) * 65 + n] * FP8_SW); \
        *(u32x4*)(dcur + (size_t)n * D + 16 * kg) = pk; } while (0)
    f32x4 rA[4], rB[4];
    int task = T0 + F.blk;
    if (task < NTASK) {
        CVT_LOAD(rA, task);
        { const int t1_ = (task + F.G < NTASK) ? task + F.G : task; CVT_LOAD(rB, t1_); }
        for (;;) {
            CVT_EMIT(rA, task);
            if (task + F.G >= NTASK) break;
            CVT_EMIT(rB, task + F.G);
            task += 2 * F.G; if (task >= NTASK) break;
        }
    }
#undef CVT_LOAD
#undef CVT_EMIT
    __syncthreads();
}

__device__ __forceinline__ void phase_norm1(const Frame& F) {
    const float* modv = WSP(float, WS_MODV); bf16_t* H = WSP(bf16_t, WS_H); unsigned char* H8 = WSP(unsigned char, WS_H8);
    constexpr int NGRP = (NTOK + NCTX) / 32;
    const int lane = F.lane();
    { float* comb = WSP(float, WS_COMB);
      for (int i = F.blk * 512 + F.tid(); i < 32 * 4096; i += F.G * 512) { const int b = i >> 12, which = (i >> 10) & 3, k = i & 1023; const float* mb = modv + (size_t)b * 6144;
          comb[i] = which == 0 ? mb[2048 + k] * F.g_mix_post()[k] : which == 1 ? F.g_ffn_pre()[k] * (mb[4096 + k] + 1.f) : which == 2 ? mb[3072 + k] : mb[5120 + k] * F.g_ffn_post()[k]; } }
    int curb = -1; f32x4 al[4], be[4];
    for (int grp = F.blk; grp < NGRP; grp += F.G) {
        const int r0 = grp * 32 + F.wave * 4;
        const int b = (r0 < NTOK) ? r0 / SEQ : 32;
        if (b != curb) { curb = b;
#pragma unroll
            for (int j = 0; j < 4; ++j) { const int k = 256 * j + 4 * lane; const f32x4 g = *(const f32x4*)(F.g_mix_pre() + k), sc = *(const f32x4*)(modv + (size_t)b * 6144 + 1024 + k);
                al[j] = g * (sc + 1.f); be[j] = *(const f32x4*)(modv + (size_t)b * 6144 + k); } }
        const float* src = (r0 < NTOK) ? F.x() + (size_t)r0 * D : F.ctx() + (size_t)(r0 - NTOK) * D;
        f32x4 v[4][4];
#pragma unroll
        for (int t = 0; t < 4; ++t)
#pragma unroll
            for (int j = 0; j < 4; ++j) v[t][j] = __builtin_nontemporal_load((const f32x4*)(src + (size_t)t * D + 256 * j + 4 * lane));
#pragma unroll
        for (int t = 0; t < 4; ++t) { float ss = 0.f;
#pragma unroll
            for (int j = 0; j < 4; ++j) ss += v[t][j][0] * v[t][j][0] + v[t][j][1] * v[t][j][1] + v[t][j][2] * v[t][j][2] + v[t][j][3] * v[t][j][3];
            ss = wave_sum(ss); const float rs = rsqrtf(ss * (1.f / D) + EPS);
#pragma unroll
            for (int j = 0; j < 4; ++j) { const f32x4 o = v[t][j] * rs * al[j] + be[j]; u32x2 pk; pk[0] = cvt_pk_bf16(o[0], o[1]); pk[1] = cvt_pk_bf16(o[2], o[3]);
                __builtin_nontemporal_store(pk, (u32x2*)(H + (size_t)(r0 + t) * D + 256 * j + 4 * lane));
                if (r0 < NTOK) __builtin_nontemporal_store(pack_fp8x4(o[0] * FP8_SHI, o[1] * FP8_SHI, o[2] * FP8_SHI, o[3] * FP8_SHI), (unsigned*)(H8 + (size_t)(r0 + t) * D + 256 * j + 4 * lane)); } }
    }
}

namespace at3 {
constexpr int PT = 72;
constexpr int O_K = 0, O_V = O_K + 2 * 64 * PT * 2, O_RP = O_V + 2 * 64 * PT * 2, O_END = O_RP + 8 * 15 * 31 * 4;
static_assert(O_END <= LDS_BARW, "attention LDS");
}
__device__ __forceinline__ f32x16 mfma32(const bf16x8 a, const bf16x8 b, const f32x16 c) { return __builtin_amdgcn_mfma_f32_32x32x16_bf16(a, b, c, 0, 0, 0); }
__device__ __forceinline__ void phase_attn(const Frame& F) {
    using namespace at3;
    constexpr float LOG2E = 1.4426950408889634f, SC = 0.125f * LOG2E;
    LAS bf16_t* Ks = (LAS bf16_t*)(F.lds + O_K); LAS bf16_t* Vs = (LAS bf16_t*)(F.lds + O_V); LAS float* rp = (LAS float*)(F.lds + O_RP);
    __syncthreads();
    { float rv[8];
#pragma unroll
      for (int r = 0; r < 8; ++r) { const int i = F.tid() + 512 * r; rv[r] = (i < 8 * 15 * 31) ? F.rpb()[i] : 0.f; }
#pragma unroll
      for (int r = 0; r < 8; ++r) { const int i = F.tid() + 512 * r; if (i < 8 * 15 * 31) rp[i] = rv[r] * LOG2E; } }
    const bf16_t* PL = WSP(bf16_t, WS_PLAT); const bf16_t* PCx = WSP(bf16_t, WS_PCTX); const bf16_t* VTL = WSP(bf16_t, WS_VTL); const bf16_t* VTC = WSP(bf16_t, WS_VTC);
    bf16_t* OC = WSP(bf16_t, WS_ONA);
    const int tid = F.tid(), lane = F.lane(), w = F.wave, l31 = lane & 31, h5 = lane >> 5, ch = w & 1, qc = 32 * ch + l31;
    const int srow = tid >> 3, sc16 = tid & 7;
    unsigned mbits = 0u; { const int cs = min(max(qc - 8, 0), 48);
#pragma unroll
        for (int kh = 0; kh < 2; ++kh)
#pragma unroll
            for (int i = 0; i < 16; ++i) { const int kc = 32 * kh + (i & 3) + 8 * (i >> 2) + 4 * h5; if (kc >= cs && kc < cs + 16) mbits |= 1u << (16 * kh + i); } }
    const int dcl = 4 * h5 - qc + 15;
    const int vcu = (F.G % 8 == 0) ? (F.blk % 8) * (F.G / 8) + F.blk / 8 : F.blk;
    int pass_ = 0;
    for (int idx = vcu; idx < NB * 8 * 8; idx += F.G, ++pass_) {
        const int rq = (idx + ((F.G % 8 == 0) ? pass_ : 0)) & 7, h = (idx >> 3) & 7, b = idx >> 6, r0 = 4 * rq, r = r0 + (w >> 1);
        const int rs = min(max(r - 4, 0), 24), kr_lo = min(max(r0 - 4, 0), 24), kr_hi = min(max(r0 - 1, 0), 24) + 7, ntile = 4 + (kr_hi - kr_lo + 1);
        const int qtok = b * SEQ + r * 64 + qc;
#define AT3_LOAD(t_, kreg, vreg) do { const bf16_t* kp_; const bf16_t* vp_; \
        if ((t_) < 4) { kp_ = PCx + (size_t)(b * CTXL + 64 * (t_) + srow) * LDPC + PC_NAK + 64 * h + 8 * sc16; vp_ = VTC + ((size_t)(b * 8 + h) * 64 + srow) * CTXL + 64 * (t_) + 8 * sc16; } \
        else { const int kr_ = kr_lo + (t_) - 4; kp_ = PL + (size_t)(b * SEQ + kr_ * 64 + srow) * LDP + PC_NAK + 64 * h + 8 * sc16; vp_ = VTL + ((size_t)(b * 8 + h) * 64 + srow) * SEQ + kr_ * 64 + 8 * sc16; } \
        asm volatile("global_load_dwordx4 %0, %1, off" : "=&v"(kreg) : "v"(kp_) : "memory"); asm volatile("global_load_dwordx4 %0, %1, off" : "=&v"(vreg) : "v"(vp_) : "memory"); } while (0)
#define AT3_WAIT(n, kreg, vreg) asm volatile("s_waitcnt vmcnt(" #n ")" : "+v"(kreg), "+v"(vreg) :: "memory")
        u32x4 kA, vA, kB, vB;
        AT3_LOAD(0, kA, vA);
        AT3_LOAD(1, kB, vB);
        bf16x8 qf[4];
#pragma unroll
        for (int ks = 0; ks < 4; ++ks) qf[ks] = __builtin_bit_cast(bf16x8, *(const u32x4*)(PL + (size_t)qtok * LDP + PC_NAQ + 64 * h + 16 * ks + 8 * h5));
#pragma unroll
        for (int ks = 0; ks < 4; ++ks) { const u32x4 qr = __builtin_bit_cast(u32x4, qf[ks]);
            union { bf16x8 v; unsigned u[4]; } qs;
#pragma unroll
            for (int z = 0; z < 4; ++z) qs.u[z] = cvt_pk_bf16(bf_lo(qr[z]) * SC, bf_hi(qr[z]) * SC);
            qf[ks] = qs.v; }
        f32x16 o[2];
#pragma unroll
        for (int dt = 0; dt < 2; ++dt)
#pragma unroll
            for (int i = 0; i < 16; ++i) o[dt][i] = 0.f;
        float m = -3.0e38f, ls = 0.f;
#define AT3_TILE(NEED, LOCAL) do { \
                f32x16 sa[2]; _Pragma("unroll") for (int kh = 0; kh < 2; ++kh) _Pragma("unroll") for (int i = 0; i < 16; ++i) sa[kh][i] = 0.f; \
                _Pragma("unroll") for (int ks = 0; ks < 4; ++ks) _Pragma("unroll") for (int kh = 0; kh < 2; ++kh)     \
                    sa[kh] = mfma32(*(const LAS bf16x8*)(Kb + (32 * kh + l31) * PT + 16 * ks + 8 * h5), qf[ks], sa[kh]); \
                f32x2 v2[2][8]; float mx = -3.0e38f; f32x2 bs2[2][8]; \
                if (LOCAL) { _Pragma("unroll") for (int kh = 0; kh < 2; ++kh) _Pragma("unroll") for (int z = 0; z < 8; ++z) if (NEED(kh, z >> 1)) {     \
                    bs2[kh][z][0] = rph[32 * kh + 2 * (z & 1) + 8 * (z >> 1)]; bs2[kh][z][1] = rph[32 * kh + 2 * (z & 1) + 1 + 8 * (z >> 1)]; } } \
                _Pragma("unroll") for (int kh = 0; kh < 2; ++kh) _Pragma("unroll") for (int z = 0; z < 8; ++z) { if (NEED(kh, z >> 1)) { float s0 = sa[kh][2 * z], s1 = sa[kh][2 * z + 1]; \
                    if (LOCAL) { s0 += bs2[kh][z][0]; s1 += bs2[kh][z][1]; s0 = ((mbits >> (16 * kh + 2 * z)) & 1u) ? s0 : -1.0e30f; s1 = ((mbits >> (16 * kh + 2 * z + 1)) & 1u) ? s1 : -1.0e30f; } \
                    v2[kh][z] = (f32x2){s0, s1}; mx = fmaxf(mx, fmaxf(s0, s1)); } else v2[kh][z] = (f32x2){0.f, 0.f}; } \
                if (__any(mx > m)) { mx = fmaxf(mx, __shfl_xor(mx, 32)); const float mn = fmaxf(m, mx), al = __builtin_amdgcn_exp2f(m - mn); ls *= al; m = mn;     \
                    _Pragma("unroll") for (int dt = 0; dt < 2; ++dt) _Pragma("unroll") for (int i = 0; i < 16; ++i) o[dt][i] *= al; } \
                f32x2 ps2 = (f32x2){0.f, 0.f}; const f32x2 m2 = (f32x2){m, m}; \
                _Pragma("unroll") for (int kh = 0; kh < 2; ++kh) _Pragma("unroll") for (int z = 0; z < 8; ++z) if (NEED(kh, z >> 1)) { const f32x2 d = v2[kh][z] - m2; \
                    v2[kh][z][0] = __builtin_amdgcn_exp2f(d[0]); v2[kh][z][1] = __builtin_amdgcn_exp2f(d[1]); ps2 += v2[kh][z]; } \
                ls += ps2[0] + ps2[1]; \
                _Pragma("unroll") for (int kh = 0; kh < 2; ++kh) _Pragma("unroll") for (int s2 = 0; s2 < 2; ++s2) if (NEED(kh, 2 * s2) || NEED(kh, 2 * s2 + 1)) { \
                    union { bf16x8 v; unsigned u[4]; } pf; \
                    _Pragma("unroll") for (int z = 0; z < 4; ++z) pf.u[z] = cvt_pk_bf16(v2[kh][4 * s2 + z][0], v2[kh][4 * s2 + z][1]); \
                    _Pragma("unroll") for (int dt = 0; dt < 2; ++dt) { union { bf16x8 v; u32x2 u[2]; } vf; \
                        vf.u[0] = *(const LAS u32x2*)(Vb + (32 * dt + l31) * PT + 32 * kh + 16 * s2 + 4 * h5); vf.u[1] = *(const LAS u32x2*)(Vb + (32 * dt + l31) * PT + 32 * kh + 16 * s2 + 8 + 4 * h5); \
                        o[dt] = mfma32(vf.v, pf.v, o[dt]); } } } while (0)
#define AT3_ALL(kh, jg) true
#define AT3_N0(kh, jg) ((kh) == 0 || (jg) == 0)
#define AT3_N1(kh, jg) ((kh) == 1 || (jg) == 3)
#define AT3_STEP(t, kw, vw) do { \
            const LAS bf16_t* Kb = Ks + ((t) & 1) * 64 * PT; const LAS bf16_t* Vb = Vs + ((t) & 1) * 64 * PT; \
            const bool loc = (t) >= 4; const int kr = kr_lo + (t) - 4; \
            if (!loc) { const LAS float* rph = rp; AT3_TILE(AT3_ALL, false); } \
            else if (kr >= rs && kr < rs + 8) { \
                const LAS float* rph = rp + (h * 15 + (kr - r + 7)) * 31 + dcl; \
                if (ch == 0) AT3_TILE(AT3_N0, true); else AT3_TILE(AT3_N1, true); \
            } \
            if ((t) + 1 < ntile) { LAS bf16_t* Kn = Ks + (((t) + 1) & 1) * 64 * PT; LAS bf16_t* Vn = Vs + (((t) + 1) & 1) * 64 * PT; \
                AT3_WAIT(2, kw, vw); *(LAS u32x4*)(Kn + srow * PT + 8 * sc16) = kw; *(LAS u32x4*)(Vn + srow * PT + 8 * sc16) = vw; } \
            { const int tn_ = min((t) + 3, ntile - 1); AT3_LOAD(tn_, kw, vw); }     \
            __syncthreads(); } while (0)
        __syncthreads();
        AT3_WAIT(2, kA, vA); *(LAS u32x4*)(Ks + srow * PT + 8 * sc16) = kA; *(LAS u32x4*)(Vs + srow * PT + 8 * sc16) = vA;
        AT3_LOAD(2, kA, vA);
        __syncthreads();
        for (int t = 0;;) {
            AT3_STEP(t, kB, vB);
            if (t + 1 >= ntile) break;
            AT3_STEP(t + 1, kA, vA);
            t += 2; if (t >= ntile) break;
        }
#undef AT3_STEP
#undef AT3_TILE
#undef AT3_ALL
#undef AT3_N0
#undef AT3_N1
#undef AT3_LOAD
#undef AT3_WAIT
        asm volatile("s_waitcnt vmcnt(0)" ::: "memory");
        ls += __shfl_xor(ls, 32); const float inv = __builtin_amdgcn_rcpf(ls);
#pragma unroll
        for (int dt = 0; dt < 2; ++dt)
#pragma unroll
            for (int jj = 0; jj < 4; ++jj) { u32x2 pk; pk[0] = cvt_pk_bf16(o[dt][4 * jj] * inv, o[dt][4 * jj + 1] * inv); pk[1] = cvt_pk_bf16(o[dt][4 * jj + 2] * inv, o[dt][4 * jj + 3] * inv);
                *(u32x2*)(OC + (size_t)qtok * 1024 + 64 * h + 32 * dt + 8 * jj + 4 * h5) = pk; }
    }
}

namespace ml {
constexpr int PT = 72;
constexpr int NPOS = 36 * 64;
constexpr int A_KW = 0, A_VT = A_KW + 2 * 64 * PT * 2, A_A = A_VT + 2 * 128 * PT * 2;
constexpr int A_M = A_A + NPOS * 4, A_WI = A_M + NPOS * 4, A_FL = A_WI + NPOS * 4, A_WS = A_FL + NPOS * 4, A_B = A_WS + NPOS * 4, A_PM = A_B + NPOS * 4;
constexpr int A_N = A_PM + NPOS * 4;
constexpr int A_MC = A_N + 256;
constexpr int A_END = A_MC + 1024;
static_assert(A_END <= LDS_BARW, "mlstm pass A LDS");
constexpr int B_K = 0, B_VT = B_K + 64 * PT * 2, B_CF = B_VT + 128 * PT * 2, B_CB = B_CF + 144 * PT * 2, B_SLOT = B_CB + 144 * PT * 2;
static_assert(2 * B_SLOT <= LDS_BARW, "mlstm pass B LDS");
constexpr int CT_ROWS = 132, CT_STRIDE = CT_ROWS * 64;
}
constexpr size_t DO_CT = 0;

__device__ __forceinline__ void phase_mlstm_states(const Frame& F) {
    using namespace ml;
    LAS unsigned char* L = F.lds;
    LAS bf16_t* Kw = (LAS bf16_t*)(L + A_KW); LAS bf16_t* Vt = (LAS bf16_t*)(L + A_VT);
    LAS float* Aa = (LAS float*)(L + A_A); LAS float* Mm = (LAS float*)(L + A_M); LAS float* Wi = (LAS float*)(L + A_WI); LAS float* Fl = (LAS float*)(L + A_FL);
    LAS float* Ws = (LAS float*)(L + A_WS); LAS float* Bb = (LAS float*)(L + A_B); LAS float* Pm = (LAS float*)(L + A_PM);
    LAS float* nS = (LAS float*)(L + A_N); LAS float* mc = (LAS float*)(L + A_MC);
    const float* gates = WSP(float, WS_GATES); float* PP = WSP(float, WS_LTOK);
    const bf16_t* MKT = (const bf16_t*)((const char*)F.out() + DO_MKT); const bf16_t* MKTC = (const bf16_t*)((const char*)F.out() + DO_MKTC);
    const bf16_t* MVT = (const bf16_t*)((const char*)F.out() + DO_MVT); const bf16_t* MVTC = (const bf16_t*)((const char*)F.out() + DO_MVTC);
    bf16_t* CT = (bf16_t*)((char*)F.out() + DO_CT);
    const int tid = F.tid(), lane = F.lane(), w = F.wave, l31 = lane & 31, lh = lane >> 5;
    for (int task = F.blk; task < NB * 4 * 2; task += F.G) {
        const int dir = task & 1, h = (task >> 1) & 3, b = task >> 3;
        __syncthreads();
        const float bi = F.b_gates()[(2 * dir) * 4 + h], bfg = F.b_gates()[(2 * dir + 1) * 4 + h];
        float gri[5], grf[5];
#pragma unroll
        for (int q = 0; q < 5; ++q) { const int ci = min(w + 8 * q, 35); int grow;
            if (ci < 4) grow = NTOK + b * CTXL + 64 * (dir ? 3 - ci : ci) + (dir ? 63 - lane : lane);
            else grow = b * SEQ + 64 * (dir ? 31 - (ci - 4) : (ci - 4)) + (dir ? 63 - lane : lane);
            gri[q] = gates[(size_t)grow * 16 + (2 * dir) * 4 + h]; grf[q] = gates[(size_t)grow * 16 + (2 * dir + 1) * 4 + h]; }
#pragma unroll
        for (int q = 0; q < 5; ++q) { const int ci = w + 8 * q; if (ci >= 36) break;
            const float ri = gri[q] + bi, rf = grf[q] + bfg;
            const float li = 15.f * tanhf(ri * (1.f / 15.f)), gf = 15.f * tanhf(rf * (1.f / 15.f));
            const float lf = fminf(gf, 0.f) - log1pf(__expf(-fabsf(gf)));
            float bc = lf;
#pragma unroll
            for (int o = 1; o < 64; o <<= 1) { const float t = __shfl_up(bc, o); if (lane >= o) bc += t; }
            const float a = li - bc; float pm = a;
#pragma unroll
            for (int o = 1; o < 64; o <<= 1) { const float t = __shfl_up(pm, o); if (lane >= o) pm = fmaxf(pm, t); }
            Aa[ci * 64 + lane] = a; Bb[ci * 64 + lane] = bc; Pm[ci * 64 + lane] = pm;
            if (lane == 63) { mc[64 + ci] = bc; mc[128 + ci] = bc + pm; }
        }
        for (int i = tid; i < 64; i += 512) nS[i] = 0.f;
        __syncthreads();
        if (tid == 0) { float m = 0.f; mc[0] = 0.f; for (int ci = 0; ci < 36; ++ci) { const float mn = fmaxf(mc[64 + ci] + m, mc[128 + ci]); mc[192 + ci] = __expf(mc[64 + ci] + m - mn); m = mn; mc[ci + 1] = m; } }
        __syncthreads();
        float* pp = PP + (size_t)((b * 4 + h) * 2 + dir) * 4 * SEQ;
        for (int p = tid; p < NPOS; p += 512) { const int ci = p >> 6, sp = p & 63; const float m0 = mc[ci], m1 = mc[ci + 1], bL = mc[64 + ci];
            const float M = fmaxf(m0, Pm[p]), wi = __expf(m0 - M), fl = __expf(-(Bb[p] + M)); Ws[p] = __expf(bL + Aa[p] - m1);
            if (ci >= 4) { const int cj = dir ? 31 - (ci - 4) : ci - 4, tk = 64 * cj + (dir ? 63 - sp : sp);
                pp[tk] = Aa[p]; pp[SEQ + tk] = M; pp[2 * SEQ + tk] = wi; pp[3 * SEQ + tk] = fl; } }
        __syncthreads();
        f32x16 cacc;
#pragma unroll
        for (int i = 0; i < 16; ++i) cacc[i] = 0.f;
        const int kd = tid >> 3, kj = tid & 7;
        const int ve = tid >> 2, vj = tid & 3;
        const int tm = w >> 2, te = w & 3;
#define MLA_SRC(c, kp, vp) do { if ((c) < 4) { const int tb_ = 64 * (dir ? 3 - (c) : (c)); kp = MKTC + ((size_t)(b * 4 + h) * 64 + kd) * CTXL + tb_ + 8 * kj; vp = MVTC + ((size_t)(b * 4 + h) * 128 + ve) * CTXL + tb_ + 16 * vj; } \
        else { const int tb_ = 64 * (dir ? 31 - ((c) - 4) : (c) - 4); kp = MKT + ((size_t)(b * 4 + h) * 64 + kd) * SEQ + tb_ + 8 * kj; vp = MVT + ((size_t)(b * 4 + h) * 128 + ve) * SEQ + tb_ + 16 * vj; } } while (0)
        u32x4 kr, v0, v1, kr2, v02, v12;
        { const bf16_t* kp; const bf16_t* vp; MLA_SRC(0, kp, vp); kr = __builtin_nontemporal_load((const u32x4*)kp); v0 = __builtin_nontemporal_load((const u32x4*)vp); v1 = __builtin_nontemporal_load((const u32x4*)(vp + 8));
          MLA_SRC(1, kp, vp); kr2 = __builtin_nontemporal_load((const u32x4*)kp); v02 = __builtin_nontemporal_load((const u32x4*)vp); v12 = __builtin_nontemporal_load((const u32x4*)(vp + 8)); }
        for (int ci = 0; ci < 36; ++ci) {
            LAS bf16_t* Kwb = Kw + (ci & 1) * 64 * PT; LAS bf16_t* Vtb = Vt + (ci & 1) * 128 * PT;
            {
                u32x4 kp4;
#pragma unroll
                for (int q = 0; q < 4; ++q) { const int j0 = 8 * kj + 2 * q; const float w0 = Ws[ci * 64 + (dir ? 63 - j0 : j0)], w1 = Ws[ci * 64 + (dir ? 62 - j0 : j0 + 1)];
                    kp4[q] = cvt_pk_bf16(bf_lo(kr[q]) * w0, bf_hi(kr[q]) * w1); }
                *(LAS u32x4*)(Kwb + kd * PT + 8 * kj) = kp4;
                *(LAS u32x4*)(Vtb + ve * PT + 16 * vj) = v0; *(LAS u32x4*)(Vtb + ve * PT + 16 * vj + 8) = v1;
            }
            kr = kr2; v0 = v02; v1 = v12;
            if (ci + 2 < 36) { const bf16_t* kp; const bf16_t* vp; MLA_SRC(ci + 2, kp, vp); kr2 = __builtin_nontemporal_load((const u32x4*)kp); v02 = __builtin_nontemporal_load((const u32x4*)vp); v12 = __builtin_nontemporal_load((const u32x4*)(vp + 8)); }
            __syncthreads();
            if (ci >= 4) {
                const int cj = dir ? 31 - (ci - 4) : ci - 4; bf16_t* cg = CT + ((size_t)(((b * 4 + h) * 2 + dir) * 32 + cj)) * CT_STRIDE;
#pragma unroll
                for (int j = 0; j < 4; ++j) { u32x2 pk; pk[0] = cvt_pk_bf16(cacc[4 * j], cacc[4 * j + 1]); pk[1] = cvt_pk_bf16(cacc[4 * j + 2], cacc[4 * j + 3]);
                    *(u32x2*)(cg + (size_t)(32 * te + l31) * 64 + 32 * tm + 8 * j + 4 * lh) = pk; }
                if (w == 0) cg[128 * 64 + lane] = f2bf(nS[lane]);
            }
            {
                const float wc = mc[192 + ci];
#pragma unroll
                for (int i = 0; i < 16; ++i) cacc[i] *= wc;
#pragma unroll
                for (int ks = 0; ks < 4; ++ks) { const bf16x8 a = *(const LAS bf16x8*)(Kwb + (32 * tm + l31) * PT + 16 * ks + 8 * lh), bq = *(const LAS bf16x8*)(Vtb + (32 * te + l31) * PT + 16 * ks + 8 * lh);
                    cacc = mfma32(a, bq, cacc); }
                if (w == 0) { float kn = 0.f;
#pragma unroll
                    for (int q = 0; q < 8; ++q) { const u32x4 kv = *(const LAS u32x4*)(Kwb + lane * PT + 8 * q);
#pragma unroll
                        for (int z = 0; z < 4; ++z) kn += bf_lo(kv[z]) + bf_hi(kv[z]); }
                    nS[lane] = wc * nS[lane] + kn; }
            }
        }
#undef MLA_SRC
    }
}

__device__ __forceinline__ void phase_mlstm_out(const Frame& F) {
    using namespace ml;
    const bf16_t* PL = WSP(bf16_t, WS_PLAT); const float* PP = WSP(float, WS_LTOK); bf16_t* OC = WSP(bf16_t, WS_ONA) + 512;
    const bf16_t* MVT = (const bf16_t*)((const char*)F.out() + DO_MVT); const bf16_t* CT = (const bf16_t*)((const char*)F.out() + DO_CT);
    const int tid = F.tid(), lane = F.lane(), w = F.wave, slot = w >> 2, tt = w & 3, l15 = lane & 15, g = lane >> 4, t2 = tid & 255;
    LAS bf16_t* Ks = (LAS bf16_t*)(F.lds + slot * B_SLOT + B_K); LAS bf16_t* Vt = (LAS bf16_t*)(F.lds + slot * B_SLOT + B_VT);
    LAS bf16_t* Cf = (LAS bf16_t*)(F.lds + slot * B_SLOT + B_CF); LAS bf16_t* Cb = (LAS bf16_t*)(F.lds + slot * B_SLOT + B_CB);
    __syncthreads();
    for (int i = t2; i < 15 * PT / 2; i += 256) { ((LAS unsigned*)(Cf + 129 * PT))[i] = 0u; ((LAS unsigned*)(Cb + 129 * PT))[i] = 0u; }
    static_assert(2 * B_SLOT + 2048 <= LDS_BARW, "mlstm pass B LDS (head-norm gains)");
    LAS float* ghl = (LAS float*)(F.lds + 2 * B_SLOT);
    if (tid < 512) ghl[tid] = F.g_head()[tid];
    constexpr int NTASK = NB * 4 * 32;
    u32x4 rk[2], rv[4], rf[5], rb[5];
#define MLB_LOAD(task_) do { const int c_ = (task_) & 31, h_ = ((task_) >> 5) & 3, b_ = (task_) >> 7; \
        _Pragma("unroll") for (int i = 0; i < 2; ++i) { const int c = t2 + 256 * i; rk[i] = *(const u32x4*)(PL + (size_t)(b_ * SEQ + 64 * c_ + (c >> 3)) * LDP + PC_MLK + 64 * h_ + 8 * (c & 7)); } \
        _Pragma("unroll") for (int i = 0; i < 4; ++i) { const int c = t2 + 256 * i; rv[i] = __builtin_nontemporal_load((const u32x4*)(MVT + ((size_t)(b_ * 4 + h_) * 128 + (c >> 3)) * SEQ + 64 * c_ + 8 * (c & 7))); } \
        const bf16_t* cf_ = CT + (size_t)(((b_ * 4 + h_) * 2 + 0) * 32 + c_) * CT_STRIDE; const bf16_t* cb_ = cf_ + (size_t)32 * CT_STRIDE; \
        _Pragma("unroll") for (int i = 0; i < 5; ++i) { const int c = t2 + 256 * i; if (c < 129 * 8) { rf[i] = __builtin_nontemporal_load((const u32x4*)(cf_ + 8 * c)); rb[i] = __builtin_nontemporal_load((const u32x4*)(cb_ + 8 * c)); } } } while (0)
    int task = 2 * F.blk + slot;
    if (task < NTASK) MLB_LOAD(task);
    for (; task - slot < NTASK; task += 2 * F.G) {
        const bool live = task < NTASK;
        const int tkc = live ? task : NTASK - 1;
        const int cj = tkc & 31, h = (tkc >> 5) & 3, b = tkc >> 7;
        const int tokq = b * SEQ + 64 * cj + 16 * tt + l15;
        bf16x8 qf[2];
#pragma unroll
        for (int ks = 0; ks < 2; ++ks) qf[ks] = *(const bf16x8*)(PL + (size_t)tokq * LDP + PC_MLQ + 64 * h + 32 * ks + 8 * g);
        float Mq2[2], wiq2[2], flq2[2]; f32x4 av2[2][4]; u32x2 op2[8];
#pragma unroll
        for (int dir = 0; dir < 2; ++dir) { const float* pp = PP + (size_t)((b * 4 + h) * 2 + dir) * 4 * SEQ + 64 * cj;
            Mq2[dir] = pp[SEQ + 16 * tt + l15]; wiq2[dir] = pp[2 * SEQ + 16 * tt + l15]; flq2[dir] = pp[3 * SEQ + 16 * tt + l15];
#pragma unroll
            for (int st = 0; st < 4; ++st) av2[dir][st] = *(const f32x4*)(pp + 16 * st + 4 * g); }
#pragma unroll
        for (int et = 0; et < 8; ++et) op2[et] = *(const u32x2*)(PL + (size_t)tokq * LDP + PC_MLO + 128 * h + 16 * et + 4 * g);
        asm volatile("" ::: "memory");
        __syncthreads();
        if (live) {
#pragma unroll
            for (int i = 0; i < 2; ++i) { const int c = t2 + 256 * i; *(LAS u32x4*)(Ks + (c >> 3) * PT + 8 * (c & 7)) = rk[i]; }
#pragma unroll
            for (int i = 0; i < 4; ++i) { const int c = t2 + 256 * i; *(LAS u32x4*)(Vt + (c >> 3) * PT + 8 * (c & 7)) = rv[i]; }
#pragma unroll
            for (int i = 0; i < 5; ++i) { const int c = t2 + 256 * i; if (c < 129 * 8) { *(LAS u32x4*)(Cf + (c >> 3) * PT + 8 * (c & 7)) = rf[i]; *(LAS u32x4*)(Cb + (c >> 3) * PT + 8 * (c & 7)) = rb[i]; } }
        }
        { const int tn_ = (task + 2 * F.G < NTASK) ? task + 2 * F.G : tkc; MLB_LOAD(tn_); }
        asm volatile("" ::: "memory");
        __syncthreads();
        if (!live) continue;
        f32x4 raw[4];
#pragma unroll
        for (int st = 0; st < 4; ++st) { f32x4 acc = (f32x4){0.f, 0.f, 0.f, 0.f};
#pragma unroll
            for (int ks = 0; ks < 2; ++ks) acc = __builtin_amdgcn_mfma_f32_16x16x32_bf16(*(const LAS bf16x8*)(Ks + (16 * st + l15) * PT + 32 * ks + 8 * g), qf[ks], acc, 0, 0, 0);
            raw[st] = acc; }
        f32x4 hsum[8];
#pragma unroll
        for (int dir = 0; dir < 2; ++dir) {
            const float Mq = Mq2[dir], wiq = wiq2[dir], flq = flq2[dir];
            const LAS bf16_t* Cd = dir ? Cb : Cf;
            f32x4 o[9];
#pragma unroll
            for (int et = 0; et < 9; ++et) { f32x4 acc = (f32x4){0.f, 0.f, 0.f, 0.f};
#pragma unroll
                for (int ks = 0; ks < 2; ++ks) acc = __builtin_amdgcn_mfma_f32_16x16x32_bf16(*(const LAS bf16x8*)(Cd + (16 * et + l15) * PT + 32 * ks + 8 * g), qf[ks], acc, 0, 0, 0);
                o[et] = acc * wiq; }
            float dsum = 0.f;
#pragma unroll
            for (int pr = 0; pr < 2; ++pr) {
                float p[8];
#pragma unroll
                for (int z = 0; z < 2; ++z) { const int st = 2 * pr + z; const f32x4 av = av2[dir][st];
#pragma unroll
                    for (int i = 0; i < 4; ++i) { const int sk = 16 * st + 4 * g + i, tq = 16 * tt + l15; const bool ok = dir ? (sk >= tq) : (sk <= tq);
                        const float wgt = ok ? __expf(av[i] - Mq) : 0.f; p[4 * z + i] = raw[st][i] * wgt; dsum += p[4 * z + i]; } }
                union { bf16x8 v; unsigned u[4]; } pf;
                pf.u[0] = cvt_pk_bf16(p[0], p[1]); pf.u[1] = cvt_pk_bf16(p[2], p[3]); pf.u[2] = cvt_pk_bf16(p[4], p[5]); pf.u[3] = cvt_pk_bf16(p[6], p[7]);
#pragma unroll
                for (int et = 0; et < 8; ++et) { union { bf16x8 v; u32x2 u[2]; } vf;
                    vf.u[0] = *(const LAS u32x2*)(Vt + (16 * et + l15) * PT + 32 * pr + 4 * g); vf.u[1] = *(const LAS u32x2*)(Vt + (16 * et + l15) * PT + 32 * pr + 16 + 4 * g);
                    o[et] = __builtin_amdgcn_mfma_f32_16x16x32_bf16(vf.v, pf.v, o[et], 0, 0, 0); }
            }
            dsum += __shfl_xor(dsum, 16); dsum += __shfl_xor(dsum, 32);
            const float dint = __shfl(o[8][0], l15);
            const float inv = __builtin_amdgcn_rcpf(fmaxf(fabsf(dint + dsum), flq));
#pragma unroll
            for (int et = 0; et < 8; ++et) hsum[et] = dir ? hsum[et] + o[et] * inv : o[et] * inv;
        }
        float ss = 0.f;
#pragma unroll
        for (int et = 0; et < 8; ++et) ss += hsum[et][0] * hsum[et][0] + hsum[et][1] * hsum[et][1] + hsum[et][2] * hsum[et][2] + hsum[et][3] * hsum[et][3];
        ss += __shfl_xor(ss, 16); ss += __shfl_xor(ss, 32);
        const float rs = rsqrtf(ss * (1.f / 128.f) + EPS);
#pragma unroll
        for (int et = 0; et < 8; ++et) { const f32x4 gh = *(const LAS f32x4*)(ghl + 128 * h + 16 * et + 4 * g);
            const u32x2 op = op2[et];
            u32x2 pk; pk[0] = cvt_pk_bf16(sigmoidf_(bf_lo(op[0])) * hsum[et][0] * rs * gh[0], sigmoidf_(bf_hi(op[0])) * hsum[et][1] * rs * gh[1]);
            pk[1] = cvt_pk_bf16(sigmoidf_(bf_lo(op[1])) * hsum[et][2] * rs * gh[2], sigmoidf_(bf_hi(op[1])) * hsum[et][3] * rs * gh[3]);
            *(u32x2*)(OC + (size_t)tokq * 1024 + 128 * h + 16 * et + 4 * g) = pk; }
    }
#undef MLB_LOAD
}

__device__ __forceinline__ f32x4 ldg4(const void* ubase, unsigned voff) { return *(const f32x4*)((const char*)ubase + voff); }
__device__ __forceinline__ u32x2 ldg2(const void* ubase, unsigned voff) { return *(const u32x2*)((const char*)ubase + voff); }
__device__ __forceinline__ f32x4 ldg4_nt(const void* ubase, unsigned voff) { return __builtin_nontemporal_load((const f32x4*)((const char*)ubase + voff)); }
__device__ __forceinline__ u32x2 ldg2_nt(const void* ubase, unsigned voff) { return __builtin_nontemporal_load((const u32x2*)((const char*)ubase + voff)); }
__device__ __forceinline__ void compute_x1(const Frame& F, int row, int b, const float* modv, const bf16_t* Y, unsigned lo16, f32x4 (&x1)[4]) {
    const bf16_t* yr = Y + (size_t)row * D; const float* xr = F.x() + (size_t)row * D; const float* gtr = modv + (size_t)b * 6144 + 2048;
    float ss = 0.f; f32x4 y[4];
#pragma unroll
    for (int j = 0; j < 4; ++j) { const u32x2 yp = ldg2_nt(yr + 256 * j, lo16 >> 1); y[j] = (f32x4){bf_lo(yp[0]), bf_hi(yp[0]), bf_lo(yp[1]), bf_hi(yp[1])};
        ss += y[j][0] * y[j][0] + y[j][1] * y[j][1] + y[j][2] * y[j][2] + y[j][3] * y[j][3]; }
    ss = wave_sum(ss); const float rs = rsqrtf(ss * (1.f / D) + EPS);
#pragma unroll
    for (int j = 0; j < 4; ++j) { const f32x4 xv = ldg4_nt(xr + 256 * j, lo16), gp = ldg4(F.g_mix_post() + 256 * j, lo16), gt = ldg4(gtr + 256 * j, lo16);
        x1[j] = xv + gt * (y[j] * rs * gp); }
}

template <int N> __device__ __forceinline__ void bfly(float (&v)[32], int lane) {
    const bool up = (lane & N) != 0;
#pragma unroll
    for (int i = 0; i < N; ++i) { const float send = up ? v[i] : v[i + N], keep = up ? v[i + N] : v[i]; v[i] = keep + __shfl_xor(send, N); }
    if constexpr (N > 1) bfly<N / 2>(v, lane);
}
__device__ __forceinline__ void phase_postmix(const Frame& F) {
    LAS float* Wl = (LAS float*)F.lds;
    LAS int* asg_e = (LAS int*)(F.lds + LDS_MISC); LAS float* asg_w = (LAS float*)(F.lds + LDS_MISC + 4096);
    LAS int* lcnt = (LAS int*)(F.lds + LDS_MISC + 8192); LAS int* gbase = lcnt + 32; LAS int* rank = (LAS int*)(F.lds + LDS_MISC + 8192 + 256);
    const float* modv = WSP(float, WS_MODV); const bf16_t* Y = WSP(bf16_t, WS_Y); bf16_t* Y1 = WSP(bf16_t, WS_Y); unsigned char* H2 = WSP(unsigned char, WS_H2);
    int* ltok = WSP(int, WS_LTOK); float* lw = WSP(float, WS_LW); unsigned* gcnt = F.ctl() + CW_GCNT;
    __syncthreads();
    {
        f32x4 wq[16];
#pragma unroll
        for (int r = 0; r < 16; ++r) wq[r] = *(const f32x4*)(F.w_router() + 4 * (F.tid() + 512 * r));
#pragma unroll
        for (int r = 0; r < 16; ++r) { const int q = F.tid() + 512 * r, k = q >> 3, eg = q & 7; const int j = k >> 8, ln = (k & 255) >> 2, ii = k & 3;
            *(LAS f32x4*)(Wl + (((j * 4 + ii) * 8 + eg) * 64 + ln) * 4) = wq[r]; } }
    if (F.tid() < 32) lcnt[F.tid()] = 0;
    __syncthreads();
    const int lane = F.lane();
    float brq[4];
#pragma unroll
    for (int q = 0; q < 4; ++q) brq[q] = F.b_router()[q * 8 + (lane & 7)];
    for (int gb0 = 0; gb0 < NTOK / 32; gb0 += 8 * F.G) {
        for (int it = 0; it < 8; ++it) {
            const int grp = gb0 + it * F.G + F.blk;
            if (grp >= NTOK / 32) { if (lane < 16) asg_e[(it * 32 + F.wave * 4) * 4 + lane] = -1; continue; }
            const int rl0 = it * 32 + F.wave * 4, row0 = grp * 32 + F.wave * 4; const int b = row0 / SEQ;
            f32x4 hv[4][4];
            {
                unsigned lo16 = (unsigned)lane * 16u; asm volatile("" : "+v"(lo16));
                const float* cbv = WSP(float, WS_COMB) + (size_t)b * 4096;
                f32x4 cA[4], cB[4], cC[4]; u32x2 yv[4][4];
#pragma unroll
                for (int j = 0; j < 4; ++j) { cA[j] = ldg4(cbv + 256 * j, lo16); cB[j] = ldg4(cbv + 1024 + 256 * j, lo16); cC[j] = ldg4(cbv + 2048 + 256 * j, lo16); }
#pragma unroll
                for (int t = 0; t < 4; ++t)
#pragma unroll
                    for (int j = 0; j < 4; ++j) { yv[t][j] = ldg2_nt(Y + (size_t)(row0 + t) * D + 256 * j, lo16 >> 1); hv[t][j] = ldg4_nt(F.x() + (size_t)(row0 + t) * D + 256 * j, lo16); }
#pragma unroll
                for (int j = 0; j < 4; ++j) { asm volatile("" : "+v"(cA[j])); asm volatile("" : "+v"(cB[j])); asm volatile("" : "+v"(cC[j])); }
#pragma unroll
                for (int t = 0; t < 4; ++t)
#pragma unroll
                    for (int j = 0; j < 4; ++j) { asm volatile("" : "+v"(yv[t][j])); asm volatile("" : "+v"(hv[t][j])); }
#pragma unroll
                for (int t = 0; t < 4; ++t) {
                    f32x4 y[4]; float sy = 0.f;
#pragma unroll
                    for (int j = 0; j < 4; ++j) { y[j] = (f32x4){bf_lo(yv[t][j][0]), bf_hi(yv[t][j][0]), bf_lo(yv[t][j][1]), bf_hi(yv[t][j][1])};
                        sy += y[j][0] * y[j][0] + y[j][1] * y[j][1] + y[j][2] * y[j][2] + y[j][3] * y[j][3]; }
                    sy = wave_sum(sy); const float rsy = rsqrtf(sy * (1.f / D) + EPS);
                    float ss = 0.f;
#pragma unroll
                    for (int j = 0; j < 4; ++j) { const f32x4 x1 = hv[t][j] + cA[j] * (y[j] * rsy); hv[t][j] = x1;
                        ss += x1[0] * x1[0] + x1[1] * x1[1] + x1[2] * x1[2] + x1[3] * x1[3];
                        u32x2 xb; xb[0] = cvt_pk_bf16(x1[0], x1[1]); xb[1] = cvt_pk_bf16(x1[2], x1[3]);
                        *(u32x2*)((char*)(Y1 + (size_t)(row0 + t) * D + 256 * j) + (lo16 >> 1)) = xb; }
                    ss = wave_sum(ss); const float rs = rsqrtf(ss * (1.f / D) + EPS);
                    unsigned char* hr = H2 + (size_t)(row0 + t) * D;
#pragma unroll
                    for (int j = 0; j < 4; ++j) { hv[t][j] = hv[t][j] * rs * cB[j] + cC[j];
                        *(unsigned*)(hr + 256 * j + (lo16 >> 2)) = pack_fp8x4(hv[t][j][0] * FP8_SH, hv[t][j][1] * FP8_SH, hv[t][j][2] * FP8_SH, hv[t][j][3] * FP8_SH); } }
            }
            asm volatile("" ::: "memory");
            float Lq[4] = {0.f, 0.f, 0.f, 0.f};
#pragma unroll 1
            for (int qd = 0; qd < 4; ++qd) {
                f32x2 a2[16];
#pragma unroll
                for (int i = 0; i < 16; ++i) a2[i] = (f32x2){0.f, 0.f};
#pragma unroll
                for (int j = 0; j < 4; ++j)
#pragma unroll
                    for (int ii = 0; ii < 4; ii += 2)
#pragma unroll
                        for (int eg = 0; eg < 2; ++eg) {
                            const f32x4 w0 = *(const LAS f32x4*)(Wl + (((j * 4 + ii) * 8 + qd * 2 + eg) * 64 + lane) * 4), w1 = *(const LAS f32x4*)(Wl + (((j * 4 + ii + 1) * 8 + qd * 2 + eg) * 64 + lane) * 4);
                            const f32x2 w0a = (f32x2){w0[0], w0[1]}, w0b = (f32x2){w0[2], w0[3]}, w1a = (f32x2){w1[0], w1[1]}, w1b = (f32x2){w1[2], w1[3]};
#pragma unroll
                            for (int t = 0; t < 4; ++t) { const f32x2 hx = (f32x2){hv[t][j][ii], hv[t][j][ii + 1]};
                                asm("v_pk_fma_f32 %0, %1, %2, %0 op_sel_hi:[0,1,1]" : "+v"(a2[t * 4 + eg * 2]) : "v"(hx), "v"(w0a));
                                asm("v_pk_fma_f32 %0, %1, %2, %0 op_sel_hi:[0,1,1]" : "+v"(a2[t * 4 + eg * 2 + 1]) : "v"(hx), "v"(w0b));
                                asm("v_pk_fma_f32 %0, %1, %2, %0 op_sel:[1,0,0]" : "+v"(a2[t * 4 + eg * 2]) : "v"(hx), "v"(w1a));
                                asm("v_pk_fma_f32 %0, %1, %2, %0 op_sel:[1,0,0]" : "+v"(a2[t * 4 + eg * 2 + 1]) : "v"(hx), "v"(w1b)); } }
                float v[32];
#pragma unroll
                for (int i = 0; i < 16; ++i) { v[2 * i] = a2[i][0]; v[2 * i + 1] = a2[i][1]; }
                bfly<16>(v, lane);
                const float lg = v[0] + __shfl_xor(v[0], 32) + (qd == 0 ? brq[0] : qd == 1 ? brq[1] : qd == 2 ? brq[2] : brq[3]);
#pragma unroll
                for (int z = 0; z < 4; ++z) Lq[z] = (z == qd) ? lg : Lq[z];
            }
            float tv[4]; int tix[4];
#pragma unroll
            for (int k = 0; k < 4; ++k) {
                float bv = Lq[0]; int bi = (lane & 7);
#pragma unroll
                for (int qd = 1; qd < 4; ++qd) { if (Lq[qd] > bv) { bv = Lq[qd]; bi = qd * 8 + (lane & 7); } }
#pragma unroll
                for (int o = 1; o < 8; o <<= 1) { const float ov = __shfl_xor(bv, o); const int oi = __shfl_xor(bi, o); if (ov > bv || (ov == bv && oi < bi)) { bv = ov; bi = oi; } }
                tv[k] = bv; tix[k] = bi;
                if ((bi & 7) == (lane & 7)) {
#pragma unroll
                    for (int qd = 0; qd < 4; ++qd) if ((bi >> 3) == qd) Lq[qd] = -3.0e38f; }
            }
            const float e1 = __expf(tv[1] - tv[0]), e2 = __expf(tv[2] - tv[0]), e3 = __expf(tv[3] - tv[0]); const float inv = 1.f / (1.f + e1 + e2 + e3);
            const int kk = lane & 7;
            if (lane < 32 && kk < 4) { const int tq = lane >> 3; const float wk = (kk == 0 ? 1.f : kk == 1 ? e1 : kk == 2 ? e2 : e3) * inv; const int ek = (kk == 0 ? tix[0] : kk == 1 ? tix[1] : kk == 2 ? tix[2] : tix[3]);
                asg_e[(rl0 + tq) * 4 + kk] = ek; asg_w[(rl0 + tq) * 4 + kk] = wk; }
        }
        __syncthreads();
        for (int i = F.tid(); i < 1024; i += 512) { const int e = asg_e[i]; rank[i] = (e >= 0) ? atomicAdd((int*)&lcnt[e], 1) : 0; }
        __syncthreads();
        if (F.tid() < 32) { gbase[F.tid()] = (int)atomicAdd(&gcnt[F.tid()], (unsigned)lcnt[F.tid()]); lcnt[F.tid()] = 0; }
        __syncthreads();
        for (int i = F.tid(); i < 1024; i += 512) { const int e = asg_e[i]; if (e < 0) continue; const int pos = gbase[e] + rank[i];
            const int rl = i >> 2, tokn = (gb0 + (rl >> 5) * F.G + F.blk) * 32 + (rl & 31);
            ltok[(size_t)e * NTOK + pos] = tokn * 4 + (i & 3); lw[(size_t)e * NTOK + pos] = asg_w[i]; }
        __syncthreads();
    }
}

__device__ __forceinline__ int moe_table(const Frame& F, LAS int* tstart, LAS int* cnt) {
    __syncthreads();
    if (F.tid() == 0) { const unsigned* gcnt = F.ctl() + CW_GCNT; int acc = 0; for (int e = 0; e < NEXP; ++e) { const int n = (int)gcnt[e]; cnt[e] = n; tstart[e] = acc; acc += (n + 255) >> 8; } tstart[NEXP] = acc; }
    __syncthreads();
    { const int NT_ = tstart[NEXP];
      for (int T = F.tid(); T < NT_; T += 512) { int e = 0; for (int j = 1; j < NEXP; ++j) e = (T >= tstart[j]) ? j : e; tstart[pg8::MOE_TEXP + T] = e; } }
    __syncthreads();
    return __builtin_amdgcn_readfirstlane(tstart[NEXP]);
}

__device__ __forceinline__ void phase_final(const Frame& F) {
    const float* modv = WSP(float, WS_MODV); const bf16_t* Y = WSP(bf16_t, WS_Y); const unsigned char* Ys = WSP(unsigned char, WS_YS);
    const int lane = F.lane();
    for (int row0 = (F.blk * 8 + F.wave) * 2; row0 < NTOK; row0 += F.G * 16) {
        const int b = row0 / SEQ;
        const unsigned lo16 = (unsigned)lane * 16u;
        f32x4 gtv[4];
#pragma unroll
        for (int j = 0; j < 4; ++j) gtv[j] = *(const f32x4*)(WSP(float, WS_COMB) + (size_t)b * 4096 + 3072 + 256 * j + 4 * lane);
        int yp[2][4][4];
#pragma unroll
        for (int t = 0; t < 2; ++t)
#pragma unroll
            for (int j = 0; j < 4; ++j)
#pragma unroll
                for (int k = 0; k < 4; ++k) yp[t][j][k] = __builtin_nontemporal_load((const int*)(Ys + ((size_t)(row0 + t) * 4 + k) * D + 256 * j + 4 * lane));
        u32x2 x1b[2][4];
#pragma unroll
        for (int t = 0; t < 2; ++t)
#pragma unroll
            for (int j = 0; j < 4; ++j) x1b[t][j] = ldg2_nt(Y + (size_t)(row0 + t) * D + 256 * j, lo16 >> 1);
#pragma unroll
        for (int j = 0; j < 4; ++j) asm volatile("" : "+v"(gtv[j]));
#pragma unroll
        for (int t = 0; t < 2; ++t)
#pragma unroll
            for (int j = 0; j < 4; ++j) {
#pragma unroll
                for (int k = 0; k < 4; ++k) asm volatile("" : "+v"(yp[t][j][k]));
                asm volatile("" : "+v"(x1b[t][j])); }
#pragma unroll
        for (int t = 0; t < 2; ++t) {
            f32x4 f[4]; float ss = 0.f;
#pragma unroll
            for (int j = 0; j < 4; ++j) { f[j] = (f32x4){0.f, 0.f, 0.f, 0.f};
#pragma unroll
                for (int k = 0; k < 4; ++k) { const f32x2 a = __builtin_amdgcn_cvt_pk_f32_fp8(yp[t][j][k], false), c = __builtin_amdgcn_cvt_pk_f32_fp8(yp[t][j][k], true); f[j] += (f32x4){a[0], a[1], c[0], c[1]}; }
                f[j] *= (1.f / FP8_SY);
                ss += f[j][0] * f[j][0] + f[j][1] * f[j][1] + f[j][2] * f[j][2] + f[j][3] * f[j][3]; }
            ss = wave_sum(ss); const float rs = rsqrtf(ss * (1.f / D) + EPS);
#pragma unroll
            for (int j = 0; j < 4; ++j) { const int k = 256 * j + 4 * lane; const f32x4 gt = gtv[j];
                const f32x4 x1v = (f32x4){bf_lo(x1b[t][j][0]), bf_hi(x1b[t][j][0]), bf_lo(x1b[t][j][1]), bf_hi(x1b[t][j][1])};
                __builtin_nontemporal_store(x1v + gt * (f[j] * rs), (f32x4*)(F.out() + (size_t)(row0 + t) * D + k)); }
        }
    }
}

__device__ __forceinline__ void phase_g2(const Frame& F) {
        { pg8::InSched16 S; S.init(WSP(bf16_t, WS_H), WSP(bf16_t, WS_BTIN), NTOK, NT_IN16 * 256, 2 * D, F.G, F.blk);
          EpiInProj<false> E{WSP(bf16_t, WS_PLAT), LDP, WSP(bf16_t, WS_VTL), SEQ, WSP(float, WS_GATES), (LAS bf16_t*)(F.lds + LDS_MISC),
                      (bf16_t*)((char*)F.out() + DO_MKT), (bf16_t*)((char*)F.out() + DO_MVT), WSP(float, WS_ROPE), true};
          pg8::gemm_phase(F.lds, 2 * D, S, E); }
        { pg8::InSched8 S; S.init(WSP(unsigned char, WS_H8), WSP(unsigned char, WS_BTIN8), NTOK, NT_IN8 * 256, D, F.G, F.blk);
          EpiInProj<true> E{WSP(bf16_t, WS_PLAT), LDP, WSP(bf16_t, WS_VTL), SEQ, WSP(float, WS_GATES), (LAS bf16_t*)(F.lds + LDS_MISC),
                      (bf16_t*)((char*)F.out() + DO_MKT), (bf16_t*)((char*)F.out() + DO_MVT), WSP(float, WS_ROPE), true};
          pg8::gemm_phase<EpiInProj<true>, pg8::InSched8, true>(F.lds, D, S, E); }
        { pg8::PlainSched S; S.init(WSP(bf16_t, WS_H) + (size_t)NTOK * D, WSP(bf16_t, WS_BTIN), NCTX, 2048, 2 * D, F.G, F.blk);
          EpiInProj<false> E{WSP(bf16_t, WS_PCTX), LDPC, WSP(bf16_t, WS_VTC), CTXL, WSP(float, WS_GATES) + (size_t)NTOK * 16, (LAS bf16_t*)(F.lds + LDS_MISC),
                      (bf16_t*)((char*)F.out() + DO_MKTC), (bf16_t*)((char*)F.out() + DO_MVTC), WSP(float, WS_ROPE), false};
          pg8::gemm_phase(F.lds, 2 * D, S, E); }
    }
__device__ __forceinline__ void phase_g5(const Frame& F) {
        bf16_t* merged = (bf16_t*)F.out(); bf16_t* T = merged + (size_t)NTOK * D;
        pg8::MixSched S; S.O = (const char*)WSP(bf16_t, WS_ONA); S.Wbr = (const char*)WSP(bf16_t, WS_BTBR); S.M = (const char*)merged; S.Wout = (const char*)WSP(bf16_t, WS_BTOUT);
        S.Kb = 2 * D; S.nM = NTOK / 256; S.G = F.G; S.c = F.blk;
        EpiMix E{WSP(bf16_t, WS_PLAT), T + (size_t)F.blk * 65536, merged, WSP(bf16_t, WS_Y)};
        pg8::gemm_phase(F.lds, 2 * D, S, E);
    }
__device__ __forceinline__ void phase_g8(const Frame& F) {
        LAS int* tstart = (LAS int*)(F.lds + LDS_MISC); LAS int* cnt = tstart + 64; LAS int* rowtok = tstart + 128;
        const int NT = moe_table(F, tstart, cnt);
        pg8::MoeSchedG S; S.tstart = tstart; S.cnt = cnt; S.Abase = (const char*)WSP(unsigned char, WS_H2); S.Abase_hi = nullptr;
        S.Bbase = (const char*)WSP(unsigned char, WS_WGL); S.bstride = (size_t)2048 * D; S.Kb = D;
        S.deal(NT, 8, F.G, F.blk); S.ltok = WSP(int, WS_LTOK); S.rowtok = rowtok;
        LAS float* biasl = (LAS float*)(F.lds + LDS_MISC + 4096); S.bgate = F.b_gate(); S.blin = F.b_lin(); S.biasl = biasl;
        EpiSwiglu E{(unsigned char*)F.out(), WSP(unsigned char, WS_AHI), biasl};
        pg8::gemm_phase<EpiSwiglu, pg8::MoeSchedG, true>(F.lds, D, S, E);
    }
__device__ __forceinline__ void phase_g9(const Frame& F) {
        LAS int* tstart = (LAS int*)(F.lds + LDS_MISC); LAS int* cnt = tstart + 64;
        const int NT = moe_table(F, tstart, cnt);
        pg8::MoeSchedD S; S.tstart = tstart; S.cnt = cnt; S.Abase = (const char*)F.out(); S.Abase_hi = (const char*)WSP(unsigned char, WS_AHI);
        S.Bbase = (const char*)F.out() + DO_WD0; S.Bbase2 = (const char*)WSP(unsigned char, WS_WD1); S.bstride = (size_t)D * D; S.Kb = D;
        S.deal(NT, 4, F.G, F.blk);
        LAS unsigned* edl = (LAS unsigned*)(F.lds + LDS_MISC + 4096); S.ltok = WSP(int, WS_LTOK); S.lw = WSP(float, WS_LW); S.bdown = F.b_down(); S.edl = edl;
        EpiDown E{WSP(unsigned char, WS_YS), edl, cnt};
        pg8::gemm_phase<EpiDown, pg8::MoeSchedD, true>(F.lds, D, S, E);
    }
__global__ void __launch_bounds__(512, 2) fwd(Args args) {
    extern __shared__ __attribute__((aligned(16))) unsigned char lds_raw[];
    Frame F;
    F.lds = (LAS unsigned char*)lds_raw; F.wave = __builtin_amdgcn_readfirstlane(F.tid() >> 6); F.G = gridDim.x; F.blk = blockIdx.x; F.out_ = args.out; F.ws_ = args.ws;
    const int lo = args.ph_lo, hi = args.ph_hi;
    if (F.tid() < 4) ((LAS unsigned*)(F.lds + LDS_BARW))[F.tid()] = 0u;
    __syncthreads();
    XcdBarrier bar; bar.bar = F.ctl(); bar.x = 0; bar.st = nullptr;
    if (hi - lo > 1) bar = xcd_barrier_post(F.ctl(), (volatile LAS unsigned*)(F.lds + LDS_BARW));
#ifndef PH_MASK
#define PH_MASK 0x7ff
#endif
#define IN(k) (((PH_MASK >> (k)) & 1) && lo <= (k) && (k) < hi)
#define SEAM(k) do { if (IN(k) && IN((k) + 1)) xcd_barrier(bar); } while (0)
#ifndef REPEAT_MASK
#define REPEAT_MASK 0
#endif

#define REP(k) (((REPEAT_MASK) >> (k)) & 1)
    if (IN(0)) { phase_ada(F); if (IN(1)) { const XbTok tk = xcd_arrive(bar); phase_cvt_small(F); xcd_wait(bar, tk); } else phase_cvt_small(F); }
    if (IN(1)) { phase_norm1(F); if constexpr (REP(1)) { xcd_barrier(bar); phase_norm1(F); } }
    SEAM(1);
    if (IN(2)) { phase_g2(F); if constexpr (REP(2)) { xcd_barrier(bar); phase_g2(F); } }
    XbTok tk2; tk2.role = 0u; tk2.gen = 0u; tk2.tg = 0u;
    if (IN(2) && IN(3)) { tk2 = xcd_arrive(bar); phase_cvt_experts(F, NEXP * 256, NEXP * 320); xcd_wait(bar, tk2); }
    else if (IN(3)) phase_cvt_experts(F, NEXP * 256, NEXP * 320);
    if (IN(3)) {
        if ((F.blk & 1) == 0) phase_cvt_experts(F, 0, NEXP * 256);
        phase_mlstm_states(F);
        XbTok tk3; tk3.role = 0u; tk3.gen = 0u; tk3.tg = 0u;
        if (IN(4)) tk3 = xcd_arrive(bar);
        phase_attn(F);
        if ((F.blk & 1) != 0) phase_cvt_experts(F, 0, NEXP * 256);
        if (IN(4)) xcd_wait(bar, tk3);
    }
    if (IN(4)) { phase_mlstm_out(F); if constexpr (REP(4)) { xcd_barrier(bar); phase_mlstm_out(F); } }
    SEAM(4);
    if (IN(5)) { phase_g5(F); if constexpr (REP(5)) { xcd_barrier(bar); phase_g5(F); } }
    if (IN(5) && IN(7)) { const XbTok tk = xcd_arrive(bar); phase_cvt_experts(F, NEXP * 320, NEXP * 384); xcd_wait(bar, tk); phase_postmix(F); }
    else if (IN(7)) { phase_cvt_experts(F, NEXP * 320, NEXP * 384); phase_postmix(F); }
    SEAM(7);
    if (IN(8)) { phase_g8(F); if constexpr (REP(8)) { xcd_barrier(bar); phase_g8(F); } }
    SEAM(8);
    if (IN(9)) { phase_g9(F); if constexpr (REP(9)) { xcd_barrier(bar); phase_g9(F); } }
    SEAM(9);
    if (IN(10)) { phase_final(F); if constexpr (REP(10)) { xcd_barrier(bar); phase_final(F); } }
#undef IN
#undef SEAM
}

extern "C" void kernel_launch(void* const* d_in, const int* in_sizes, int n_in, void* d_out, int out_size, void* d_ws, size_t ws_size, hipStream_t stream) {
    static int grid = 0;
    if (grid == 0) {
        if (n_in != 25 || out_size != NTOK * D || ws_size < WS_END) { fprintf(stderr, "kernel_launch: unexpected shapes (n_in %d out %d ws %zu)\n", n_in, out_size, ws_size); grid = -1; return; }
        int dev = 0, cus = 0, per_cu = 0;
        if (hipGetDevice(&dev) != hipSuccess || hipDeviceGetAttribute(&cus, hipDeviceAttributeMultiprocessorCount, dev) != hipSuccess) { grid = -1; return; }
        if (hipFuncSetAttribute((const void*)fwd, hipFuncAttributeMaxDynamicSharedMemorySize, LDS_BYTES) != hipSuccess) { fprintf(stderr, "kernel_launch: hipFuncSetAttribute failed\n"); grid = -1; return; }
        if (hipOccupancyMaxActiveBlocksPerMultiprocessor(&per_cu, (const void*)fwd, 512, LDS_BYTES) != hipSuccess || per_cu < 1) fprintf(stderr, "kernel_launch: occupancy query says %d\n", per_cu);
        (void)hipGetLastError();
        grid = cus;
    }
    if (grid < 0) return;
    (void)hipMemsetAsync((char*)d_ws + WS_CTL, 0, CTL_ZERO_BYTES, stream);
    Args a{};
    for (int i = 0; i < 25; ++i) a.in[i] = (const float*)d_in[i];
    a.out = (float*)d_out; a.ws = (unsigned char*)d_ws;
#if MK_ONE_LAUNCH
    a.ph_lo = 0; a.ph_hi = NPHASE;
    hipLaunchKernelGGL(fwd, dim3(grid), dim3(512), LDS_BYTES, stream, a);
#else
    for (int p = 0; p < NPHASE; ++p) { a.ph_lo = p; a.ph_hi = p + 1; hipLaunchKernelGGL(fwd, dim3(grid), dim3(512), LDS_BYTES, stream, a); }
#endif
}
```

```cpp
#include <hip/hip_runtime.h>
#include <cstdio>
#include <cstdint>

#ifndef MK_ONE_LAUNCH
#define MK_ONE_LAUNCH 1
#endif

#define LAS __attribute__((address_space(3)))
typedef unsigned short bf16_t;
typedef short bf16x8 __attribute__((ext_vector_type(8)));
typedef float f32x4 __attribute__((ext_vector_type(4)));
typedef float f32x2 __attribute__((ext_vector_type(2)));
typedef float f32x16 __attribute__((ext_vector_type(16)));
typedef unsigned u32x4 __attribute__((ext_vector_type(4)));
typedef unsigned u32x2 __attribute__((ext_vector_type(2)));
typedef int i32x4 __attribute__((ext_vector_type(4)));
typedef int i32x8 __attribute__((ext_vector_type(8)));
typedef long i64x2 __attribute__((ext_vector_type(2)));

constexpr int D = 1024, NB = 32, SEQ = 2048, NTOK = NB * SEQ, CTXL = 256, NCTX = NB * CTXL;
constexpr int NEXP = 32, TOPK = 4;
constexpr int LDP = 5120, LDPC = 1792;
constexpr int PC_NAK = 0, PC_MLK = 1024, PC_MLV = 1280, PC_NAQ = 1792, PC_MLQ = 2304, PC_MLO = 2560, PC_GNA = 3072, PC_GML = 4096;
constexpr int N_IN = 5376;
constexpr int W_IN_COLS = 5136;
constexpr float EPS = 1e-6f;
constexpr int NPHASE = 11;
constexpr float FP8_SHI = 16.f;
constexpr int N_IN16 = 2816, N_IN8 = 2560;
#ifndef INCFG
#define INCFG 3
#endif
#if INCFG == 0
constexpr int NT_IN16 = 11, NT_IN8 = 10;
__device__ __forceinline__ int in_map16(int i) { return i; }
__device__ __forceinline__ int in_map8(int i) { return i + 11; }
__device__ __forceinline__ bool in_is8(int t) { return t >= 11; }
#elif INCFG == 1
constexpr int NT_IN16 = 7, NT_IN8 = 14;
__device__ __forceinline__ int in_map16(int i) { return i + (i >= 2 ? 2 : 0) + (i >= 3 ? 2 : 0); }
__device__ __forceinline__ int in_map8(int i) { return i + 2 + (i >= 2 ? 1 : 0) + (i >= 4 ? 4 : 0); }
__device__ __forceinline__ bool in_is8(int t) { return t >= 11 || t == 2 || t == 3 || t == 5 || t == 6; }
#elif INCFG == 3
constexpr int NT_IN16 = 3, NT_IN8 = 18;
__device__ __forceinline__ int in_map16(int i) { return 4 + 3 * i; }
__device__ __forceinline__ int in_map8(int i) { return i + (i >= 4 ? 1 : 0) + (i >= 6 ? 1 : 0) + (i >= 8 ? 1 : 0); }
__device__ __forceinline__ bool in_is8(int t) { return t != 4 && t != 7 && t != 10; }
#else
constexpr int NT_IN16 = 1, NT_IN8 = 20;
__device__ __forceinline__ int in_map16(int i) { return 7; }
__device__ __forceinline__ int in_map8(int i) { return i + (i >= 7 ? 1 : 0); }
__device__ __forceinline__ bool in_is8(int t) { return t != 7; }
#endif
constexpr float FP8_SG = 256.f;
constexpr float FP8_SY = 32.f;
constexpr float FP8_SW = 64.f, FP8_SH = 8.f, FP8_SA = 8.f;
constexpr int LDS_BYTES = 147456;
constexpr int LDS_MISC = 131072;
constexpr int LDS_BARW = LDS_BYTES - 16;

constexpr size_t MiB = (size_t)1 << 20;
constexpr size_t WS_CTL = 0, CTL_ZERO_BYTES = 65536;
constexpr size_t WS_MODV = 1 * MiB;
constexpr size_t WS_BTIN = 2 * MiB;
constexpr size_t WS_BTBR = 13 * MiB;
constexpr size_t WS_BTOUT = 15 * MiB;
constexpr size_t WS_GATES = 17 * MiB;
constexpr size_t WS_ROPE = 21 * MiB + 512 * 1024;
constexpr size_t WS_COMB = 22 * MiB;
constexpr size_t WS_LTOK = 24 * MiB;
constexpr size_t WS_LW = 32 * MiB;
constexpr size_t WS_H = 40 * MiB;
constexpr size_t WS_ONA = 40 * MiB;
constexpr size_t WS_Y = 40 * MiB;
constexpr size_t WS_PLAT = 184 * MiB;
constexpr size_t WS_PCTX = 824 * MiB;
constexpr size_t WS_VTL = 852 * MiB;
constexpr size_t WS_VTC = 916 * MiB;
constexpr size_t WS_H8 = 924 * MiB;
constexpr size_t WS_BTIN8 = 996 * MiB;
constexpr size_t DO_WD = 160 * MiB;
constexpr size_t WS_AHI = 232 * MiB;
constexpr size_t WS_YS = 504 * MiB;
constexpr size_t WS_H2 = 504 * MiB;
constexpr size_t WS_WGL = 924 * MiB;
constexpr size_t WS_END = 1020 * MiB;
constexpr size_t DO_MKT = 132 * MiB, DO_MKTC = 164 * MiB, DO_MVT = 168 * MiB, DO_MVTC = 232 * MiB;
constexpr int PA_HID = 1152;
constexpr int A_LO_ROWS = 131072;
constexpr int CW_GCNT = 4096;

__device__ __forceinline__ unsigned cvt_pk_bf16(float lo, float hi) { unsigned r; asm volatile("v_cvt_pk_bf16_f32 %0, %1, %2" : "=v"(r) : "v"(lo), "v"(hi)); return r; }
__device__ __forceinline__ bf16_t f2bf(float f) { return (bf16_t)(cvt_pk_bf16(f, 0.f) & 0xffffu); }
__device__ __forceinline__ float bf_lo(unsigned u) { return __uint_as_float(u << 16); }
__device__ __forceinline__ float bf_hi(unsigned u) { return __uint_as_float(u & 0xffff0000u); }
__device__ __forceinline__ float bf2f(bf16_t b) { return __uint_as_float(((unsigned)b) << 16); }
__device__ __forceinline__ unsigned pack_fp8x4(float a, float b, float c, float d) {
    a = __builtin_amdgcn_fmed3f(a, -448.f, 448.f); b = __builtin_amdgcn_fmed3f(b, -448.f, 448.f); c = __builtin_amdgcn_fmed3f(c, -448.f, 448.f); d = __builtin_amdgcn_fmed3f(d, -448.f, 448.f);
    unsigned p = 0u; p = __builtin_amdgcn_cvt_pk_fp8_f32(a, b, p, false); p = __builtin_amdgcn_cvt_pk_fp8_f32(c, d, p, true); return p;
}
template <int N> __device__ __forceinline__ float dpp_ror(float v) { return __builtin_bit_cast(float, __builtin_amdgcn_update_dpp(0, __builtin_bit_cast(int, v), 0x120 + N, 0xf, 0xf, false)); }
__device__ __forceinline__ float wave_sum(float v) {
    v += dpp_ror<8>(v); v += dpp_ror<4>(v); v += dpp_ror<2>(v); v += dpp_ror<1>(v);
    v += __shfl_xor(v, 16); v += __shfl_xor(v, 32);
    return v;
}
__device__ __forceinline__ float sigmoidf_(float x) { return __builtin_amdgcn_rcpf(1.f + __builtin_amdgcn_exp2f(x * -1.4426950408889634f)); }

#define XB_TMO      128
#define XB_XCNT(j)  (256  + 64 * (j))
#define XB_XSUB(j)  (1280 + 64 * (j))
#define XB_XGEN(j)  (2304 + 64 * (j))
#define XB_TOP      3328
#define XB_TOPGEN   3392
#define XCD_BAR_WORDS 3456
#define XB_SPIN_CAP (1u << 18)
__device__ __forceinline__ unsigned xb_ld(unsigned* p)              { return __hip_atomic_load(p, __ATOMIC_RELAXED, __HIP_MEMORY_SCOPE_AGENT); }
__device__ __forceinline__ unsigned xb_add(unsigned* p, unsigned v) { return __hip_atomic_fetch_add(p, v, __ATOMIC_RELAXED, __HIP_MEMORY_SCOPE_AGENT); }
__device__ __forceinline__ unsigned xb_xcc_id() { return (unsigned)__builtin_amdgcn_s_getreg((3 << 11) | 20) & 0xFu; }
#define XB_SPIN(cond, bar) do { unsigned _sp = 0; while (cond) { __builtin_amdgcn_s_sleep(1); \
    if ((++_sp & 255u) == 0u) { if (xb_ld(&(bar)[XB_TMO])) break; if (_sp > XB_SPIN_CAP) { atomicAdd(&(bar)[XB_TMO], 1u); break; } } } } while (0)
struct XcdBarrier { unsigned* bar; unsigned x; volatile LAS unsigned* st; };
__device__ __forceinline__ XcdBarrier xcd_barrier_post(unsigned* bar, volatile LAS unsigned* st) {
    XcdBarrier b; b.bar = bar; b.x = xb_xcc_id(); b.st = st;
    if (threadIdx.x == 0) (void)xb_add(&bar[XB_XCNT(b.x)], 1u);
    return b;
}
__device__ __forceinline__ void xcd_barrier_complete(unsigned* bar, unsigned x, unsigned& nloc, unsigned& nx) {
    const unsigned G = gridDim.x * gridDim.y * gridDim.z;
    unsigned sum, cnt, mine, sp = 0u;
    for (;;) {
        sum = 0u; cnt = 0u; mine = 0u;
#pragma unroll
        for (unsigned j = 0; j < 16; ++j) { const unsigned c = xb_ld(&bar[XB_XCNT(j)]); sum += c; cnt += (c > 0u) ? 1u : 0u; mine = (j == x) ? c : mine; }
        if (sum == G) break;
        __builtin_amdgcn_s_sleep(1);
        if ((++sp & 255u) == 0u) { if (xb_ld(&bar[XB_TMO])) break; if (sp > XB_SPIN_CAP) { atomicAdd(&bar[XB_TMO], 1u); break; } }
    }
    nloc = mine > 0u ? mine : 1u; nx = cnt > 0u ? cnt : 1u;
}
__device__ __forceinline__ void xcd_barrier(const XcdBarrier& b) {
    asm volatile("s_waitcnt vmcnt(0)" ::: "memory");
    __syncthreads();
    if (threadIdx.x == 0) {
        unsigned* bar = b.bar;
        __builtin_amdgcn_s_waitcnt(0);
        unsigned nloc = b.st[0], nx = b.st[1];
        if (nloc == 0u) { xcd_barrier_complete(bar, b.x, nloc, nx); b.st[0] = nloc; b.st[1] = nx; }
        const unsigned old = xb_add(&bar[XB_XSUB(b.x)], 1u);
        const unsigned gen = old / nloc;
        if (old + 1u == (gen + 1u) * nloc) {
            __builtin_amdgcn_fence(__ATOMIC_RELEASE, "agent");
            asm volatile("s_waitcnt vmcnt(0)" ::: "memory");
            const unsigned og = xb_add(&bar[XB_TOP], 1u);
            const unsigned tg = og / nx;
            if (og + 1u == (tg + 1u) * nx) xb_add(&bar[XB_TOPGEN], 1u);
            else XB_SPIN(xb_ld(&bar[XB_TOPGEN]) == tg, bar);
            __builtin_amdgcn_fence(__ATOMIC_ACQUIRE, "agent");
            asm volatile("s_waitcnt vmcnt(0)" ::: "memory");
        } else {
            XB_SPIN(xb_ld(&bar[XB_TOPGEN]) == gen, bar);
            __builtin_amdgcn_fence(__ATOMIC_ACQUIRE, "agent");
            asm volatile("s_waitcnt vmcnt(0)" ::: "memory");
        }
    }
    __syncthreads();
}

struct XbTok { unsigned role, gen, tg; };
__device__ __forceinline__ XbTok xcd_arrive(const XcdBarrier& b) {
    asm volatile("s_waitcnt vmcnt(0)" ::: "memory");
    __syncthreads();
    XbTok t; t.role = 0u; t.gen = 0u; t.tg = 0u;
    if (threadIdx.x == 0) {
        unsigned* bar = b.bar;
        __builtin_amdgcn_s_waitcnt(0);
        unsigned nloc = b.st[0], nx = b.st[1];
        if (nloc == 0u) { xcd_barrier_complete(bar, b.x, nloc, nx); b.st[0] = nloc; b.st[1] = nx; }
        const unsigned old = xb_add(&bar[XB_XSUB(b.x)], 1u);
        t.gen = old / nloc;
        if (old + 1u == (t.gen + 1u) * nloc) {
            __builtin_amdgcn_fence(__ATOMIC_RELEASE, "agent");
            asm volatile("s_waitcnt vmcnt(0)" ::: "memory");
            const unsigned og = xb_add(&bar[XB_TOP], 1u);
            t.tg = og / nx; t.role = 1u;
            if (og + 1u == (t.tg + 1u) * nx) { xb_add(&bar[XB_TOPGEN], 1u); t.role = 3u; }
        }
    }
    return t;
}
__device__ __forceinline__ void xcd_wait(const XcdBarrier& b, const XbTok& t) {
    if (threadIdx.x == 0) {
        unsigned* bar = b.bar;
        if (t.role != 0u) {
            if (t.role == 1u) XB_SPIN(xb_ld(&bar[XB_TOPGEN]) == t.tg, bar);
            __builtin_amdgcn_fence(__ATOMIC_ACQUIRE, "agent");
            asm volatile("s_waitcnt vmcnt(0)" ::: "memory");
        } else {
            XB_SPIN(xb_ld(&bar[XB_TOPGEN]) == t.gen, bar);
            __builtin_amdgcn_fence(__ATOMIC_ACQUIRE, "agent");
            asm volatile("s_waitcnt vmcnt(0)" ::: "memory");
        }
    }
    __syncthreads();
}

namespace pg8 {
constexpr int BM = 256, BK = 64, HALF = 128, HTB = HALF * BK * 2, STAGE_BYTES = 8 * HTB, NXCD = 8, WGM = 8;
__host__ __device__ __forceinline__ int lds_byte(int r, int c) { const int st = (r >> 4) * 2 + (c >> 5), rr = r & 15, cc = c & 31, ob = rr * 64 + cc * 2; return st * 1024 + (ob ^ (((ob >> 9) & 1) << 5)); }
__host__ __device__ __forceinline__ void stage_rc(int b, int& R, int& C) { const int st = b / 1024, sb = b % 1024, swz = sb ^ (((sb >> 9) & 1) << 5); R = (st >> 1) * 16 + swz / 64; C = (st & 1) * 32 + (swz % 64) / 2; }
__host__ __device__ __forceinline__ int perm32(int rho) { const int n = rho >> 4, i = rho & 15; return 8 * (i >> 2) + 4 * n + (i & 3); }

struct Unit { int pm, pn, e, tile, rb; };

struct PlainSched {
    static constexpr bool GATHER = false, ROWDMA = false, VARK = false;
    const void* A; const void* Bt; int Kb;
    int nM, nN, nwg, G, c;
    __device__ void init(const void* A_, const void* Bt_, int M, int N, int Kb_, int G_, int c_) { A = A_; Bt = Bt_; Kb = Kb_; nM = M / BM; nN = N / BM; nwg = nM * nN; G = G_; c = c_; }
    __device__ bool next(int i, Unit& u) const {
        const long L = (long)i * G + c; if (L >= nwg) return false;
        int wgid = (int)L; { const int q = nwg / NXCD, r = nwg % NXCD, xcd = wgid % NXCD, off = wgid / NXCD; wgid = (xcd < r ? xcd * (q + 1) : r * (q + 1) + (xcd - r) * q) + off; }
        const int nig = WGM * nN, gid = wgid / nig, fm = gid * WGM, gsz = (nM - fm) < WGM ? (nM - fm) : WGM;
        u.pm = fm + ((wgid % nig) % gsz); u.pn = (wgid % nig) / gsz; u.e = 0; u.tile = u.pm; u.rb = 0; return true;
    }
    __device__ __forceinline__ const char* a_ptr(const Unit& u) const { return (const char*)A + (size_t)u.pm * ((size_t)BM * Kb); }
    __device__ __forceinline__ const char* b_ptr(const Unit& u) const { return (const char*)Bt + (size_t)u.pn * ((size_t)BM * Kb); }
    __device__ __forceinline__ void a_offsets(const Unit&, unsigned (&v)[2][2]) const {
#pragma unroll
        for (int h = 0; h < 2; ++h)
#pragma unroll
            for (int i = 0; i < 2; ++i) { int R, C; stage_rc((int)threadIdx.x * 16 + i * 8192, R, C); v[h][i] = (unsigned)((R + HALF * h) * Kb + C * 2); }
    }
};

struct PlainSchedO : PlainSched {
    static constexpr bool GATHER = true, ROWDMA = false;
    __device__ __forceinline__ void a_offsets_h(const Unit&, int h, unsigned (&v)[2]) const {
#pragma unroll
        for (int i = 0; i < 2; ++i) { int R, C; stage_rc((int)threadIdx.x * 16 + i * 8192, R, C); unsigned o = (unsigned)((R + HALF * h) * Kb + C * 2); asm volatile("" : "+v"(o)); v[i] = o; }
    }
    __device__ __forceinline__ void a_offsets(const Unit& u, unsigned (&v)[2][2]) const { a_offsets_h(u, 0, v[0]); a_offsets_h(u, 1, v[1]); }
};
struct InSched16 : PlainSched {
    __device__ bool next(int i, Unit& u) const { if (!PlainSched::next(i, u)) return false; u.pn = in_map16(u.pn); return true; }
};
struct InSched8 : PlainSchedO {
    __device__ bool next(int i, Unit& u) const { if (!PlainSched::next(i, u)) return false; u.pn = in_map8(u.pn); return true; }
};
struct MixSched {
    static constexpr bool GATHER = false, ROWDMA = false, VARK = true;
    const char* O; const char* Wbr; const char* M; const char* Wout; int Kb, nM, G, c;
    __device__ bool next(int i, Unit& u) const {
        const int rt = i / 12, j = i - rt * 12, pm = c + rt * G; if (pm >= nM) return false;
        u.pm = pm; u.tile = pm; u.rb = 0;
        if (j < 8) { u.pn = j >> 1; u.e = j & 1; } else { u.pn = j - 8; u.e = 2; }
        return true;
    }
    __device__ __forceinline__ int nt(const Unit& u) const { return u.e == 2 ? 16 : 8; }
    __device__ __forceinline__ const char* a_ptr(const Unit& u) const { return (u.e == 2 ? M : O + u.e * 1024) + (size_t)u.pm * ((size_t)BM * 2048); }
    __device__ __forceinline__ const char* b_ptr(const Unit& u) const { return (u.e == 2 ? Wout : Wbr + u.e * 1024) + (size_t)u.pn * ((size_t)BM * 2048); }
    __device__ __forceinline__ void a_offsets(const Unit&, unsigned (&v)[2][2]) const {
#pragma unroll
        for (int h = 0; h < 2; ++h)
#pragma unroll
            for (int i = 0; i < 2; ++i) { int R, C; stage_rc((int)threadIdx.x * 16 + i * 8192, R, C); v[h][i] = (unsigned)((R + HALF * h) * 2048 + C * 2); }
    }
};
constexpr int MOE_TEXP = 2560;
struct MoeSched {
    static constexpr bool VARK = false;
    const LAS int* tstart;
    const LAS int* cnt;
    const char* Abase; const char* Abase_hi;
    const char* Bbase; size_t bstride;
    int Kb, T0, T1, slot, nslot, pn;
    __device__ void deal(int NT, int npn, int G, int blk) {
        const int X = (G % (8 * npn) == 0) ? 8 : 1, per = G / X, x = blk % X, c = blk / X;
        T0 = (int)((long)x * NT / X); T1 = (int)((long)(x + 1) * NT / X); pn = c % npn; slot = c / npn; nslot = per / npn;
    }
    __device__ bool next(int i, Unit& u) const {
        const int T = T0 + slot + nslot * i; if (T >= T1) return false;
        u.pn = pn; u.tile = T; u.rb = i & 1;
        const int e = __builtin_amdgcn_readfirstlane(tstart[MOE_TEXP + T]);
        u.e = e; u.pm = __builtin_amdgcn_readfirstlane(T - tstart[e]); return true;
    }
    __device__ __forceinline__ const char* b_ptr(const Unit& u) const { return Bbase + (size_t)u.e * bstride + (size_t)u.pn * ((size_t)BM * Kb); }
};
struct MoeSchedG : MoeSched {
    static constexpr bool GATHER = true, ROWDMA = true;
    const int* ltok; LAS int* rowtok;
    const float* bgate; const float* blin; LAS float* biasl;
    __device__ __forceinline__ const char* a_ptr(const Unit&) const { return Abase; }
    __device__ __forceinline__ void prefetch_rows(const Unit& u, int wid, int lane) const {
        if (wid < 4) __builtin_amdgcn_global_load_lds((const __attribute__((address_space(1))) unsigned*)(ltok + (size_t)u.e * NTOK + u.pm * BM + wid * 64) + lane, (LAS unsigned*)(rowtok + u.rb * BM + wid * 64), 4, 0, 0);
        else { const float* src = (wid < 6 ? bgate : blin) + (size_t)u.e * D + u.pn * 128 + (wid & 1) * 64;
            __builtin_amdgcn_global_load_lds((const __attribute__((address_space(1))) unsigned*)src + lane, (LAS unsigned*)(biasl + u.rb * 256 + (wid - 4) * 64), 4, 0, 0); }
    }
    __device__ __forceinline__ void a_offsets_h(const Unit& u, int h, unsigned (&v)[2]) const {
        const int n = cnt[u.e];
#pragma unroll
        for (int i = 0; i < 2; ++i) { int R, C; stage_rc((int)threadIdx.x * 16 + i * 8192, R, C); const int r = R + HALF * h; const int val = rowtok[u.rb * BM + r];
            const int tok = (u.pm * BM + r < n) ? (val >> 2) : 0; v[i] = (unsigned)(tok * Kb + C * 2); }
    }
    __device__ __forceinline__ void a_offsets(const Unit& u, unsigned (&v)[2][2]) const { a_offsets_h(u, 0, v[0]); a_offsets_h(u, 1, v[1]); }
};
struct MoeSchedD : MoeSched {
    static constexpr bool GATHER = true, ROWDMA = true;
    const int* ltok; const float* lw; const float* bdown; LAS unsigned* edl;
    __device__ __forceinline__ void prefetch_rows(const Unit& u, int wid, int lane) const {
        const size_t ro = (size_t)u.e * NTOK + u.pm * BM + (wid & 3) * 64;
        if (wid < 4) { __builtin_amdgcn_global_load_lds((const __attribute__((address_space(1))) unsigned*)(ltok + ro) + lane, edl + u.rb * 768 + wid * 64, 4, 0, 0);
            __builtin_amdgcn_global_load_lds((const __attribute__((address_space(1))) unsigned*)(bdown + (size_t)u.e * D + u.pn * 256 + wid * 64) + lane, edl + u.rb * 768 + 512 + wid * 64, 4, 0, 0); }
        else __builtin_amdgcn_global_load_lds((const __attribute__((address_space(1))) unsigned*)(lw + ro) + lane, edl + u.rb * 768 + 256 + (wid - 4) * 64, 4, 0, 0);
    }
    __device__ __forceinline__ const char* a_ptr(const Unit& u) const { const int r0 = __builtin_amdgcn_readfirstlane(u.tile) * BM; const bool lo_ = r0 < A_LO_ROWS;
        const char* base = lo_ ? Abase : Abase_hi; const int rr = lo_ ? r0 : r0 - A_LO_ROWS; return base + (size_t)rr * PA_HID; }
    __device__ __forceinline__ void a_offsets_h(const Unit&, int h, unsigned (&v)[2]) const {
#pragma unroll
        for (int i = 0; i < 2; ++i) { int R, C; stage_rc((int)threadIdx.x * 16 + i * 8192, R, C); unsigned o = (unsigned)((R + HALF * h) * PA_HID + C * 2); asm volatile("" : "+v"(o)); v[i] = o; }
    }
    __device__ __forceinline__ void a_offsets(const Unit& u, unsigned (&v)[2][2]) const { a_offsets_h(u, 0, v[0]); a_offsets_h(u, 1, v[1]); }
};

typedef f32x4 Acc[2][2][4][2];
template <class Epi, class Sched, bool FP8 = false>
__device__ __forceinline__ void gemm_phase(LAS unsigned char* lds, const int Kb, const Sched& S, const Epi& E) {
    const int tid = threadIdx.x, wid = __builtin_amdgcn_readfirstlane(tid >> 6), lane = tid & 63, wr = wid >> 2, wc = wid & 3, fr = lane & 15, fq = lane >> 4;
    const int nt = Kb / (BK * 2);
    unsigned voffB[2];
#pragma unroll
    for (int i = 0; i < 2; ++i) { int R, C; stage_rc(tid * 16 + i * 8192, R, C); const int Rb = (R & ~31) + perm32(R & 31);
        voffB[i] = (unsigned)(Rb * Kb + C * 2); }
    const size_t kstep = (size_t)(BK * 2);
    const size_t hstep = (size_t)HALF * Kb;
    const unsigned ldsw = (unsigned)wid * 1024u;
    const int aoff = lds_byte(wr * 64 + fr, fq * 8), boff = lds_byte(wc * 32 + fr, fq * 8);
#define PG8_SA(b, h) (((b) * 2 + (h)) * HTB)
#define PG8_SB(b, h) ((4 + (b) * 2 + (h)) * HTB)
#define PG8_GP(gbase, v) ((const __attribute__((address_space(1))) unsigned*)((const __attribute__((address_space(1))) char*)(gbase) + (v)))
#define PG8_STAGE(bufoff, gbase, voff) do { _Pragma("unroll") for (int _i = 0; _i < 2; ++_i) \
        __builtin_amdgcn_global_load_lds(PG8_GP(gbase, (voff)[_i]), (LAS unsigned*)(lds + (bufoff) + ldsw + _i * 8192), 16, 0, 0); } while (0)
#define PG8_STAGE2(bufoff, gbase, v0, v1) do { \
        __builtin_amdgcn_global_load_lds(PG8_GP(gbase, v0), (LAS unsigned*)(lds + (bufoff) + ldsw), 16, 0, 0); \
        __builtin_amdgcn_global_load_lds(PG8_GP(gbase, v1), (LAS unsigned*)(lds + (bufoff) + ldsw + 8192), 16, 0, 0); } while (0)
#define PG8_LDA(dst, b, h) do { _Pragma("unroll") for (int m = 0; m < 4; ++m) _Pragma("unroll") for (int k = 0; k < 2; ++k) dst[m][k] = *(const LAS bf16x8*)(lds + PG8_SA(b, h) + aoff + m * 2048 + k * 1024); } while (0)
#define PG8_LDB(dst, b, h) do { _Pragma("unroll") for (int n = 0; n < 2; ++n) _Pragma("unroll") for (int k = 0; k < 2; ++k) dst[n][k] = *(const LAS bf16x8*)(lds + PG8_SB(b, h) + boff + n * 2048 + k * 1024); } while (0)
#define PG8_MMA(ai, bj, At, Bt) do { __builtin_amdgcn_s_setprio(1); _Pragma("unroll") for (int m = 0; m < 4; ++m) _Pragma("unroll") for (int n = 0; n < 2; ++n) { \
        if constexpr (FP8) { const i32x8 a8 = __builtin_shufflevector(__builtin_bit_cast(i32x4, At[m][0]), __builtin_bit_cast(i32x4, At[m][1]), 0, 1, 2, 3, 4, 5, 6, 7); \
            const i32x8 b8 = __builtin_shufflevector(__builtin_bit_cast(i32x4, Bt[n][0]), __builtin_bit_cast(i32x4, Bt[n][1]), 0, 1, 2, 3, 4, 5, 6, 7); \
            acc[ai][bj][m][n] = __builtin_amdgcn_mfma_scale_f32_16x16x128_f8f6f4(b8, a8, acc[ai][bj][m][n], 0, 0, 0, 0x7f7f7f7f, 0, 0x7f7f7f7f); } \
        else { _Pragma("unroll") for (int k = 0; k < 2; ++k) acc[ai][bj][m][n] = __builtin_amdgcn_mfma_f32_16x16x32_bf16(Bt[n][k], At[m][k], acc[ai][bj][m][n], 0, 0, 0); } } \
        __builtin_amdgcn_s_setprio(0); } while (0)
#define PG8_WAIT_V(n) asm volatile("s_waitcnt vmcnt(" #n ")" ::: "memory")
#define PG8_WAIT_L(n) asm volatile("s_waitcnt lgkmcnt(" #n ")" ::: "memory")
#define PG8_BAR __builtin_amdgcn_s_barrier()
#define PG8_SCHED __builtin_amdgcn_sched_barrier(0)
    Unit cur, nxt; int ui = 0;
    if (!S.next(0, cur)) return;
    int ntu = nt; if constexpr (Sched::VARK) ntu = S.nt(cur);
    Acc acc;
#pragma unroll
    for (int a = 0; a < 2; ++a)
#pragma unroll
        for (int b = 0; b < 2; ++b)
#pragma unroll
            for (int m = 0; m < 4; ++m)
#pragma unroll
                for (int n = 0; n < 2; ++n) acc[a][b][m][n] = (f32x4){0.f, 0.f, 0.f, 0.f};
    bf16x8 At[4][2], B0[2][2], B1[2][2];
    unsigned vA[2][2];
    if constexpr (Sched::ROWDMA) { S.prefetch_rows(cur, wid, lane); PG8_WAIT_V(0); PG8_BAR; }
    S.a_offsets(cur, vA);
    const char* cA = S.a_ptr(cur); const char* cB = S.b_ptr(cur);
    PG8_STAGE(PG8_SB(0, 0), cB, voffB); PG8_STAGE(PG8_SB(0, 1), cB + hstep, voffB); PG8_STAGE2(PG8_SA(0, 0), cA, vA[0][0], vA[0][1]); PG8_STAGE2(PG8_SA(0, 1), cA, vA[1][0], vA[1][1]);
    if (wr == 1) PG8_BAR;
    PG8_WAIT_V(2); PG8_BAR;
    PG8_STAGE(PG8_SB(1, 0), cB + kstep, voffB); PG8_STAGE2(PG8_SA(1, 0), cA + kstep, vA[0][0], vA[0][1]); PG8_STAGE(PG8_SB(1, 1), cB + hstep + kstep, voffB);
    PG8_WAIT_V(6); PG8_BAR;
    for (;;) {
        const bool has_next = S.next(ui + 1, nxt);
        const char* nA = has_next ? S.a_ptr(nxt) : cA; const char* nB = has_next ? S.b_ptr(nxt) : cB;
        const bool newrows = has_next && nxt.tile != cur.tile;
        if constexpr (Sched::ROWDMA) { if (newrows) S.prefetch_rows(nxt, wid, lane); }
#pragma unroll 1
        for (int t = 0; t < ntu; t += 2) {
            const bool last = (t == ntu - 2);
            const char* a1 = cA + (size_t)(t + 1) * kstep;
            const char* a2 = last ? nA : cA + (size_t)(t + 2) * kstep; const char* b2 = last ? nB : cB + (size_t)(t + 2) * kstep;
            const char* a3 = a2 + kstep; const char* b3 = b2 + kstep;
            if constexpr (Sched::GATHER) { if (last && newrows) S.a_offsets_h(nxt, 0, vA[0]); }
            PG8_LDB(B0, 0, 0); PG8_LDB(B1, 0, 1); PG8_SCHED; PG8_LDA(At, 0, 0); PG8_STAGE2(PG8_SA(1, 1), a1, vA[1][0], vA[1][1]);
            if constexpr (Sched::GATHER) { if (last && newrows) S.a_offsets_h(nxt, 1, vA[1]); }
            PG8_WAIT_V(8); PG8_WAIT_L(0); PG8_BAR; PG8_MMA(0, 0, At, B0); PG8_MMA(0, 1, At, B1); PG8_BAR; PG8_SCHED;
            PG8_LDA(At, 0, 1); PG8_STAGE(PG8_SB(0, 0), b2, voffB); PG8_STAGE(PG8_SB(0, 1), b2 + hstep, voffB); PG8_STAGE2(PG8_SA(0, 0), a2, vA[0][0], vA[0][1]);
            PG8_WAIT_V(8); PG8_WAIT_L(0); PG8_BAR; PG8_MMA(1, 0, At, B0); PG8_MMA(1, 1, At, B1); PG8_BAR; PG8_SCHED;
            PG8_LDB(B0, 1, 0); PG8_LDB(B1, 1, 1); PG8_SCHED; PG8_LDA(At, 1, 0); PG8_STAGE2(PG8_SA(0, 1), a2, vA[1][0], vA[1][1]);
            PG8_WAIT_V(8); PG8_WAIT_L(0); PG8_BAR; PG8_MMA(0, 0, At, B0); PG8_MMA(0, 1, At, B1); PG8_BAR; PG8_SCHED;
            PG8_LDA(At, 1, 1); PG8_STAGE(PG8_SB(1, 0), b3, voffB); PG8_STAGE(PG8_SB(1, 1), b3 + hstep, voffB); PG8_STAGE2(PG8_SA(1, 0), a3, vA[0][0], vA[0][1]);
            PG8_WAIT_V(8); PG8_WAIT_L(0); PG8_BAR; PG8_MMA(1, 0, At, B0); PG8_MMA(1, 1, At, B1); PG8_BAR; PG8_SCHED;
        }
        if (wr == 0) PG8_BAR;
        { int tl = (int)threadIdx.x; asm volatile("" : "+v"(tl));
          E(acc, cur, wr, wc, tl & 15, (tl & 63) >> 4); }
        if (!has_next) break;
#pragma unroll
        for (int a = 0; a < 2; ++a)
#pragma unroll
            for (int b = 0; b < 2; ++b)
#pragma unroll
                for (int m = 0; m < 4; ++m)
#pragma unroll
                    for (int n = 0; n < 2; ++n) acc[a][b][m][n] = (f32x4){0.f, 0.f, 0.f, 0.f};
        cur = nxt; cA = nA; cB = nB; ++ui;
        if constexpr (Sched::VARK) ntu = S.nt(cur);
        if (wr == 1) PG8_BAR;
    }
    PG8_WAIT_V(0);
    PG8_BAR;
#undef PG8_SA
#undef PG8_SB
#undef PG8_STAGE
#undef PG8_STAGE2
#undef PG8_LDA
#undef PG8_LDB
#undef PG8_MMA
#undef PG8_WAIT_V
#undef PG8_WAIT_L
#undef PG8_BAR
#undef PG8_SCHED
}
}

struct Args { const float* in[25]; float* out; unsigned char* ws; int ph_lo, ph_hi; };
struct Frame {
    LAS unsigned char* lds; int wave, G, blk;
    static __device__ __forceinline__ int tid() { return (int)threadIdx.x; }
    static __device__ __forceinline__ int lane() { return (int)(threadIdx.x & 63u); }
    static __device__ __forceinline__ const __attribute__((address_space(4))) Args* ka() { return (const __attribute__((address_space(4))) Args*)__builtin_amdgcn_kernarg_segment_ptr(); }
    __device__ __forceinline__ const float* x() const { return ka()->in[0]; }
    __device__ __forceinline__ const float* c() const { return ka()->in[1]; }
    __device__ __forceinline__ const float* ctx() const { return ka()->in[2]; }
    __device__ __forceinline__ const float* c_ctx() const { return ka()->in[3]; }
    __device__ __forceinline__ const float* w_ada() const { return ka()->in[4]; }
    __device__ __forceinline__ const float* b_ada() const { return ka()->in[5]; }
    __device__ __forceinline__ const float* g_mix_pre() const { return ka()->in[6]; }
    __device__ __forceinline__ const float* g_mix_post() const { return ka()->in[7]; }
    __device__ __forceinline__ const float* g_ffn_pre() const { return ka()->in[8]; }
    __device__ __forceinline__ const float* g_ffn_post() const { return ka()->in[9]; }
    __device__ __forceinline__ const float* w_in() const { return ka()->in[10]; }
    __device__ __forceinline__ const float* b_gates() const { return ka()->in[11]; }
    __device__ __forceinline__ const float* rpb() const { return ka()->in[12]; }
    __device__ __forceinline__ const float* g_head() const { return ka()->in[13]; }
    __device__ __forceinline__ const float* w_br_na() const { return ka()->in[14]; }
    __device__ __forceinline__ const float* w_br_ml() const { return ka()->in[15]; }
    __device__ __forceinline__ const float* w_out() const { return ka()->in[16]; }
    __device__ __forceinline__ const float* w_router() const { return ka()->in[17]; }
    __device__ __forceinline__ const float* b_router() const { return ka()->in[18]; }
    __device__ __forceinline__ const float* w_gate() const { return ka()->in[19]; }
    __device__ __forceinline__ const float* b_gate() const { return ka()->in[20]; }
    __device__ __forceinline__ const float* w_lin() const { return ka()->in[21]; }
    __device__ __forceinline__ const float* b_lin() const { return ka()->in[22]; }
    __device__ __forceinline__ const float* w_down() const { return ka()->in[23]; }
    __device__ __forceinline__ const float* b_down() const { return ka()->in[24]; }
    float* out_; unsigned char* ws_;
    __device__ __forceinline__ float* out() const { return out_; }
    __device__ __forceinline__ unsigned char* ws() const { return ws_; }
    __device__ __forceinline__ unsigned* ctl() const { return (unsigned*)(ws_ + WS_CTL); }
};
#define WSP(T, off) ((T*)(F.ws() + (off)))

template <bool F8>
struct EpiInProj {
    static constexpr bool MID = false;
    static constexpr float DSC = F8 ? 1.f / (FP8_SHI * FP8_SW) : 1.f;
    bf16_t* P; int ldp; bf16_t* Vt; int S; float* gates; LAS bf16_t* scr_base;
    bf16_t* Kt; bf16_t* Mvt; const float* rope; bool lat;
    __device__ __forceinline__ void store_t(LAS bf16_t* scr, const float (&v)[8], bf16_t* dst, int lane, int fr, int fq) const {
#pragma unroll
        for (int j = 0; j < 8; ++j) scr[(8 * fq + j) * 24 + fr] = f2bf(v[j]);
        const int rdim = lane >> 1, rhalf = lane & 1;
        const u32x4 tv = *(const LAS u32x4*)(scr + rdim * 24 + 8 * rhalf);
        *(u32x4*)(dst + (size_t)rdim * S + 8 * rhalf) = tv;
    }
    __device__ __forceinline__ void operator()(const pg8::Acc& acc, const pg8::Unit& u, int wr, int wc, int fr, int fq) const {
        const int row0 = u.pm * 256 + wr * 64 + fr, pn = u.pn;
        const int lane = fr + 16 * fq; LAS bf16_t* scr = scr_base + (wr * 4 + wc) * (32 * 24);
        if (pn == 2 || pn == 3 || pn == 5 || pn == 6) {
            const bool na = pn < 4;
#pragma unroll
            for (int ai = 0; ai < 2; ++ai)
#pragma unroll
                for (int m = 0; m < 4; ++m) { const int rowb = u.pm * 256 + wr * 64 + ai * 128 + m * 16; const int b = rowb / S, tin = rowb - b * S;
#pragma unroll
                    for (int bj = 0; bj < 2; ++bj) { float v[8];
#pragma unroll
                        for (int n = 0; n < 2; ++n)
#pragma unroll
                            for (int i = 0; i < 4; ++i) v[4 * n + i] = acc[ai][bj][m][n][i] * DSC;
                        if (na) { const int col0 = (pn - 2) * 256 + bj * 128 + wc * 32; const int head = col0 >> 6, dim0 = col0 & 63;
                            store_t(scr, v, Vt + ((size_t)(b * 8 + head) * 64 + dim0) * S + tin, lane, fr, fq); }
                        else { const int head = 2 * (pn - 5) + bj;
                            store_t(scr, v, Mvt + ((size_t)(b * 4 + head) * 128 + wc * 32) * S + tin, lane, fr, fq); } } }
        } else if (!F8 && pn == 7) {
            if (wc == 0 && fq < 2) {
#pragma unroll
                for (int ai = 0; ai < 2; ++ai)
#pragma unroll
                    for (int m = 0; m < 4; ++m) { const int row = row0 + ai * 128 + m * 16; float* dst = gates + (size_t)row * 16 + 8 * fq;
                        *(f32x4*)dst = acc[ai][0][m][0]; *(f32x4*)(dst + 4) = acc[ai][0][m][1]; }
            }
        } else if (pn == 4 || pn == 10) {
            const int cb = (pn < 7 ? pn : pn - 1) * 256 + wc * 32 + 8 * fq; const bool isk = pn == 4; const float ksc = (isk ? 0.125f : 1.f) * DSC;
#pragma unroll
            for (int am = 0; am < 4; ++am) { const int ai = am >> 1, m0 = 2 * (am & 1);
                f32x4 csv[4][2], snv[4][2];
#pragma unroll
                for (int m = m0; m < m0 + 2; ++m) { const int rowb = u.pm * 256 + wr * 64 + ai * 128 + m * 16; const int b = rowb / S, tin = rowb - b * S, tinl = tin + fr;
                    const int pos = (wc & 1) ? 32 + (tinl & 63) : (tinl >> 6);
                    csv[m][0] = (f32x4){1.f, 1.f, 1.f, 1.f}; csv[m][1] = csv[m][0]; snv[m][0] = (f32x4){0.f, 0.f, 0.f, 0.f}; snv[m][1] = snv[m][0];
                    if (lat) { const float* tp = rope + pos * 16 + 8 * (fq & 1); csv[m][0] = *(const f32x4*)tp; csv[m][1] = *(const f32x4*)(tp + 4); snv[m][0] = *(const f32x4*)(tp + 96 * 16); snv[m][1] = *(const f32x4*)(tp + 96 * 16 + 4); } }
#pragma unroll
                for (int m = m0; m < m0 + 2; ++m) { asm volatile("" : "+v"(csv[m][0])); asm volatile("" : "+v"(csv[m][1])); asm volatile("" : "+v"(snv[m][0])); asm volatile("" : "+v"(snv[m][1])); }
#pragma unroll
                for (int m = m0; m < m0 + 2; ++m) { const int rowb = u.pm * 256 + wr * 64 + ai * 128 + m * 16; const int b = rowb / S, tin = rowb - b * S;
                    bf16_t* rowp = P + (size_t)(row0 + ai * 128 + m * 16) * ldp + cb;
                    f32x4 cs0 = csv[m][0], cs1 = csv[m][1], sn0 = snv[m][0], sn1 = snv[m][1];
                    if (lat && fq < 2) { sn0 = -sn0; sn1 = -sn1; }
#pragma unroll
                    for (int bj = 0; bj < 2; ++bj) { float v[8];
#pragma unroll
                        for (int n = 0; n < 2; ++n)
#pragma unroll
                            for (int i = 0; i < 4; ++i) { float own = acc[ai][bj][m][n][i];
                                if (lat) { const float oth = __shfl_xor(own, 32); own = own * (n ? cs1[i] : cs0[i]) + oth * (n ? sn1[i] : sn0[i]); }
                                v[4 * n + i] = own * ksc; }
                        u32x4 pk; pk[0] = cvt_pk_bf16(v[0], v[1]); pk[1] = cvt_pk_bf16(v[2], v[3]); pk[2] = cvt_pk_bf16(v[4], v[5]); pk[3] = cvt_pk_bf16(v[6], v[7]);
                        *(u32x4*)(rowp + bj * 128) = pk;
                        if (isk) { const int head = 2 * bj + (wc >> 1); store_t(scr, v, Kt + ((size_t)(b * 4 + head) * 64 + 32 * (wc & 1)) * S + tin, lane, fr, fq); } } }
            }
        } else if (pn >= 13) {
            const int gb = 2 * PC_GNA + (pn - 13) * 256 + wc * 32 + 8 * fq;
#pragma unroll
            for (int ai = 0; ai < 2; ++ai)
#pragma unroll
                for (int m = 0; m < 4; ++m) { unsigned char* rowp = (unsigned char*)(P + (size_t)(row0 + ai * 128 + m * 16) * ldp) + gb;
#pragma unroll
                    for (int bj = 0; bj < 2; ++bj) { float g[8];
#pragma unroll
                        for (int n = 0; n < 2; ++n)
#pragma unroll
                            for (int i = 0; i < 4; ++i) g[4 * n + i] = FP8_SG * __builtin_amdgcn_rcpf(1.f + __builtin_amdgcn_exp2f(acc[ai][bj][m][n][i] * (-1.4426950408889634f * DSC)));
                        *(u32x2*)(rowp + bj * 128) = (u32x2){pack_fp8x4(g[0], g[1], g[2], g[3]), pack_fp8x4(g[4], g[5], g[6], g[7])}; } }
        } else {
            const int cb = (pn < 7 ? pn : pn - 1) * 256 + wc * 32 + 8 * fq;
#pragma unroll
            for (int ai = 0; ai < 2; ++ai)
#pragma unroll
                for (int m = 0; m < 4; ++m) { bf16_t* rowp = P + (size_t)(row0 + ai * 128 + m * 16) * ldp + cb;
#pragma unroll
                    for (int bj = 0; bj < 2; ++bj) { const f32x4 v0 = acc[ai][bj][m][0] * DSC, v1 = acc[ai][bj][m][1] * DSC;
                        u32x4 pk; pk[0] = cvt_pk_bf16(v0[0], v0[1]); pk[1] = cvt_pk_bf16(v0[2], v0[3]); pk[2] = cvt_pk_bf16(v1[0], v1[1]); pk[3] = cvt_pk_bf16(v1[2], v1[3]);
                        *(u32x4*)(rowp + bj * 128) = pk; } }
        }
    }
};
struct EpiBranchA {
    static constexpr bool MID = false;
    const bf16_t* P; bf16_t* T;
    __device__ __forceinline__ void operator()(const pg8::Acc& acc, const pg8::Unit& u, int wr, int wc, int fr, int fq) const {
        const int row0 = u.pm * 256 + wr * 64 + fr, cb = u.pn * 256 + wc * 32 + 8 * fq;
#pragma unroll
        for (int ai = 0; ai < 2; ++ai)
#pragma unroll
            for (int m = 0; m < 4; ++m) { const size_t row = (size_t)(row0 + ai * 128 + m * 16);
#pragma unroll
                for (int bj = 0; bj < 2; ++bj) { const u32x4 gm = *(const u32x4*)(P + row * LDP + cb + PC_GNA + bj * 128);
                    float v[8];
#pragma unroll
                    for (int q = 0; q < 4; ++q) { const f32x2 gq = (f32x2){bf_lo(gm[q]), bf_hi(gm[q])} * -1.4426950408889634f; f32x2 e; e[0] = __builtin_amdgcn_exp2f(gq[0]); e[1] = __builtin_amdgcn_exp2f(gq[1]);
                        const f32x2 dn = e + 1.f; f32x2 r; r[0] = __builtin_amdgcn_rcpf(dn[0]); r[1] = __builtin_amdgcn_rcpf(dn[1]);
                        const f32x2 o = (f32x2){acc[ai][bj][m][q >> 1][(q & 1) * 2], acc[ai][bj][m][q >> 1][(q & 1) * 2 + 1]} * r; v[2 * q] = o[0]; v[2 * q + 1] = o[1]; }
                    u32x4 pk; pk[0] = cvt_pk_bf16(v[0], v[1]); pk[1] = cvt_pk_bf16(v[2], v[3]); pk[2] = cvt_pk_bf16(v[4], v[5]); pk[3] = cvt_pk_bf16(v[6], v[7]);
                    *(u32x4*)(T + row * D + cb + bj * 128) = pk; } }
    }
};
struct EpiBranchB {
    static constexpr bool MID = false;
    const bf16_t* P; const bf16_t* T; bf16_t* O;
    __device__ __forceinline__ void operator()(const pg8::Acc& acc, const pg8::Unit& u, int wr, int wc, int fr, int fq) const {
        const int row0 = u.pm * 256 + wr * 64 + fr, cb = u.pn * 256 + wc * 32 + 8 * fq;
#pragma unroll
        for (int ai = 0; ai < 2; ++ai)
#pragma unroll
            for (int m = 0; m < 4; ++m) { const size_t row = (size_t)(row0 + ai * 128 + m * 16);
#pragma unroll
                for (int bj = 0; bj < 2; ++bj) { const u32x4 gm = *(const u32x4*)(P + row * LDP + cb + PC_GML + bj * 128); const u32x4 tv = *(const u32x4*)(T + row * D + cb + bj * 128);
                    float v[8];
#pragma unroll
                    for (int q = 0; q < 4; ++q) { const f32x2 gq = (f32x2){bf_lo(gm[q]), bf_hi(gm[q])} * -1.4426950408889634f; f32x2 e; e[0] = __builtin_amdgcn_exp2f(gq[0]); e[1] = __builtin_amdgcn_exp2f(gq[1]);
                        const f32x2 dn = e + 1.f; f32x2 r; r[0] = __builtin_amdgcn_rcpf(dn[0]); r[1] = __builtin_amdgcn_rcpf(dn[1]);
                        const f32x2 o = (f32x2){acc[ai][bj][m][q >> 1][(q & 1) * 2], acc[ai][bj][m][q >> 1][(q & 1) * 2 + 1]} * r + (f32x2){bf_lo(tv[q]), bf_hi(tv[q])}; v[2 * q] = o[0]; v[2 * q + 1] = o[1]; }
                    u32x4 pk; pk[0] = cvt_pk_bf16(v[0], v[1]); pk[1] = cvt_pk_bf16(v[2], v[3]); pk[2] = cvt_pk_bf16(v[4], v[5]); pk[3] = cvt_pk_bf16(v[6], v[7]);
                    *(u32x4*)(O + row * D + cb + bj * 128) = pk; } }
    }
};
struct EpiMix {
    static constexpr bool MID = false;
    const bf16_t* P; bf16_t* Tw; bf16_t* M; bf16_t* Y;
    __device__ __forceinline__ void operator()(const pg8::Acc& acc, const pg8::Unit& u, int wr, int wc, int fr, int fq) const {
        const int rl0 = wr * 64 + fr, cl = wc * 32 + 8 * fq, row0 = u.pm * 256 + rl0, cb = u.pn * 256 + cl;
        if (u.e == 2) {
#pragma unroll
            for (int ai = 0; ai < 2; ++ai)
#pragma unroll
                for (int m = 0; m < 4; ++m) { bf16_t* rowp = Y + (size_t)(row0 + ai * 128 + m * 16) * D + cb;
#pragma unroll
                    for (int bj = 0; bj < 2; ++bj) { const f32x4 v0 = acc[ai][bj][m][0], v1 = acc[ai][bj][m][1];
                        u32x4 pk; pk[0] = cvt_pk_bf16(v0[0], v0[1]); pk[1] = cvt_pk_bf16(v0[2], v0[3]); pk[2] = cvt_pk_bf16(v1[0], v1[1]); pk[3] = cvt_pk_bf16(v1[2], v1[3]);
                        *(u32x4*)(rowp + bj * 128) = pk; } }
        } else {
            const bool second = u.e != 0; const int gc = 2 * PC_GNA + (second ? 1024 : 0);
            u32x2 gmv[2][4][2];
#pragma unroll
            for (int m = 0; m < 4; ++m)
#pragma unroll
                for (int bj = 0; bj < 2; ++bj) gmv[0][m][bj] = *(const u32x2*)((const unsigned char*)(P + (size_t)(u.pm * 256 + rl0 + m * 16) * LDP) + gc + cb + bj * 128);
#pragma unroll
            for (int ai = 0; ai < 2; ++ai) {
                u32x4 tvv[4][2];
#pragma unroll
                for (int m = 0; m < 4; ++m) { const int rl = rl0 + ai * 128 + m * 16;
#pragma unroll
                    for (int bj = 0; bj < 2; ++bj) { tvv[m][bj] = (u32x4){0u, 0u, 0u, 0u}; if (second) tvv[m][bj] = *(const u32x4*)(Tw + rl * 256 + cl + bj * 128); } }
                if (ai == 0) {
#pragma unroll
                    for (int m = 0; m < 4; ++m)
#pragma unroll
                        for (int bj = 0; bj < 2; ++bj) gmv[1][m][bj] = *(const u32x2*)((const unsigned char*)(P + (size_t)(u.pm * 256 + rl0 + 128 + m * 16) * LDP) + gc + cb + bj * 128); }
#pragma unroll
                for (int m = 0; m < 4; ++m)
#pragma unroll
                    for (int bj = 0; bj < 2; ++bj) { asm volatile("" : "+v"(gmv[ai][m][bj])); asm volatile("" : "+v"(tvv[m][bj])); }
#pragma unroll
                for (int m = 0; m < 4; ++m) { const int rl = rl0 + ai * 128 + m * 16; const size_t row = (size_t)(u.pm * 256 + rl);
#pragma unroll
                    for (int bj = 0; bj < 2; ++bj) { const u32x2 gm = gmv[ai][m][bj]; const u32x4 tv = tvv[m][bj];
                        bf16_t* tp = Tw + rl * 256 + cl + bj * 128;
                        float v[8];
#pragma unroll
                        for (int q = 0; q < 4; ++q) { const f32x2 r = ((q & 1) ? __builtin_amdgcn_cvt_pk_f32_fp8((int)gm[q >> 1], true) : __builtin_amdgcn_cvt_pk_f32_fp8((int)gm[q >> 1], false)) * (1.f / FP8_SG);
                            const f32x2 o = (f32x2){acc[ai][bj][m][q >> 1][(q & 1) * 2], acc[ai][bj][m][q >> 1][(q & 1) * 2 + 1]} * r + (f32x2){bf_lo(tv[q]), bf_hi(tv[q])}; v[2 * q] = o[0]; v[2 * q + 1] = o[1]; }
                        u32x4 pk; pk[0] = cvt_pk_bf16(v[0], v[1]); pk[1] = cvt_pk_bf16(v[2], v[3]); pk[2] = cvt_pk_bf16(v[4], v[5]); pk[3] = cvt_pk_bf16(v[6], v[7]);
                        if (second) *(u32x4*)(M + row * D + cb + bj * 128) = pk; else *(u32x4*)tp = pk; } }
            }
            if (second) asm volatile("s_waitcnt vmcnt(0)" ::: "memory");
        }
    }
};
struct EpiPlain {
    static constexpr bool MID = false;
    bf16_t* O; int ldc;
    __device__ __forceinline__ void operator()(const pg8::Acc& acc, const pg8::Unit& u, int wr, int wc, int fr, int fq) const {
        const int row0 = u.pm * 256 + wr * 64 + fr, cb = u.pn * 256 + wc * 32 + 8 * fq;
#pragma unroll
        for (int ai = 0; ai < 2; ++ai)
#pragma unroll
            for (int m = 0; m < 4; ++m) { bf16_t* rowp = O + (size_t)(row0 + ai * 128 + m * 16) * ldc + cb;
#pragma unroll
                for (int bj = 0; bj < 2; ++bj) { const f32x4 v0 = acc[ai][bj][m][0], v1 = acc[ai][bj][m][1];
                    u32x4 pk; pk[0] = cvt_pk_bf16(v0[0], v0[1]); pk[1] = cvt_pk_bf16(v0[2], v0[3]); pk[2] = cvt_pk_bf16(v1[0], v1[1]); pk[3] = cvt_pk_bf16(v1[2], v1[3]);
                    *(u32x4*)(rowp + bj * 128) = pk; } }
    }
};
struct EpiSwiglu {
    static constexpr bool MID = false;
    unsigned char* Alo; unsigned char* Ahi; const LAS float* biasl;
    __device__ __forceinline__ void operator()(const pg8::Acc& acc, const pg8::Unit& u, int wr, int wc, int fr, int fq) const {
        constexpr float dsc = 1.f / (FP8_SW * FP8_SH);
        const int r0 = u.tile * 256; unsigned char* base = r0 < A_LO_ROWS ? Alo + (size_t)r0 * PA_HID : Ahi + (size_t)(r0 - A_LO_ROWS) * PA_HID;
        const int rl0 = wr * 64 + fr, cb = u.pn * 128 + wc * 32 + 8 * fq;
        const LAS float* pg = biasl + u.rb * 256 + wc * 32 + 8 * fq; const LAS float* pl = pg + 128;
        const f32x4 g0 = *(const LAS f32x4*)pg * FP8_SA, g1 = *(const LAS f32x4*)(pg + 4) * FP8_SA, l0 = *(const LAS f32x4*)pl + 1.f, l1 = *(const LAS f32x4*)(pl + 4) + 1.f;
        constexpr float dg = dsc * FP8_SA, ce = -2.4554669595930157f / FP8_SA;
#pragma unroll
        for (int ai = 0; ai < 2; ++ai)
#pragma unroll
            for (int m = 0; m < 4; ++m) { float v[8];
#pragma unroll
                for (int n = 0; n < 2; ++n)
#pragma unroll
                    for (int p = 0; p < 2; ++p) { const f32x4 bgv = n ? g1 : g0, blv = n ? l1 : l0;
                        f32x2 G = (f32x2){acc[ai][0][m][n][2 * p], acc[ai][0][m][n][2 * p + 1]} * dg + (f32x2){bgv[2 * p], bgv[2 * p + 1]};
                        f32x2 L = (f32x2){acc[ai][1][m][n][2 * p], acc[ai][1][m][n][2 * p + 1]} * dsc + (f32x2){blv[2 * p], blv[2 * p + 1]};
                        G[0] = fminf(G[0], 7.f * FP8_SA); G[1] = fminf(G[1], 7.f * FP8_SA); L[0] = __builtin_amdgcn_fmed3f(L[0], -6.f, 8.f); L[1] = __builtin_amdgcn_fmed3f(L[1], -6.f, 8.f);
                        const f32x2 T = G * ce; f32x2 E; E[0] = __builtin_amdgcn_exp2f(T[0]); E[1] = __builtin_amdgcn_exp2f(T[1]);
                        const f32x2 Dn = E + 1.f; f32x2 R; R[0] = __builtin_amdgcn_rcpf(Dn[0]); R[1] = __builtin_amdgcn_rcpf(Dn[1]);
                        const f32x2 O = (G * R) * L; v[4 * n + 2 * p] = O[0]; v[4 * n + 2 * p + 1] = O[1]; }
                unsigned p0 = 0u, p1 = 0u;
                p0 = __builtin_amdgcn_cvt_pk_fp8_f32(v[0], v[1], p0, false); p0 = __builtin_amdgcn_cvt_pk_fp8_f32(v[2], v[3], p0, true);
                p1 = __builtin_amdgcn_cvt_pk_fp8_f32(v[4], v[5], p1, false); p1 = __builtin_amdgcn_cvt_pk_fp8_f32(v[6], v[7], p1, true);
                *(u32x2*)(base + (size_t)(rl0 + ai * 128 + m * 16) * PA_HID + cb) = (u32x2){p0, p1}; }
    }
};
struct EpiDown {
    static constexpr bool MID = false;
    unsigned char* Ys; const LAS unsigned* edl; const LAS int* cnt;
    __device__ __forceinline__ void operator()(const pg8::Acc& acc, const pg8::Unit& u, int wr, int wc, int fr, int fq) const {
        constexpr float dsc = 1.f / (FP8_SW * FP8_SA);
        const int n = __builtin_amdgcn_readfirstlane(cnt[u.e]), li0 = u.pm * 256 + wr * 64 + fr, cb = u.pn * 256 + wc * 32 + 8 * fq;
        const LAS unsigned* ed = edl + u.rb * 768; const LAS float* pb = (const LAS float*)(ed + 512) + wc * 32 + 8 * fq;
        f32x4 bv[2][2];
#pragma unroll
        for (int bj = 0; bj < 2; ++bj) { bv[bj][0] = *(const LAS f32x4*)(pb + bj * 128); bv[bj][1] = *(const LAS f32x4*)(pb + bj * 128 + 4); }
        int slv[2][4]; float wvv[2][4];
#pragma unroll
        for (int ai = 0; ai < 2; ++ai)
#pragma unroll
            for (int m = 0; m < 4; ++m) { const int rl = wr * 64 + fr + ai * 128 + m * 16; slv[ai][m] = (int)ed[rl]; wvv[ai][m] = __uint_as_float(ed[256 + rl]); }
#pragma unroll
        for (int ai = 0; ai < 2; ++ai)
#pragma unroll
            for (int m = 0; m < 4; ++m) { const int li = li0 + ai * 128 + m * 16;
                if (li < n) { const int slot = slv[ai][m]; const float w = wvv[ai][m];
                    unsigned char* rowp = Ys + (size_t)slot * D + cb;
#pragma unroll
                    for (int bj = 0; bj < 2; ++bj) { const float ws = w * FP8_SY; f32x4 v0 = (acc[ai][bj][m][0] * dsc + bv[bj][0]) * ws, v1 = (acc[ai][bj][m][1] * dsc + bv[bj][1]) * ws;
#pragma unroll
                        for (int i = 0; i < 4; ++i) { v0[i] = __builtin_amdgcn_fmed3f(v0[i], -448.f, 448.f); v1[i] = __builtin_amdgcn_fmed3f(v1[i], -448.f, 448.f); }
                        unsigned p0 = 0u, p1 = 0u;
                        p0 = __builtin_amdgcn_cvt_pk_fp8_f32(v0[0], v0[1], p0, false); p0 = __builtin_amdgcn_cvt_pk_fp8_f32(v0[2], v0[3], p0, true);
                        p1 = __builtin_amdgcn_cvt_pk_fp8_f32(v1[0], v1[1], p1, false); p1 = __builtin_amdgcn_cvt_pk_fp8_f32(v1[2], v1[3], p1, true);
                        *(u32x2*)(rowp + bj * 128) = (u32x2){p0, p1}; } } }
    }
};

__device__ __forceinline__ void phase_ada(const Frame& F) {
    LAS float* tab = (LAS float*)F.lds;
    float* modv = WSP(float, WS_MODV);
    for (int cg = F.blk; cg < 256; cg += F.G) {
        const int j0 = cg * 24, cc = F.tid() % 24, kg = F.tid() / 24;
        float acc[33];
#pragma unroll
        for (int b = 0; b < 33; ++b) acc[b] = 0.f;
        for (int half = 0; half < 2; ++half) {
            __syncthreads();
            {
                float vv[33]; const int k = F.tid();
#pragma unroll
                for (int b = 0; b < 33; ++b) vv[b] = (b < 32) ? F.c()[b * D + half * 512 + k] : F.c_ctx()[half * 512 + k];
#pragma unroll
                for (int b = 0; b < 33; ++b) tab[k * 36 + b] = vv[b] * sigmoidf_(vv[b]); }
            __syncthreads();
            if (kg < 21) {
                float wv[25];
#pragma unroll
                for (int i = 0; i < 25; ++i) { const int k = kg + 21 * i; wv[i] = (k < 512) ? F.w_ada()[(size_t)(half * 512 + k) * 6144 + j0 + cc] : 0.f; }
#pragma unroll
                for (int i = 0; i < 25; ++i) { const int k = (kg + 21 * i < 512) ? kg + 21 * i : 0; const float w = wv[i];
                    const LAS f32x4* tp = (const LAS f32x4*)(tab + k * 36);
#pragma unroll
                    for (int q = 0; q < 8; ++q) { const f32x4 sv = tp[q]; acc[4 * q] += sv[0] * w; acc[4 * q + 1] += sv[1] * w; acc[4 * q + 2] += sv[2] * w; acc[4 * q + 3] += sv[3] * w; }
                    acc[32] += tab[k * 36 + 32] * w;
                }
            }
        }
        __syncthreads();
        LAS float* part = (LAS float*)F.lds;
        if (kg < 21) {
#pragma unroll
            for (int b = 0; b < 33; ++b) part[(kg * 24 + cc) * 33 + b] = acc[b];
        }
        __syncthreads();
        for (int o = F.tid(); o < 24 * 33; o += 512) { const int c2 = o / 33, b = o % 33; float s = F.b_ada()[j0 + c2];
            for (int g = 0; g < 21; ++g) s += part[(g * 24 + c2) * 33 + b];
            modv[(size_t)b * 6144 + j0 + c2] = s; }
        __syncthreads();
    }
}

__device__ __forceinline__ void cvt_tile(const Frame& F, LAS bf16_t* t, const float* src, int ld, int valid, bf16_t* dst, int dld) {
    const int tid = F.tid();
    __syncthreads();
    f32x4 vq[4];
#pragma unroll
    for (int p = 0; p < 4; ++p) { const int k = (tid >> 4) + 32 * p, c = 4 * (tid & 15); const int cc = c < valid ? c : 0;
        vq[p] = *(const f32x4*)(src + (size_t)k * ld + cc); }
#pragma unroll
    for (int p = 0; p < 4; ++p) asm volatile("" : "+v"(vq[p]));
#pragma unroll
    for (int p = 0; p < 4; ++p) { const int k = (tid >> 4) + 32 * p, c = 4 * (tid & 15);
        const f32x4 v = (c < valid) ? vq[p] : (f32x4){0.f, 0.f, 0.f, 0.f};
        *(LAS unsigned*)(t + k * 66 + c) = cvt_pk_bf16(v[0], v[1]); *(LAS unsigned*)(t + k * 66 + c + 2) = cvt_pk_bf16(v[2], v[3]); }
    __syncthreads();
    const int n = tid >> 3, kg = tid & 7;
    unsigned pk[8];
#pragma unroll
    for (int q = 0; q < 8; ++q) { const unsigned lo = t[(16 * kg + 2 * q) * 66 + n], hi = t[(16 * kg + 2 * q + 1) * 66 + n]; pk[q] = lo | (hi << 16); }
    u32x4* d = (u32x4*)(dst + (size_t)n * dld + 16 * kg);
    d[0] = (u32x4){pk[0], pk[1], pk[2], pk[3]}; d[1] = (u32x4){pk[4], pk[5], pk[6], pk[7]};
}
__device__ __forceinline__ void cvt_tile8(const Frame& F, LAS float* t, const float* src, int ld, unsigned char* dst, int dld, float scale) {
    const int tid = F.tid();
    __syncthreads();
#pragma unroll
    for (int p = 0; p < 4; ++p) { const int k = (tid >> 4) + 32 * p, c = 4 * (tid & 15);
        const f32x4 v = *(const f32x4*)(src + (size_t)k * ld + c);
        t[k * 65 + c] = v[0]; t[k * 65 + c + 1] = v[1]; t[k * 65 + c + 2] = v[2]; t[k * 65 + c + 3] = v[3]; }
    __syncthreads();
    const int n = tid >> 3, kg = tid & 7;
    u32x4 pk;
#pragma unroll
    for (int q = 0; q < 4; ++q) pk[q] = pack_fp8x4(t[(16 * kg + 4 * q) * 65 + n] * scale, t[(16 * kg + 4 * q + 1) * 65 + n] * scale, t[(16 * kg + 4 * q + 2) * 65 + n] * scale, t[(16 * kg + 4 * q + 3) * 65 + n] * scale);
    *(u32x4*)(dst + (size_t)n * dld + 16 * kg) = pk;
}
__device__ __forceinline__ void phase_cvt_small(const Frame& F) {
    if (F.blk == 0) { float* rope = WSP(float, WS_ROPE);
        for (int i = F.tid(); i < 96 * 16; i += 512) { const int p = i >> 4, j = i & 15; const float pos = (p < 32) ? (float)p : (float)(p - 32);
            const float inv = powf(10000.f, -(float)j / 16.f); float sn, cs; sincosf(pos * inv, &sn, &cs); rope[i] = cs; rope[96 * 16 + i] = sn; } }
    LAS bf16_t* t = (LAS bf16_t*)F.lds;
    bf16_t* btin = WSP(bf16_t, WS_BTIN); bf16_t* btbr = WSP(bf16_t, WS_BTBR); bf16_t* btout = WSP(bf16_t, WS_BTOUT);
    for (int task = F.blk; task < 928; task += F.G) {
        if (task < 672) { const int nc = task >> 3, kt = task & 7, n0 = nc * 64; int c0, valid;
            if (n0 < 1792) { c0 = n0; valid = 64; } else if (n0 == 1792) { c0 = 1792; valid = 16; } else if (n0 < 2048) { c0 = 0; valid = 0; } else { c0 = n0 - 240; valid = 64; }
            if (n0 < N_IN16) cvt_tile(F, t, F.w_in() + (size_t)(kt * 128) * W_IN_COLS + c0, W_IN_COLS, valid, btin + (size_t)n0 * D + kt * 128, D);
            if (in_is8(n0 >> 8)) cvt_tile8(F, (LAS float*)F.lds, F.w_in() + (size_t)(kt * 128) * W_IN_COLS + c0, W_IN_COLS, WSP(unsigned char, WS_BTIN8) + (size_t)n0 * D + kt * 128, D, FP8_SW);
        } else if (task < 800) { const int q = task - 672, nc = q >> 3, kt = q & 7;
            const float* src = (kt < 4) ? F.w_br_na() + (size_t)(kt * 128) * D + nc * 64 : F.w_br_ml() + (size_t)((kt - 4) * 128) * D + nc * 64;
            cvt_tile(F, t, src, D, 64, btbr + (size_t)(nc * 64) * D + kt * 128, D);
        } else { const int q = task - 800, nc = q >> 3, kt = q & 7;
            cvt_tile(F, t, F.w_out() + (size_t)(kt * 128) * D + nc * 64, D, 64, btout + (size_t)(nc * 64) * D + kt * 128, D); }
    }
    __syncthreads();
}
__device__ __forceinline__ void cvt_exp_task(const Frame& F, int task, const float*& src, unsigned char*& dst) {
    unsigned char* wgl = WSP(unsigned char, WS_WGL); unsigned char* wd = (unsigned char*)F.out() + DO_WD;
    if (task < NEXP * 256) { const int e = task >> 8, q = task & 255; const int nc = q >> 3, kt = q & 7, n0 = nc * 64;
        const int pn = n0 >> 8, bj = (n0 >> 7) & 1, j = 128 * pn + (n0 & 127);
        src = (bj ? F.w_lin() : F.w_gate()) + (size_t)e * D * D + (size_t)(kt * 128) * D + j; dst = wgl + (size_t)e * 2048 * D + (size_t)n0 * D + kt * 128;
    } else { const int t2 = task - NEXP * 256; const int e = t2 >> 7, q2 = t2 & 127, nc = q2 >> 3, kt = q2 & 7;
        src = F.w_down() + (size_t)e * D * D + (size_t)(kt * 128) * D + nc * 64; dst = wd + (size_t)e * D * D + (size_t)(nc * 64) * D + kt * 128; }
}
__device__ __forceinline__ void phase_cvt_experts(const Frame& F, const int T0, const int NTASK) {
    LAS float* t = (LAS float*)F.lds;
    const int tid = F.tid(), k0 = tid >> 4, c = 4 * (tid & 15), n = tid >> 3, kg = tid & 7;
#define CVT_LOAD(r, task_) do { const float* src_; unsigned char* dst_; cvt_exp_task(F, (task_), src_, dst_); (void)dst_; \
        _Pragma("unroll") for (int p = 0; p < 4; ++p) (r)[p] = __builtin_nontemporal_load((const f32x4*)(src_ + (size_t)(k0 + 32 * p) * D + c)); } while (0)
#define CVT_EMIT(r, task_) do { __syncthreads(); \
        _Pragma("unroll") for (int p = 0; p < 4; ++p) { LAS float* tp = t + (k0 + 32 * p) * 65 + c; tp[0] = (r)[p][0]; tp[1] = (r)[p][1]; tp[2] = (r)[p][2]; tp[3] = (r)[p][3]; } \
        const float* src_; unsigned char* dcur; cvt_exp_task(F, (task_), src_, dcur); (void)src_; \
        { const int tn_ = ((task_) + 2 * F.G < NTASK) ? (task_) + 2 * F.G : (task_); CVT_LOAD(r, tn_); }     \
        __syncthreads(); u32x4 pk; \
        _Pragma("unroll") for (int q = 0; q < 4; ++q) pk[q] = pack_fp8x4(t[(16 * kg + 4 * q) * 65 + n] * FP8_SW, t[(16 * kg + 4 * q + 1) * 65 + n] * FP8_SW, t[(16 * kg + 4 * q + 2) * 65 + n] * FP8_SW, t[(16 * kg + 4 * q + 3) * 65 + n] * FP8_SW); \
        *(u32x4*)(dcur + (size_t)n * D + 16 * kg) = pk; } while (0)
    f32x4 rA[4], rB[4];
    int task = T0 + F.blk;
    if (task < NTASK) {
        CVT_LOAD(rA, task);
        { const int t1_ = (task + F.G < NTASK) ? task + F.G : task; CVT_LOAD(rB, t1_); }
        for (;;) {
            CVT_EMIT(rA, task);
            if (task + F.G >= NTASK) break;
            CVT_EMIT(rB, task + F.G);
            task += 2 * F.G; if (task >= NTASK) break;
        }
    }
#undef CVT_LOAD
#undef CVT_EMIT
    __syncthreads();
}

__device__ __forceinline__ void phase_norm1(const Frame& F) {
    const float* modv = WSP(float, WS_MODV); bf16_t* H = WSP(bf16_t, WS_H); unsigned char* H8 = WSP(unsigned char, WS_H8);
    constexpr int NGRP = (NTOK + NCTX) / 32;
    const int lane = F.lane();
    { float* comb = WSP(float, WS_COMB);
      for (int i = F.blk * 512 + F.tid(); i < 32 * 4096; i += F.G * 512) { const int b = i >> 12, which = (i >> 10) & 3, k = i & 1023; const float* mb = modv + (size_t)b * 6144;
          comb[i] = which == 0 ? mb[2048 + k] * F.g_mix_post()[k] : which == 1 ? F.g_ffn_pre()[k] * (mb[4096 + k] + 1.f) : which == 2 ? mb[3072 + k] : mb[5120 + k] * F.g_ffn_post()[k]; } }
    int curb = -1; f32x4 al[4], be[4];
    for (int grp = F.blk; grp < NGRP; grp += F.G) {
        const int r0 = grp * 32 + F.wave * 4;
        const int b = (r0 < NTOK) ? r0 / SEQ : 32;
        if (b != curb) { curb = b;
#pragma unroll
            for (int j = 0; j < 4; ++j) { const int k = 256 * j + 4 * lane; const f32x4 g = *(const f32x4*)(F.g_mix_pre() + k), sc = *(const f32x4*)(modv + (size_t)b * 6144 + 1024 + k);
                al[j] = g * (sc + 1.f); be[j] = *(const f32x4*)(modv + (size_t)b * 6144 + k); } }
        const float* src = (r0 < NTOK) ? F.x() + (size_t)r0 * D : F.ctx() + (size_t)(r0 - NTOK) * D;
        f32x4 v[4][4];
#pragma unroll
        for (int t = 0; t < 4; ++t)
#pragma unroll
            for (int j = 0; j < 4; ++j) v[t][j] = __builtin_nontemporal_load((const f32x4*)(src + (size_t)t * D + 256 * j + 4 * lane));
#pragma unroll
        for (int t = 0; t < 4; ++t) { float ss = 0.f;
#pragma unroll
            for (int j = 0; j < 4; ++j) ss += v[t][j][0] * v[t][j][0] + v[t][j][1] * v[t][j][1] + v[t][j][2] * v[t][j][2] + v[t][j][3] * v[t][j][3];
            ss = wave_sum(ss); const float rs = rsqrtf(ss * (1.f / D) + EPS);
#pragma unroll
            for (int j = 0; j < 4; ++j) { const f32x4 o = v[t][j] * rs * al[j] + be[j]; u32x2 pk; pk[0] = cvt_pk_bf16(o[0], o[1]); pk[1] = cvt_pk_bf16(o[2], o[3]);
                __builtin_nontemporal_store(pk, (u32x2*)(H + (size_t)(r0 + t) * D + 256 * j + 4 * lane));
                if (r0 < NTOK) __builtin_nontemporal_store(pack_fp8x4(o[0] * FP8_SHI, o[1] * FP8_SHI, o[2] * FP8_SHI, o[3] * FP8_SHI), (unsigned*)(H8 + (size_t)(r0 + t) * D + 256 * j + 4 * lane)); } }
    }
}

namespace at3 {
constexpr int PT = 72;
constexpr int O_K = 0, O_V = O_K + 2 * 64 * PT * 2, O_RP = O_V + 2 * 64 * PT * 2, O_END = O_RP + 8 * 15 * 31 * 4;
static_assert(O_END <= LDS_BARW, "attention LDS");
}
__device__ __forceinline__ f32x16 mfma32(const bf16x8 a, const bf16x8 b, const f32x16 c) { return __builtin_amdgcn_mfma_f32_32x32x16_bf16(a, b, c, 0, 0, 0); }
__device__ __forceinline__ void phase_attn(const Frame& F) {
    using namespace at3;
    constexpr float LOG2E = 1.4426950408889634f, SC = 0.125f * LOG2E;
    LAS bf16_t* Ks = (LAS bf16_t*)(F.lds + O_K); LAS bf16_t* Vs = (LAS bf16_t*)(F.lds + O_V); LAS float* rp = (LAS float*)(F.lds + O_RP);
    __syncthreads();
    { float rv[8];
#pragma unroll
      for (int r = 0; r < 8; ++r) { const int i = F.tid() + 512 * r; rv[r] = (i < 8 * 15 * 31) ? F.rpb()[i] : 0.f; }
#pragma unroll
      for (int r = 0; r < 8; ++r) { const int i = F.tid() + 512 * r; if (i < 8 * 15 * 31) rp[i] = rv[r] * LOG2E; } }
    const bf16_t* PL = WSP(bf16_t, WS_PLAT); const bf16_t* PCx = WSP(bf16_t, WS_PCTX); const bf16_t* VTL = WSP(bf16_t, WS_VTL); const bf16_t* VTC = WSP(bf16_t, WS_VTC);
    bf16_t* OC = WSP(bf16_t, WS_ONA);
    const int tid = F.tid(), lane = F.lane(), w = F.wave, l31 = lane & 31, h5 = lane >> 5, ch = w & 1, qc = 32 * ch + l31;
    const int srow = tid >> 3, sc16 = tid & 7;
    unsigned mbits = 0u; { const int cs = min(max(qc - 8, 0), 48);
#pragma unroll
        for (int kh = 0; kh < 2; ++kh)
#pragma unroll
            for (int i = 0; i < 16; ++i) { const int kc = 32 * kh + (i & 3) + 8 * (i >> 2) + 4 * h5; if (kc >= cs && kc < cs + 16) mbits |= 1u << (16 * kh + i); } }
    const int dcl = 4 * h5 - qc + 15;
    const int vcu = (F.G % 8 == 0) ? (F.blk % 8) * (F.G / 8) + F.blk / 8 : F.blk;
    int pass_ = 0;
    for (int idx = vcu; idx < NB * 8 * 8; idx += F.G, ++pass_) {
        const int rq = (idx + ((F.G % 8 == 0) ? pass_ : 0)) & 7, h = (idx >> 3) & 7, b = idx >> 6, r0 = 4 * rq, r = r0 + (w >> 1);
        const int rs = min(max(r - 4, 0), 24), kr_lo = min(max(r0 - 4, 0), 24), kr_hi = min(max(r0 - 1, 0), 24) + 7, ntile = 4 + (kr_hi - kr_lo + 1);
        const int qtok = b * SEQ + r * 64 + qc;
#define AT3_LOAD(t_, kreg, vreg) do { const bf16_t* kp_; const bf16_t* vp_; \
        if ((t_) < 4) { kp_ = PCx + (size_t)(b * CTXL + 64 * (t_) + srow) * LDPC + PC_NAK + 64 * h + 8 * sc16; vp_ = VTC + ((size_t)(b * 8 + h) * 64 + srow) * CTXL + 64 * (t_) + 8 * sc16; } \
        else { const int kr_ = kr_lo + (t_) - 4; kp_ = PL + (size_t)(b * SEQ + kr_ * 64 + srow) * LDP + PC_NAK + 64 * h + 8 * sc16; vp_ = VTL + ((size_t)(b * 8 + h) * 64 + srow) * SEQ + kr_ * 64 + 8 * sc16; } \
        asm volatile("global_load_dwordx4 %0, %1, off" : "=&v"(kreg) : "v"(kp_) : "memory"); asm volatile("global_load_dwordx4 %0, %1, off" : "=&v"(vreg) : "v"(vp_) : "memory"); } while (0)
#define AT3_WAIT(n, kreg, vreg) asm volatile("s_waitcnt vmcnt(" #n ")" : "+v"(kreg), "+v"(vreg) :: "memory")
        u32x4 kA, vA, kB, vB;
        AT3_LOAD(0, kA, vA);
        AT3_LOAD(1, kB, vB);
        bf16x8 qf[4];
#pragma unroll
        for (int ks = 0; ks < 4; ++ks) qf[ks] = __builtin_bit_cast(bf16x8, *(const u32x4*)(PL + (size_t)qtok * LDP + PC_NAQ + 64 * h + 16 * ks + 8 * h5));
#pragma unroll
        for (int ks = 0; ks < 4; ++ks) { const u32x4 qr = __builtin_bit_cast(u32x4, qf[ks]);
            union { bf16x8 v; unsigned u[4]; } qs;
#pragma unroll
            for (int z = 0; z < 4; ++z) qs.u[z] = cvt_pk_bf16(bf_lo(qr[z]) * SC, bf_hi(qr[z]) * SC);
            qf[ks] = qs.v; }
        f32x16 o[2];
#pragma unroll
        for (int dt = 0; dt < 2; ++dt)
#pragma unroll
            for (int i = 0; i < 16; ++i) o[dt][i] = 0.f;
        float m = -3.0e38f, ls = 0.f;
#define AT3_TILE(NEED, LOCAL) do { \
                f32x16 sa[2]; _Pragma("unroll") for (int kh = 0; kh < 2; ++kh) _Pragma("unroll") for (int i = 0; i < 16; ++i) sa[kh][i] = 0.f; \
                _Pragma("unroll") for (int ks = 0; ks < 4; ++ks) _Pragma("unroll") for (int kh = 0; kh < 2; ++kh)     \
                    sa[kh] = mfma32(*(const LAS bf16x8*)(Kb + (32 * kh + l31) * PT + 16 * ks + 8 * h5), qf[ks], sa[kh]); \
                f32x2 v2[2][8]; float mx = -3.0e38f; f32x2 bs2[2][8]; \
                if (LOCAL) { _Pragma("unroll") for (int kh = 0; kh < 2; ++kh) _Pragma("unroll") for (int z = 0; z < 8; ++z) if (NEED(kh, z >> 1)) {     \
                    bs2[kh][z][0] = rph[32 * kh + 2 * (z & 1) + 8 * (z >> 1)]; bs2[kh][z][1] = rph[32 * kh + 2 * (z & 1) + 1 + 8 * (z >> 1)]; } } \
                _Pragma("unroll") for (int kh = 0; kh < 2; ++kh) _Pragma("unroll") for (int z = 0; z < 8; ++z) { if (NEED(kh, z >> 1)) { float s0 = sa[kh][2 * z], s1 = sa[kh][2 * z + 1]; \
                    if (LOCAL) { s0 += bs2[kh][z][0]; s1 += bs2[kh][z][1]; s0 = ((mbits >> (16 * kh + 2 * z)) & 1u) ? s0 : -1.0e30f; s1 = ((mbits >> (16 * kh + 2 * z + 1)) & 1u) ? s1 : -1.0e30f; } \
                    v2[kh][z] = (f32x2){s0, s1}; mx = fmaxf(mx, fmaxf(s0, s1)); } else v2[kh][z] = (f32x2){0.f, 0.f}; } \
                if (__any(mx > m)) { mx = fmaxf(mx, __shfl_xor(mx, 32)); const float mn = fmaxf(m, mx), al = __builtin_amdgcn_exp2f(m - mn); ls *= al; m = mn;     \
                    _Pragma("unroll") for (int dt = 0; dt < 2; ++dt) _Pragma("unroll") for (int i = 0; i < 16; ++i) o[dt][i] *= al; } \
                f32x2 ps2 = (f32x2){0.f, 0.f}; const f32x2 m2 = (f32x2){m, m}; \
                _Pragma("unroll") for (int kh = 0; kh < 2; ++kh) _Pragma("unroll") for (int z = 0; z < 8; ++z) if (NEED(kh, z >> 1)) { const f32x2 d = v2[kh][z] - m2; \
                    v2[kh][z][0] = __builtin_amdgcn_exp2f(d[0]); v2[kh][z][1] = __builtin_amdgcn_exp2f(d[1]); ps2 += v2[kh][z]; } \
                ls += ps2[0] + ps2[1]; \
                _Pragma("unroll") for (int kh = 0; kh < 2; ++kh) _Pragma("unroll") for (int s2 = 0; s2 < 2; ++s2) if (NEED(kh, 2 * s2) || NEED(kh, 2 * s2 + 1)) { \
                    union { bf16x8 v; unsigned u[4]; } pf; \
                    _Pragma("unroll") for (int z = 0; z < 4; ++z) pf.u[z] = cvt_pk_bf16(v2[kh][4 * s2 + z][0], v2[kh][4 * s2 + z][1]); \
                    _Pragma("unroll") for (int dt = 0; dt < 2; ++dt) { union { bf16x8 v; u32x2 u[2]; } vf; \
                        vf.u[0] = *(const LAS u32x2*)(Vb + (32 * dt + l31) * PT + 32 * kh + 16 * s2 + 4 * h5); vf.u[1] = *(const LAS u32x2*)(Vb + (32 * dt + l31) * PT + 32 * kh + 16 * s2 + 8 + 4 * h5); \
                        o[dt] = mfma32(vf.v, pf.v, o[dt]); } } } while (0)
#define AT3_ALL(kh, jg) true
#define AT3_N0(kh, jg) ((kh) == 0 || (jg) == 0)
#define AT3_N1(kh, jg) ((kh) == 1 || (jg) == 3)
#define AT3_STEP(t, kw, vw) do { \
            const LAS bf16_t* Kb = Ks + ((t) & 1) * 64 * PT; const LAS bf16_t* Vb = Vs + ((t) & 1) * 64 * PT; \
            const bool loc = (t) >= 4; const int kr = kr_lo + (t) - 4; \
            if (!loc) { const LAS float* rph = rp; AT3_TILE(AT3_ALL, false); } \
            else if (kr >= rs && kr < rs + 8) { \
                const LAS float* rph = rp + (h * 15 + (kr - r + 7)) * 31 + dcl; \
                if (ch == 0) AT3_TILE(AT3_N0, true); else AT3_TILE(AT3_N1, true); \
            } \
            if ((t) + 1 < ntile) { LAS bf16_t* Kn = Ks + (((t) + 1) & 1) * 64 * PT; LAS bf16_t* Vn = Vs + (((t) + 1) & 1) * 64 * PT; \
                AT3_WAIT(2, kw, vw); *(LAS u32x4*)(Kn + srow * PT + 8 * sc16) = kw; *(LAS u32x4*)(Vn + srow * PT + 8 * sc16) = vw; } \
            { const int tn_ = min((t) + 3, ntile - 1); AT3_LOAD(tn_, kw, vw); }     \
            __syncthreads(); } while (0)
        __syncthreads();
        AT3_WAIT(2, kA, vA); *(LAS u32x4*)(Ks + srow * PT + 8 * sc16) = kA; *(LAS u32x4*)(Vs + srow * PT + 8 * sc16) = vA;
        AT3_LOAD(2, kA, vA);
        __syncthreads();
        for (int t = 0;;) {
            AT3_STEP(t, kB, vB);
            if (t + 1 >= ntile) break;
            AT3_STEP(t + 1, kA, vA);
            t += 2; if (t >= ntile) break;
        }
#undef AT3_STEP
#undef AT3_TILE
#undef AT3_ALL
#undef AT3_N0
#undef AT3_N1
#undef AT3_LOAD
#undef AT3_WAIT
        asm volatile("s_waitcnt vmcnt(0)" ::: "memory");
        ls += __shfl_xor(ls, 32); const float inv = __builtin_amdgcn_rcpf(ls);
#pragma unroll
        for (int dt = 0; dt < 2; ++dt)
#pragma unroll
            for (int jj = 0; jj < 4; ++jj) { u32x2 pk; pk[0] = cvt_pk_bf16(o[dt][4 * jj] * inv, o[dt][4 * jj + 1] * inv); pk[1] = cvt_pk_bf16(o[dt][4 * jj + 2] * inv, o[dt][4 * jj + 3] * inv);
                *(u32x2*)(OC + (size_t)qtok * 1024 + 64 * h + 32 * dt + 8 * jj + 4 * h5) = pk; }
    }
}

namespace ml {
constexpr int PT = 72;
constexpr int NPOS = 36 * 64;
constexpr int A_KW = 0, A_VT = A_KW + 2 * 64 * PT * 2, A_A = A_VT + 2 * 128 * PT * 2;
constexpr int A_M = A_A + NPOS * 4, A_WI = A_M + NPOS * 4, A_FL = A_WI + NPOS * 4, A_WS = A_FL + NPOS * 4, A_B = A_WS + NPOS * 4, A_PM = A_B + NPOS * 4;
constexpr int A_N = A_PM + NPOS * 4;
constexpr int A_MC = A_N + 256;
constexpr int A_END = A_MC + 1024;
static_assert(A_END <= LDS_BARW, "mlstm pass A LDS");
constexpr int B_K = 0, B_VT = B_K + 64 * PT * 2, B_CF = B_VT + 128 * PT * 2, B_CB = B_CF + 144 * PT * 2, B_SLOT = B_CB + 144 * PT * 2;
static_assert(2 * B_SLOT <= LDS_BARW, "mlstm pass B LDS");
constexpr int CT_ROWS = 132, CT_STRIDE = CT_ROWS * 64;
}
constexpr size_t DO_CT = 0;

__device__ __forceinline__ void phase_mlstm_states(const Frame& F) {
    using namespace ml;
    LAS unsigned char* L = F.lds;
    LAS bf16_t* Kw = (LAS bf16_t*)(L + A_KW); LAS bf16_t* Vt = (LAS bf16_t*)(L + A_VT);
    LAS float* Aa = (LAS float*)(L + A_A); LAS float* Mm = (LAS float*)(L + A_M); LAS float* Wi = (LAS float*)(L + A_WI); LAS float* Fl = (LAS float*)(L + A_FL);
    LAS float* Ws = (LAS float*)(L + A_WS); LAS float* Bb = (LAS float*)(L + A_B); LAS float* Pm = (LAS float*)(L + A_PM);
    LAS float* nS = (LAS float*)(L + A_N); LAS float* mc = (LAS float*)(L + A_MC);
    const float* gates = WSP(float, WS_GATES); float* PP = WSP(float, WS_LTOK);
    const bf16_t* MKT = (const bf16_t*)((const char*)F.out() + DO_MKT); const bf16_t* MKTC = (const bf16_t*)((const char*)F.out() + DO_MKTC);
    const bf16_t* MVT = (const bf16_t*)((const char*)F.out() + DO_MVT); const bf16_t* MVTC = (const bf16_t*)((const char*)F.out() + DO_MVTC);
    bf16_t* CT = (bf16_t*)((char*)F.out() + DO_CT);
    const int tid = F.tid(), lane = F.lane(), w = F.wave, l31 = lane & 31, lh = lane >> 5;
    for (int task = F.blk; task < NB * 4 * 2; task += F.G) {
        const int dir = task & 1, h = (task >> 1) & 3, b = task >> 3;
        __syncthreads();
        const float bi = F.b_gates()[(2 * dir) * 4 + h], bfg = F.b_gates()[(2 * dir + 1) * 4 + h];
        float gri[5], grf[5];
#pragma unroll
        for (int q = 0; q < 5; ++q) { const int ci = min(w + 8 * q, 35); int grow;
            if (ci < 4) grow = NTOK + b * CTXL + 64 * (dir ? 3 - ci : ci) + (dir ? 63 - lane : lane);
            else grow = b * SEQ + 64 * (dir ? 31 - (ci - 4) : (ci - 4)) + (dir ? 63 - lane : lane);
            gri[q] = gates[(size_t)grow * 16 + (2 * dir) * 4 + h]; grf[q] = gates[(size_t)grow * 16 + (2 * dir + 1) * 4 + h]; }
#pragma unroll
        for (int q = 0; q < 5; ++q) { const int ci = w + 8 * q; if (ci >= 36) break;
            const float ri = gri[q] + bi, rf = grf[q] + bfg;
            const float li = 15.f * tanhf(ri * (1.f / 15.f)), gf = 15.f * tanhf(rf * (1.f / 15.f));
            const float lf = fminf(gf, 0.f) - log1pf(__expf(-fabsf(gf)));
            float bc = lf;
#pragma unroll
            for (int o = 1; o < 64; o <<= 1) { const float t = __shfl_up(bc, o); if (lane >= o) bc += t; }
            const float a = li - bc; float pm = a;
#pragma unroll
            for (int o = 1; o < 64; o <<= 1) { const float t = __shfl_up(pm, o); if (lane >= o) pm = fmaxf(pm, t); }
            Aa[ci * 64 + lane] = a; Bb[ci * 64 + lane] = bc; Pm[ci * 64 + lane] = pm;
            if (lane == 63) { mc[64 + ci] = bc; mc[128 + ci] = bc + pm; }
        }
        for (int i = tid; i < 64; i += 512) nS[i] = 0.f;
        __syncthreads();
        if (tid == 0) { float m = 0.f; mc[0] = 0.f; for (int ci = 0; ci < 36; ++ci) { const float mn = fmaxf(mc[64 + ci] + m, mc[128 + ci]); mc[192 + ci] = __expf(mc[64 + ci] + m - mn); m = mn; mc[ci + 1] = m; } }
        __syncthreads();
        float* pp = PP + (size_t)((b * 4 + h) * 2 + dir) * 4 * SEQ;
        for (int p = tid; p < NPOS; p += 512) { const int ci = p >> 6, sp = p & 63; const float m0 = mc[ci], m1 = mc[ci + 1], bL = mc[64 + ci];
            const float M = fmaxf(m0, Pm[p]), wi = __expf(m0 - M), fl = __expf(-(Bb[p] + M)); Ws[p] = __expf(bL + Aa[p] - m1);
            if (ci >= 4) { const int cj = dir ? 31 - (ci - 4) : ci - 4, tk = 64 * cj + (dir ? 63 - sp : sp);
                pp[tk] = Aa[p]; pp[SEQ + tk] = M; pp[2 * SEQ + tk] = wi; pp[3 * SEQ + tk] = fl; } }
        __syncthreads();
        f32x16 cacc;
#pragma unroll
        for (int i = 0; i < 16; ++i) cacc[i] = 0.f;
        const int kd = tid >> 3, kj = tid & 7;
        const int ve = tid >> 2, vj = tid & 3;
        const int tm = w >> 2, te = w & 3;
#define MLA_SRC(c, kp, vp) do { if ((c) < 4) { const int tb_ = 64 * (dir ? 3 - (c) : (c)); kp = MKTC + ((size_t)(b * 4 + h) * 64 + kd) * CTXL + tb_ + 8 * kj; vp = MVTC + ((size_t)(b * 4 + h) * 128 + ve) * CTXL + tb_ + 16 * vj; } \
        else { const int tb_ = 64 * (dir ? 31 - ((c) - 4) : (c) - 4); kp = MKT + ((size_t)(b * 4 + h) * 64 + kd) * SEQ + tb_ + 8 * kj; vp = MVT + ((size_t)(b * 4 + h) * 128 + ve) * SEQ + tb_ + 16 * vj; } } while (0)
        u32x4 kr, v0, v1, kr2, v02, v12;
        { const bf16_t* kp; const bf16_t* vp; MLA_SRC(0, kp, vp); kr = __builtin_nontemporal_load((const u32x4*)kp); v0 = __builtin_nontemporal_load((const u32x4*)vp); v1 = __builtin_nontemporal_load((const u32x4*)(vp + 8));
          MLA_SRC(1, kp, vp); kr2 = __builtin_nontemporal_load((const u32x4*)kp); v02 = __builtin_nontemporal_load((const u32x4*)vp); v12 = __builtin_nontemporal_load((const u32x4*)(vp + 8)); }
        for (int ci = 0; ci < 36; ++ci) {
            LAS bf16_t* Kwb = Kw + (ci & 1) * 64 * PT; LAS bf16_t* Vtb = Vt + (ci & 1) * 128 * PT;
            {
                u32x4 kp4;
#pragma unroll
                for (int q = 0; q < 4; ++q) { const int j0 = 8 * kj + 2 * q; const float w0 = Ws[ci * 64 + (dir ? 63 - j0 : j0)], w1 = Ws[ci * 64 + (dir ? 62 - j0 : j0 + 1)];
                    kp4[q] = cvt_pk_bf16(bf_lo(kr[q]) * w0, bf_hi(kr[q]) * w1); }
                *(LAS u32x4*)(Kwb + kd * PT + 8 * kj) = kp4;
                *(LAS u32x4*)(Vtb + ve * PT + 16 * vj) = v0; *(LAS u32x4*)(Vtb + ve * PT + 16 * vj + 8) = v1;
            }
            kr = kr2; v0 = v02; v1 = v12;
            if (ci + 2 < 36) { const bf16_t* kp; const bf16_t* vp; MLA_SRC(ci + 2, kp, vp); kr2 = __builtin_nontemporal_load((const u32x4*)kp); v02 = __builtin_nontemporal_load((const u32x4*)vp); v12 = __builtin_nontemporal_load((const u32x4*)(vp + 8)); }
            __syncthreads();
            if (ci >= 4) {
                const int cj = dir ? 31 - (ci - 4) : ci - 4; bf16_t* cg = CT + ((size_t)(((b * 4 + h) * 2 + dir) * 32 + cj)) * CT_STRIDE;
#pragma unroll
                for (int j = 0; j < 4; ++j) { u32x2 pk; pk[0] = cvt_pk_bf16(cacc[4 * j], cacc[4 * j + 1]); pk[1] = cvt_pk_bf16(cacc[4 * j + 2], cacc[4 * j + 3]);
                    *(u32x2*)(cg + (size_t)(32 * te + l31) * 64 + 32 * tm + 8 * j + 4 * lh) = pk; }
                if (w == 0) cg[128 * 64 + lane] = f2bf(nS[lane]);
            }
            {
                const float wc = mc[192 + ci];
#pragma unroll
                for (int i = 0; i < 16; ++i) cacc[i] *= wc;
#pragma unroll
                for (int ks = 0; ks < 4; ++ks) { const bf16x8 a = *(const LAS bf16x8*)(Kwb + (32 * tm + l31) * PT + 16 * ks + 8 * lh), bq = *(const LAS bf16x8*)(Vtb + (32 * te + l31) * PT + 16 * ks + 8 * lh);
                    cacc = mfma32(a, bq, cacc); }
                if (w == 0) { float kn = 0.f;
#pragma unroll
                    for (int q = 0; q < 8; ++q) { const u32x4 kv = *(const LAS u32x4*)(Kwb + lane * PT + 8 * q);
#pragma unroll
                        for (int z = 0; z < 4; ++z) kn += bf_lo(kv[z]) + bf_hi(kv[z]); }
                    nS[lane] = wc * nS[lane] + kn; }
            }
        }
#undef MLA_SRC
    }
}

__device__ __forceinline__ void phase_mlstm_out(const Frame& F) {
    using namespace ml;
    const bf16_t* PL = WSP(bf16_t, WS_PLAT); const float* PP = WSP(float, WS_LTOK); bf16_t* OC = WSP(bf16_t, WS_ONA) + 512;
    const bf16_t* MVT = (const bf16_t*)((const char*)F.out() + DO_MVT); const bf16_t* CT = (const bf16_t*)((const char*)F.out() + DO_CT);
    const int tid = F.tid(), lane = F.lane(), w = F.wave, slot = w >> 2, tt = w & 3, l15 = lane & 15, g = lane >> 4, t2 = tid & 255;
    LAS bf16_t* Ks = (LAS bf16_t*)(F.lds + slot * B_SLOT + B_K); LAS bf16_t* Vt = (LAS bf16_t*)(F.lds + slot * B_SLOT + B_VT);
    LAS bf16_t* Cf = (LAS bf16_t*)(F.lds + slot * B_SLOT + B_CF); LAS bf16_t* Cb = (LAS bf16_t*)(F.lds + slot * B_SLOT + B_CB);
    __syncthreads();
    for (int i = t2; i < 15 * PT / 2; i += 256) { ((LAS unsigned*)(Cf + 129 * PT))[i] = 0u; ((LAS unsigned*)(Cb + 129 * PT))[i] = 0u; }
    static_assert(2 * B_SLOT + 2048 <= LDS_BARW, "mlstm pass B LDS (head-norm gains)");
    LAS float* ghl = (LAS float*)(F.lds + 2 * B_SLOT);
    if (tid < 512) ghl[tid] = F.g_head()[tid];
    constexpr int NTASK = NB * 4 * 32;
    u32x4 rk[2], rv[4], rf[5], rb[5];
#define MLB_LOAD(task_) do { const int c_ = (task_) & 31, h_ = ((task_) >> 5) & 3, b_ = (task_) >> 7; \
        _Pragma("unroll") for (int i = 0; i < 2; ++i) { const int c = t2 + 256 * i; rk[i] = *(const u32x4*)(PL + (size_t)(b_ * SEQ + 64 * c_ + (c >> 3)) * LDP + PC_MLK + 64 * h_ + 8 * (c & 7)); } \
        _Pragma("unroll") for (int i = 0; i < 4; ++i) { const int c = t2 + 256 * i; rv[i] = __builtin_nontemporal_load((const u32x4*)(MVT + ((size_t)(b_ * 4 + h_) * 128 + (c >> 3)) * SEQ + 64 * c_ + 8 * (c & 7))); } \
        const bf16_t* cf_ = CT + (size_t)(((b_ * 4 + h_) * 2 + 0) * 32 + c_) * CT_STRIDE; const bf16_t* cb_ = cf_ + (size_t)32 * CT_STRIDE; \
        _Pragma("unroll") for (int i = 0; i < 5; ++i) { const int c = t2 + 256 * i; if (c < 129 * 8) { rf[i] = __builtin_nontemporal_load((const u32x4*)(cf_ + 8 * c)); rb[i] = __builtin_nontemporal_load((const u32x4*)(cb_ + 8 * c)); } } } while (0)
    int task = 2 * F.blk + slot;
    if (task < NTASK) MLB_LOAD(task);
    for (; task - slot < NTASK; task += 2 * F.G) {
        const bool live = task < NTASK;
        const int tkc = live ? task : NTASK - 1;
        const int cj = tkc & 31, h = (tkc >> 5) & 3, b = tkc >> 7;
        const int tokq = b * SEQ + 64 * cj + 16 * tt + l15;
        bf16x8 qf[2];
#pragma unroll
        for (int ks = 0; ks < 2; ++ks) qf[ks] = *(const bf16x8*)(PL + (size_t)tokq * LDP + PC_MLQ + 64 * h + 32 * ks + 8 * g);
        float Mq2[2], wiq2[2], flq2[2]; f32x4 av2[2][4]; u32x2 op2[8];
#pragma unroll
        for (int dir = 0; dir < 2; ++dir) { const float* pp = PP + (size_t)((b * 4 + h) * 2 + dir) * 4 * SEQ + 64 * cj;
            Mq2[dir] = pp[SEQ + 16 * tt + l15]; wiq2[dir] = pp[2 * SEQ + 16 * tt + l15]; flq2[dir] = pp[3 * SEQ + 16 * tt + l15];
#pragma unroll
            for (int st = 0; st < 4; ++st) av2[dir][st] = *(const f32x4*)(pp + 16 * st + 4 * g); }
#pragma unroll
        for (int et = 0; et < 8; ++et) op2[et] = *(const u32x2*)(PL + (size_t)tokq * LDP + PC_MLO + 128 * h + 16 * et + 4 * g);
        asm volatile("" ::: "memory");
        __syncthreads();
        if (live) {
#pragma unroll
            for (int i = 0; i < 2; ++i) { const int c = t2 + 256 * i; *(LAS u32x4*)(Ks + (c >> 3) * PT + 8 * (c & 7)) = rk[i]; }
#pragma unroll
            for (int i = 0; i < 4; ++i) { const int c = t2 + 256 * i; *(LAS u32x4*)(Vt + (c >> 3) * PT + 8 * (c & 7)) = rv[i]; }
#pragma unroll
            for (int i = 0; i < 5; ++i) { const int c = t2 + 256 * i; if (c < 129 * 8) { *(LAS u32x4*)(Cf + (c >> 3) * PT + 8 * (c & 7)) = rf[i]; *(LAS u32x4*)(Cb + (c >> 3) * PT + 8 * (c & 7)) = rb[i]; } }
        }
        { const int tn_ = (task + 2 * F.G < NTASK) ? task + 2 * F.G : tkc; MLB_LOAD(tn_); }
        asm volatile("" ::: "memory");
        __syncthreads();
        if (!live) continue;
        f32x4 raw[4];
#pragma unroll
        for (int st = 0; st < 4; ++st) { f32x4 acc = (f32x4){0.f, 0.f, 0.f, 0.f};
#pragma unroll
            for (int ks = 0; ks < 2; ++ks) acc = __builtin_amdgcn_mfma_f32_16x16x32_bf16(*(const LAS bf16x8*)(Ks + (16 * st + l15) * PT + 32 * ks + 8 * g), qf[ks], acc, 0, 0, 0);
            raw[st] = acc; }
        f32x4 hsum[8];
#pragma unroll
        for (int dir = 0; dir < 2; ++dir) {
            const float Mq = Mq2[dir], wiq = wiq2[dir], flq = flq2[dir];
            const LAS bf16_t* Cd = dir ? Cb : Cf;
            f32x4 o[9];
#pragma unroll
            for (int et = 0; et < 9; ++et) { f32x4 acc = (f32x4){0.f, 0.f, 0.f, 0.f};
#pragma unroll
                for (int ks = 0; ks < 2; ++ks) acc = __builtin_amdgcn_mfma_f32_16x16x32_bf16(*(const LAS bf16x8*)(Cd + (16 * et + l15) * PT + 32 * ks + 8 * g), qf[ks], acc, 0, 0, 0);
                o[et] = acc * wiq; }
            float dsum = 0.f;
#pragma unroll
            for (int pr = 0; pr < 2; ++pr) {
                float p[8];
#pragma unroll
                for (int z = 0; z < 2; ++z) { const int st = 2 * pr + z; const f32x4 av = av2[dir][st];
#pragma unroll
                    for (int i = 0; i < 4; ++i) { const int sk = 16 * st + 4 * g + i, tq = 16 * tt + l15; const bool ok = dir ? (sk >= tq) : (sk <= tq);
                        const float wgt = ok ? __expf(av[i] - Mq) : 0.f; p[4 * z + i] = raw[st][i] * wgt; dsum += p[4 * z + i]; } }
                union { bf16x8 v; unsigned u[4]; } pf;
                pf.u[0] = cvt_pk_bf16(p[0], p[1]); pf.u[1] = cvt_pk_bf16(p[2], p[3]); pf.u[2] = cvt_pk_bf16(p[4], p[5]); pf.u[3] = cvt_pk_bf16(p[6], p[7]);
#pragma unroll
                for (int et = 0; et < 8; ++et) { union { bf16x8 v; u32x2 u[2]; } vf;
                    vf.u[0] = *(const LAS u32x2*)(Vt + (16 * et + l15) * PT + 32 * pr + 4 * g); vf.u[1] = *(const LAS u32x2*)(Vt + (16 * et + l15) * PT + 32 * pr + 16 + 4 * g);
                    o[et] = __builtin_amdgcn_mfma_f32_16x16x32_bf16(vf.v, pf.v, o[et], 0, 0, 0); }
            }
            dsum += __shfl_xor(dsum, 16); dsum += __shfl_xor(dsum, 32);
            const float dint = __shfl(o[8][0], l15);
            const float inv = __builtin_amdgcn_rcpf(fmaxf(fabsf(dint + dsum), flq));
#pragma unroll
            for (int et = 0; et < 8; ++et) hsum[et] = dir ? hsum[et] + o[et] * inv : o[et] * inv;
        }
        float ss = 0.f;
#pragma unroll
        for (int et = 0; et < 8; ++et) ss += hsum[et][0] * hsum[et][0] + hsum[et][1] * hsum[et][1] + hsum[et][2] * hsum[et][2] + hsum[et][3] * hsum[et][3];
        ss += __shfl_xor(ss, 16); ss += __shfl_xor(ss, 32);
        const float rs = rsqrtf(ss * (1.f / 128.f) + EPS);
#pragma unroll
        for (int et = 0; et < 8; ++et) { const f32x4 gh = *(const LAS f32x4*)(ghl + 128 * h + 16 * et + 4 * g);
            const u32x2 op = op2[et];
            u32x2 pk; pk[0] = cvt_pk_bf16(sigmoidf_(bf_lo(op[0])) * hsum[et][0] * rs * gh[0], sigmoidf_(bf_hi(op[0])) * hsum[et][1] * rs * gh[1]);
            pk[1] = cvt_pk_bf16(sigmoidf_(bf_lo(op[1])) * hsum[et][2] * rs * gh[2], sigmoidf_(bf_hi(op[1])) * hsum[et][3] * rs * gh[3]);
            *(u32x2*)(OC + (size_t)tokq * 1024 + 128 * h + 16 * et + 4 * g) = pk; }
    }
#undef MLB_LOAD
}

__device__ __forceinline__ f32x4 ldg4(const void* ubase, unsigned voff) { return *(const f32x4*)((const char*)ubase + voff); }
__device__ __forceinline__ u32x2 ldg2(const void* ubase, unsigned voff) { return *(const u32x2*)((const char*)ubase + voff); }
__device__ __forceinline__ f32x4 ldg4_nt(const void* ubase, unsigned voff) { return __builtin_nontemporal_load((const f32x4*)((const char*)ubase + voff)); }
__device__ __forceinline__ u32x2 ldg2_nt(const void* ubase, unsigned voff) { return __builtin_nontemporal_load((const u32x2*)((const char*)ubase + voff)); }
__device__ __forceinline__ void compute_x1(const Frame& F, int row, int b, const float* modv, const bf16_t* Y, unsigned lo16, f32x4 (&x1)[4]) {
    const bf16_t* yr = Y + (size_t)row * D; const float* xr = F.x() + (size_t)row * D; const float* gtr = modv + (size_t)b * 6144 + 2048;
    float ss = 0.f; f32x4 y[4];
#pragma unroll
    for (int j = 0; j < 4; ++j) { const u32x2 yp = ldg2_nt(yr + 256 * j, lo16 >> 1); y[j] = (f32x4){bf_lo(yp[0]), bf_hi(yp[0]), bf_lo(yp[1]), bf_hi(yp[1])};
        ss += y[j][0] * y[j][0] + y[j][1] * y[j][1] + y[j][2] * y[j][2] + y[j][3] * y[j][3]; }
    ss = wave_sum(ss); const float rs = rsqrtf(ss * (1.f / D) + EPS);
#pragma unroll
    for (int j = 0; j < 4; ++j) { const f32x4 xv = ldg4_nt(xr + 256 * j, lo16), gp = ldg4(F.g_mix_post() + 256 * j, lo16), gt = ldg4(gtr + 256 * j, lo16);
        x1[j] = xv + gt * (y[j] * rs * gp); }
}

template <int N> __device__ __forceinline__ void bfly(float (&v)[32], int lane) {
    const bool up = (lane & N) != 0;
#pragma unroll
    for (int i = 0; i < N; ++i) { const float send = up ? v[i] : v[i + N], keep = up ? v[i + N] : v[i]; v[i] = keep + __shfl_xor(send, N); }
    if constexpr (N > 1) bfly<N / 2>(v, lane);
}
__device__ __forceinline__ void phase_postmix(const Frame& F) {
    LAS float* Wl = (LAS float*)F.lds;
    LAS int* asg_e = (LAS int*)(F.lds + LDS_MISC); LAS float* asg_w = (LAS float*)(F.lds + LDS_MISC + 4096);
    LAS int* lcnt = (LAS int*)(F.lds + LDS_MISC + 8192); LAS int* gbase = lcnt + 32; LAS int* rank = (LAS int*)(F.lds + LDS_MISC + 8192 + 256);
    const float* modv = WSP(float, WS_MODV); const bf16_t* Y = WSP(bf16_t, WS_Y); bf16_t* Y1 = WSP(bf16_t, WS_Y); unsigned char* H2 = WSP(unsigned char, WS_H2);
    int* ltok = WSP(int, WS_LTOK); float* lw = WSP(float, WS_LW); unsigned* gcnt = F.ctl() + CW_GCNT;
    __syncthreads();
    {
        f32x4 wq[16];
#pragma unroll
        for (int r = 0; r < 16; ++r) wq[r] = *(const f32x4*)(F.w_router() + 4 * (F.tid() + 512 * r));
#pragma unroll
        for (int r = 0; r < 16; ++r) { const int q = F.tid() + 512 * r, k = q >> 3, eg = q & 7; const int j = k >> 8, ln = (k & 255) >> 2, ii = k & 3;
            *(LAS f32x4*)(Wl + (((j * 4 + ii) * 8 + eg) * 64 + ln) * 4) = wq[r]; } }
    if (F.tid() < 32) lcnt[F.tid()] = 0;
    __syncthreads();
    const int lane = F.lane();
    float brq[4];
#pragma unroll
    for (int q = 0; q < 4; ++q) brq[q] = F.b_router()[q * 8 + (lane & 7)];
    for (int gb0 = 0; gb0 < NTOK / 32; gb0 += 8 * F.G) {
        for (int it = 0; it < 8; ++it) {
            const int grp = gb0 + it * F.G + F.blk;
            if (grp >= NTOK / 32) { if (lane < 16) asg_e[(it * 32 + F.wave * 4) * 4 + lane] = -1; continue; }
            const int rl0 = it * 32 + F.wave * 4, row0 = grp * 32 + F.wave * 4; const int b = row0 / SEQ;
            f32x4 hv[4][4];
            {
                unsigned lo16 = (unsigned)lane * 16u; asm volatile("" : "+v"(lo16));
                const float* cbv = WSP(float, WS_COMB) + (size_t)b * 4096;
                f32x4 cA[4], cB[4], cC[4]; u32x2 yv[4][4];
#pragma unroll
                for (int j = 0; j < 4; ++j) { cA[j] = ldg4(cbv + 256 * j, lo16); cB[j] = ldg4(cbv + 1024 + 256 * j, lo16); cC[j] = ldg4(cbv + 2048 + 256 * j, lo16); }
#pragma unroll
                for (int t = 0; t < 4; ++t)
#pragma unroll
                    for (int j = 0; j < 4; ++j) { yv[t][j] = ldg2_nt(Y + (size_t)(row0 + t) * D + 256 * j, lo16 >> 1); hv[t][j] = ldg4_nt(F.x() + (size_t)(row0 + t) * D + 256 * j, lo16); }
#pragma unroll
                for (int j = 0; j < 4; ++j) { asm volatile("" : "+v"(cA[j])); asm volatile("" : "+v"(cB[j])); asm volatile("" : "+v"(cC[j])); }
#pragma unroll
                for (int t = 0; t < 4; ++t)
#pragma unroll
                    for (int j = 0; j < 4; ++j) { asm volatile("" : "+v"(yv[t][j])); asm volatile("" : "+v"(hv[t][j])); }
#pragma unroll
                for (int t = 0; t < 4; ++t) {
                    f32x4 y[4]; float sy = 0.f;
#pragma unroll
                    for (int j = 0; j < 4; ++j) { y[j] = (f32x4){bf_lo(yv[t][j][0]), bf_hi(yv[t][j][0]), bf_lo(yv[t][j][1]), bf_hi(yv[t][j][1])};
                        sy += y[j][0] * y[j][0] + y[j][1] * y[j][1] + y[j][2] * y[j][2] + y[j][3] * y[j][3]; }
                    sy = wave_sum(sy); const float rsy = rsqrtf(sy * (1.f / D) + EPS);
                    float ss = 0.f;
#pragma unroll
                    for (int j = 0; j < 4; ++j) { const f32x4 x1 = hv[t][j] + cA[j] * (y[j] * rsy); hv[t][j] = x1;
                        ss += x1[0] * x1[0] + x1[1] * x1[1] + x1[2] * x1[2] + x1[3] * x1[3];
                        u32x2 xb; xb[0] = cvt_pk_bf16(x1[0], x1[1]); xb[1] = cvt_pk_bf16(x1[2], x1[3]);
                        *(u32x2*)((char*)(Y1 + (size_t)(row0 + t) * D + 256 * j) + (lo16 >> 1)) = xb; }
                    ss = wave_sum(ss); const float rs = rsqrtf(ss * (1.f / D) + EPS);
                    unsigned char* hr = H2 + (size_t)(row0 + t) * D;
#pragma unroll
                    for (int j = 0; j < 4; ++j) { hv[t][j] = hv[t][j] * rs * cB[j] + cC[j];
                        *(unsigned*)(hr + 256 * j + (lo16 >> 2)) = pack_fp8x4(hv[t][j][0] * FP8_SH, hv[t][j][1] * FP8_SH, hv[t][j][2] * FP8_SH, hv[t][j][3] * FP8_SH); } }
            }
            asm volatile("" ::: "memory");
            float Lq[4] = {0.f, 0.f, 0.f, 0.f};
#pragma unroll 1
            for (int qd = 0; qd < 4; ++qd) {
                f32x2 a2[16];
#pragma unroll
                for (int i = 0; i < 16; ++i) a2[i] = (f32x2){0.f, 0.f};
#pragma unroll
                for (int j = 0; j < 4; ++j)
#pragma unroll
                    for (int ii = 0; ii < 4; ii += 2)
#pragma unroll
                        for (int eg = 0; eg < 2; ++eg) {
                            const f32x4 w0 = *(const LAS f32x4*)(Wl + (((j * 4 + ii) * 8 + qd * 2 + eg) * 64 + lane) * 4), w1 = *(const LAS f32x4*)(Wl + (((j * 4 + ii + 1) * 8 + qd * 2 + eg) * 64 + lane) * 4);
                            const f32x2 w0a = (f32x2){w0[0], w0[1]}, w0b = (f32x2){w0[2], w0[3]}, w1a = (f32x2){w1[0], w1[1]}, w1b = (f32x2){w1[2], w1[3]};
#pragma unroll
                            for (int t = 0; t < 4; ++t) { const f32x2 hx = (f32x2){hv[t][j][ii], hv[t][j][ii + 1]};
                                asm("v_pk_fma_f32 %0, %1, %2, %0 op_sel_hi:[0,1,1]" : "+v"(a2[t * 4 + eg * 2]) : "v"(hx), "v"(w0a));
                                asm("v_pk_fma_f32 %0, %1, %2, %0 op_sel_hi:[0,1,1]" : "+v"(a2[t * 4 + eg * 2 + 1]) : "v"(hx), "v"(w0b));
                                asm("v_pk_fma_f32 %0, %1, %2, %0 op_sel:[1,0,0]" : "+v"(a2[t * 4 + eg * 2]) : "v"(hx), "v"(w1a));
                                asm("v_pk_fma_f32 %0, %1, %2, %0 op_sel:[1,0,0]" : "+v"(a2[t * 4 + eg * 2 + 1]) : "v"(hx), "v"(w1b)); } }
                float v[32];
#pragma unroll
                for (int i = 0; i < 16; ++i) { v[2 * i] = a2[i][0]; v[2 * i + 1] = a2[i][1]; }
                bfly<16>(v, lane);
                const float lg = v[0] + __shfl_xor(v[0], 32) + (qd == 0 ? brq[0] : qd == 1 ? brq[1] : qd == 2 ? brq[2] : brq[3]);
#pragma unroll
                for (int z = 0; z < 4; ++z) Lq[z] = (z == qd) ? lg : Lq[z];
            }
            float tv[4]; int tix[4];
#pragma unroll
            for (int k = 0; k < 4; ++k) {
                float bv = Lq[0]; int bi = (lane & 7);
#pragma unroll
                for (int qd = 1; qd < 4; ++qd) { if (Lq[qd] > bv) { bv = Lq[qd]; bi = qd * 8 + (lane & 7); } }
#pragma unroll
                for (int o = 1; o < 8; o <<= 1) { const float ov = __shfl_xor(bv, o); const int oi = __shfl_xor(bi, o); if (ov > bv || (ov == bv && oi < bi)) { bv = ov; bi = oi; } }
                tv[k] = bv; tix[k] = bi;
                if ((bi & 7) == (lane & 7)) {
#pragma unroll
                    for (int qd = 0; qd < 4; ++qd) if ((bi >> 3) == qd) Lq[qd] = -3.0e38f; }
            }
            const float e1 = __expf(tv[1] - tv[0]), e2 = __expf(tv[2] - tv[0]), e3 = __expf(tv[3] - tv[0]); const float inv = 1.f / (1.f + e1 + e2 + e3);
            const int kk = lane & 7;
            if (lane < 32 && kk < 4) { const int tq = lane >> 3; const float wk = (kk == 0 ? 1.f : kk == 1 ? e1 : kk == 2 ? e2 : e3) * inv; const int ek = (kk == 0 ? tix[0] : kk == 1 ? tix[1] : kk == 2 ? tix[2] : tix[3]);
                asg_e[(rl0 + tq) * 4 + kk] = ek; asg_w[(rl0 + tq) * 4 + kk] = wk; }
        }
        __syncthreads();
        for (int i = F.tid(); i < 1024; i += 512) { const int e = asg_e[i]; rank[i] = (e >= 0) ? atomicAdd((int*)&lcnt[e], 1) : 0; }
        __syncthreads();
        if (F.tid() < 32) { gbase[F.tid()] = (int)atomicAdd(&gcnt[F.tid()], (unsigned)lcnt[F.tid()]); lcnt[F.tid()] = 0; }
        __syncthreads();
        for (int i = F.tid(); i < 1024; i += 512) { const int e = asg_e[i]; if (e < 0) continue; const int pos = gbase[e] + rank[i];
            const int rl = i >> 2, tokn = (gb0 + (rl >> 5) * F.G + F.blk) * 32 + (rl & 31);
            ltok[(size_t)e * NTOK + pos] = tokn * 4 + (i & 3); lw[(size_t)e * NTOK + pos] = asg_w[i]; }
        __syncthreads();
    }
}

__device__ __forceinline__ int moe_table(const Frame& F, LAS int* tstart, LAS int* cnt) {
    __syncthreads();
    if (F.tid() == 0) { const unsigned* gcnt = F.ctl() + CW_GCNT; int acc = 0; for (int e = 0; e < NEXP; ++e) { const int n = (int)gcnt[e]; cnt[e] = n; tstart[e] = acc; acc += (n + 255) >> 8; } tstart[NEXP] = acc; }
    __syncthreads();
    { const int NT_ = tstart[NEXP];
      for (int T = F.tid(); T < NT_; T += 512) { int e = 0; for (int j = 1; j < NEXP; ++j) e = (T >= tstart[j]) ? j : e; tstart[pg8::MOE_TEXP + T] = e; } }
    __syncthreads();
    return __builtin_amdgcn_readfirstlane(tstart[NEXP]);
}

__device__ __forceinline__ void phase_final(const Frame& F) {
    const float* modv = WSP(float, WS_MODV); const bf16_t* Y = WSP(bf16_t, WS_Y); const unsigned char* Ys = WSP(unsigned char, WS_YS);
    const int lane = F.lane();
    for (int row0 = (F.blk * 8 + F.wave) * 2; row0 < NTOK; row0 += F.G * 16) {
        const int b = row0 / SEQ;
        const unsigned lo16 = (unsigned)lane * 16u;
        f32x4 gtv[4];
#pragma unroll
        for (int j = 0; j < 4; ++j) gtv[j] = *(const f32x4*)(WSP(float, WS_COMB) + (size_t)b * 4096 + 3072 + 256 * j + 4 * lane);
        int yp[2][4][4];
#pragma unroll
        for (int t = 0; t < 2; ++t)
#pragma unroll
            for (int j = 0; j < 4; ++j)
#pragma unroll
                for (int k = 0; k < 4; ++k) yp[t][j][k] = __builtin_nontemporal_load((const int*)(Ys + ((size_t)(row0 + t) * 4 + k) * D + 256 * j + 4 * lane));
        u32x2 x1b[2][4];
#pragma unroll
        for (int t = 0; t < 2; ++t)
#pragma unroll
            for (int j = 0; j < 4; ++j) x1b[t][j] = ldg2_nt(Y + (size_t)(row0 + t) * D + 256 * j, lo16 >> 1);
#pragma unroll
        for (int j = 0; j < 4; ++j) asm volatile("" : "+v"(gtv[j]));
#pragma unroll
        for (int t = 0; t < 2; ++t)
#pragma unroll
            for (int j = 0; j < 4; ++j) {
#pragma unroll
                for (int k = 0; k < 4; ++k) asm volatile("" : "+v"(yp[t][j][k]));
                asm volatile("" : "+v"(x1b[t][j])); }
#pragma unroll
        for (int t = 0; t < 2; ++t) {
            f32x4 f[4]; float ss = 0.f;
#pragma unroll
            for (int j = 0; j < 4; ++j) { f[j] = (f32x4){0.f, 0.f, 0.f, 0.f};
#pragma unroll
                for (int k = 0; k < 4; ++k) { const f32x2 a = __builtin_amdgcn_cvt_pk_f32_fp8(yp[t][j][k], false), c = __builtin_amdgcn_cvt_pk_f32_fp8(yp[t][j][k], true); f[j] += (f32x4){a[0], a[1], c[0], c[1]}; }
                f[j] *= (1.f / FP8_SY);
                ss += f[j][0] * f[j][0] + f[j][1] * f[j][1] + f[j][2] * f[j][2] + f[j][3] * f[j][3]; }
            ss = wave_sum(ss); const float rs = rsqrtf(ss * (1.f / D) + EPS);
#pragma unroll
            for (int j = 0; j < 4; ++j) { const int k = 256 * j + 4 * lane; const f32x4 gt = gtv[j];
                const f32x4 x1v = (f32x4){bf_lo(x1b[t][j][0]), bf_hi(x1b[t][j][0]), bf_lo(x1b[t][j][1]), bf_hi(x1b[t][j][1])};
                __builtin_nontemporal_store(x1v + gt * (f[j] * rs), (f32x4*)(F.out() + (size_t)(row0 + t) * D + k)); }
        }
    }
}

__device__ __forceinline__ void phase_g2(const Frame& F) {
        { pg8::InSched16 S; S.init(WSP(bf16_t, WS_H), WSP(bf16_t, WS_BTIN), NTOK, NT_IN16 * 256, 2 * D, F.G, F.blk);
          EpiInProj<false> E{WSP(bf16_t, WS_PLAT), LDP, WSP(bf16_t, WS_VTL), SEQ, WSP(float, WS_GATES), (LAS bf16_t*)(F.lds + LDS_MISC),
                      (bf16_t*)((char*)F.out() + DO_MKT), (bf16_t*)((char*)F.out() + DO_MVT), WSP(float, WS_ROPE), true};
          pg8::gemm_phase(F.lds, 2 * D, S, E); }
        { pg8::InSched8 S; S.init(WSP(unsigned char, WS_H8), WSP(unsigned char, WS_BTIN8), NTOK, NT_IN8 * 256, D, F.G, F.blk);
          EpiInProj<true> E{WSP(bf16_t, WS_PLAT), LDP, WSP(bf16_t, WS_VTL), SEQ, WSP(float, WS_GATES), (LAS bf16_t*)(F.lds + LDS_MISC),
                      (bf16_t*)((char*)F.out() + DO_MKT), (bf16_t*)((char*)F.out() + DO_MVT), WSP(float, WS_ROPE), true};
          pg8::gemm_phase<EpiInProj<true>, pg8::InSched8, true>(F.lds, D, S, E); }
        { pg8::PlainSched S; S.init(WSP(bf16_t, WS_H) + (size_t)NTOK * D, WSP(bf16_t, WS_BTIN), NCTX, 2048, 2 * D, F.G, F.blk);
          EpiInProj<false> E{WSP(bf16_t, WS_PCTX), LDPC, WSP(bf16_t, WS_VTC), CTXL, WSP(float, WS_GATES) + (size_t)NTOK * 16, (LAS bf16_t*)(F.lds + LDS_MISC),
                      (bf16_t*)((char*)F.out() + DO_MKTC), (bf16_t*)((char*)F.out() + DO_MVTC), WSP(float, WS_ROPE), false};
          pg8::gemm_phase(F.lds, 2 * D, S, E); }
    }
__device__ __forceinline__ void phase_g5(const Frame& F) {
        bf16_t* merged = (bf16_t*)F.out(); bf16_t* T = merged + (size_t)NTOK * D;
        pg8::MixSched S; S.O = (const char*)WSP(bf16_t, WS_ONA); S.Wbr = (const char*)WSP(bf16_t, WS_BTBR); S.M = (const char*)merged; S.Wout = (const char*)WSP(bf16_t, WS_BTOUT);
        S.Kb = 2 * D; S.nM = NTOK / 256; S.G = F.G; S.c = F.blk;
        EpiMix E{WSP(bf16_t, WS_PLAT), T + (size_t)F.blk * 65536, merged, WSP(bf16_t, WS_Y)};
        pg8::gemm_phase(F.lds, 2 * D, S, E);
    }
__device__ __forceinline__ void phase_g8(const Frame& F) {
        LAS int* tstart = (LAS int*)(F.lds + LDS_MISC); LAS int* cnt = tstart + 64; LAS int* rowtok = tstart + 128;
        const int NT = moe_table(F, tstart, cnt);
        pg8::MoeSchedG S; S.tstart = tstart; S.cnt = cnt; S.Abase = (const char*)WSP(unsigned char, WS_H2); S.Abase_hi = nullptr;
        S.Bbase = (const char*)WSP(unsigned char, WS_WGL); S.bstride = (size_t)2048 * D; S.Kb = D;
        S.deal(NT, 8, F.G, F.blk); S.ltok = WSP(int, WS_LTOK); S.rowtok = rowtok;
        LAS float* biasl = (LAS float*)(F.lds + LDS_MISC + 4096); S.bgate = F.b_gate(); S.blin = F.b_lin(); S.biasl = biasl;
        EpiSwiglu E{(unsigned char*)F.out(), WSP(unsigned char, WS_AHI), biasl};
        pg8::gemm_phase<EpiSwiglu, pg8::MoeSchedG, true>(F.lds, D, S, E);
    }
__device__ __forceinline__ void phase_g9(const Frame& F) {
        LAS int* tstart = (LAS int*)(F.lds + LDS_MISC); LAS int* cnt = tstart + 64;
        const int NT = moe_table(F, tstart, cnt);
        pg8::MoeSchedD S; S.tstart = tstart; S.cnt = cnt; S.Abase = (const char*)F.out(); S.Abase_hi = (const char*)WSP(unsigned char, WS_AHI);
        S.Bbase = (const char*)F.out() + DO_WD; S.bstride = (size_t)D * D; S.Kb = D;
        S.deal(NT, 4, F.G, F.blk);
        LAS unsigned* edl = (LAS unsigned*)(F.lds + LDS_MISC + 4096); S.ltok = WSP(int, WS_LTOK); S.lw = WSP(float, WS_LW); S.bdown = F.b_down(); S.edl = edl;
        EpiDown E{WSP(unsigned char, WS_YS), edl, cnt};
        pg8::gemm_phase<EpiDown, pg8::MoeSchedD, true>(F.lds, D, S, E);
    }
__global__ void __launch_bounds__(512, 2) fwd(Args args) {
    extern __shared__ __attribute__((aligned(16))) unsigned char lds_raw[];
    Frame F;
    F.lds = (LAS unsigned char*)lds_raw; F.wave = __builtin_amdgcn_readfirstlane(F.tid() >> 6); F.G = gridDim.x; F.blk = blockIdx.x; F.out_ = args.out; F.ws_ = args.ws;
    const int lo = args.ph_lo, hi = args.ph_hi;
    if (F.tid() < 4) ((LAS unsigned*)(F.lds + LDS_BARW))[F.tid()] = 0u;
    __syncthreads();
    XcdBarrier bar; bar.bar = F.ctl(); bar.x = 0; bar.st = nullptr;
    if (hi - lo > 1) bar = xcd_barrier_post(F.ctl(), (volatile LAS unsigned*)(F.lds + LDS_BARW));
#ifndef PH_MASK
#define PH_MASK 0x7ff
#endif
#define IN(k) (((PH_MASK >> (k)) & 1) && lo <= (k) && (k) < hi)
#define SEAM(k) do { if (IN(k) && IN((k) + 1)) xcd_barrier(bar); } while (0)
#ifndef REPEAT_MASK
#define REPEAT_MASK 0
#endif

#define REP(k) (((REPEAT_MASK) >> (k)) & 1)
    if (IN(0)) { phase_ada(F); if (IN(1)) { const XbTok tk = xcd_arrive(bar); phase_cvt_small(F); xcd_wait(bar, tk); } else phase_cvt_small(F); }
    if (IN(1)) { phase_norm1(F); if constexpr (REP(1)) { xcd_barrier(bar); phase_norm1(F); } }
    SEAM(1);
    if (IN(2)) { phase_g2(F); if constexpr (REP(2)) { xcd_barrier(bar); phase_g2(F); } }
    SEAM(2);
    if (IN(3)) {
        if ((F.blk & 1) == 0) phase_cvt_experts(F, 0, NEXP * 256);
        phase_mlstm_states(F);
        XbTok tk3; tk3.role = 0u; tk3.gen = 0u; tk3.tg = 0u;
        if (IN(4)) tk3 = xcd_arrive(bar);
        phase_attn(F);
        if ((F.blk & 1) != 0) phase_cvt_experts(F, 0, NEXP * 256);
        if (IN(4)) xcd_wait(bar, tk3);
    }
    if (IN(4)) { phase_mlstm_out(F); if constexpr (REP(4)) { xcd_barrier(bar); phase_mlstm_out(F); } }
    SEAM(4);
    if (IN(5)) { phase_g5(F); if constexpr (REP(5)) { xcd_barrier(bar); phase_g5(F); } }
    if (IN(5) && IN(7)) { const XbTok tk = xcd_arrive(bar); phase_cvt_experts(F, NEXP * 256, NEXP * 384); xcd_wait(bar, tk); phase_postmix(F); }
    else if (IN(7)) { phase_cvt_experts(F, NEXP * 256, NEXP * 384); phase_postmix(F); }
    SEAM(7);
    if (IN(8)) { phase_g8(F); if constexpr (REP(8)) { xcd_barrier(bar); phase_g8(F); } }
    SEAM(8);
    if (IN(9)) { phase_g9(F); if constexpr (REP(9)) { xcd_barrier(bar); phase_g9(F); } }
    SEAM(9);
    if (IN(10)) { phase_final(F); if constexpr (REP(10)) { xcd_barrier(bar); phase_final(F); } }
#undef IN
#undef SEAM
}

extern "C" void kernel_launch(void* const* d_in, const int* in_sizes, int n_in, void* d_out, int out_size, void* d_ws, size_t ws_size, hipStream_t stream) {
    static int grid = 0;
    if (grid == 0) {
        if (n_in != 25 || out_size != NTOK * D || ws_size < WS_END) { fprintf(stderr, "kernel_launch: unexpected shapes (n_in %d out %d ws %zu)\n", n_in, out_size, ws_size); grid = -1; return; }
        int dev = 0, cus = 0, per_cu = 0;
        if (hipGetDevice(&dev) != hipSuccess || hipDeviceGetAttribute(&cus, hipDeviceAttributeMultiprocessorCount, dev) != hipSuccess) { grid = -1; return; }
        if (hipFuncSetAttribute((const void*)fwd, hipFuncAttributeMaxDynamicSharedMemorySize, LDS_BYTES) != hipSuccess) { fprintf(stderr, "kernel_launch: hipFuncSetAttribute failed\n"); grid = -1; return; }
        if (hipOccupancyMaxActiveBlocksPerMultiprocessor(&per_cu, (const void*)fwd, 512, LDS_BYTES) != hipSuccess || per_cu < 1) fprintf(stderr, "kernel_launch: occupancy query says %d\n", per_cu);
        (void)hipGetLastError();
        grid = cus;
    }
    if (grid < 0) return;
    (void)hipMemsetAsync((char*)d_ws + WS_CTL, 0, CTL_ZERO_BYTES, stream);
    Args a{};
    for (int i = 0; i < 25; ++i) a.in[i] = (const float*)d_in[i];
    a.out = (float*)d_out; a.ws = (unsigned char*)d_ws;
#if MK_ONE_LAUNCH
    a.ph_lo = 0; a.ph_hi = NPHASE;
    hipLaunchKernelGGL(fwd, dim3(grid), dim3(512), LDS_BYTES, stream, a);
#else
    for (int p = 0; p < NPHASE; ++p) { a.ph_lo = p; a.ph_hi = p + 1; hipLaunchKernelGGL(fwd, dim3(grid), dim3(512), LDS_BYTES, stream, a); }
#endif
}
```

```cpp
#include <hip/hip_runtime.h>
#include <cstdio>
#include <cstdint>

#ifndef MK_ONE_LAUNCH
#define MK_ONE_LAUNCH 1
#endif

#define LAS __attribute__((address_space(3)))
typedef unsigned short bf16_t;
typedef short bf16x8 __attribute__((ext_vector_type(8)));
typedef float f32x4 __attribute__((ext_vector_type(4)));
typedef float f32x2 __attribute__((ext_vector_type(2)));
typedef float f32x16 __attribute__((ext_vector_type(16)));
typedef unsigned u32x4 __attribute__((ext_vector_type(4)));
typedef unsigned u32x2 __attribute__((ext_vector_type(2)));
typedef int i32x4 __attribute__((ext_vector_type(4)));
typedef int i32x8 __attribute__((ext_vector_type(8)));
typedef long i64x2 __attribute__((ext_vector_type(2)));

constexpr int D = 1024, NB = 32, SEQ = 2048, NTOK = NB * SEQ, CTXL = 256, NCTX = NB * CTXL;
constexpr int NEXP = 32, TOPK = 4;
constexpr int LDP = 5120, LDPC = 1792;
constexpr int PC_NAK = 0, PC_MLK = 1024, PC_MLV = 1280, PC_NAQ = 1792, PC_MLQ = 2304, PC_MLO = 2560, PC_GNA = 3072, PC_GML = 4096;
constexpr int N_IN = 5376;
constexpr int W_IN_COLS = 5136;
constexpr float EPS = 1e-6f;
constexpr int NPHASE = 11;
constexpr float FP8_SHI = 16.f;
constexpr int N_IN16 = 2816, N_IN8 = 2560;
#ifndef INCFG
#define INCFG 3
#endif
#if INCFG == 0
constexpr int NT_IN16 = 11, NT_IN8 = 10;
__device__ __forceinline__ int in_map16(int i) { return i; }
__device__ __forceinline__ int in_map8(int i) { return i + 11; }
__device__ __forceinline__ bool in_is8(int t) { return t >= 11; }
#elif INCFG == 1
constexpr int NT_IN16 = 7, NT_IN8 = 14;
__device__ __forceinline__ int in_map16(int i) { return i + (i >= 2 ? 2 : 0) + (i >= 3 ? 2 : 0); }
__device__ __forceinline__ int in_map8(int i) { return i + 2 + (i >= 2 ? 1 : 0) + (i >= 4 ? 4 : 0); }
__device__ __forceinline__ bool in_is8(int t) { return t >= 11 || t == 2 || t == 3 || t == 5 || t == 6; }
#elif INCFG == 3
constexpr int NT_IN16 = 3, NT_IN8 = 18;
__device__ __forceinline__ int in_map16(int i) { return 4 + 3 * i; }
__device__ __forceinline__ int in_map8(int i) { return i + (i >= 4 ? 1 : 0) + (i >= 6 ? 1 : 0) + (i >= 8 ? 1 : 0); }
__device__ __forceinline__ bool in_is8(int t) { return t != 4 && t != 7 && t != 10; }
#else
constexpr int NT_IN16 = 1, NT_IN8 = 20;
__device__ __forceinline__ int in_map16(int i) { return 7; }
__device__ __forceinline__ int in_map8(int i) { return i + (i >= 7 ? 1 : 0); }
__device__ __forceinline__ bool in_is8(int t) { return t != 7; }
#endif
constexpr float FP8_SG = 256.f;
constexpr float FP8_SY = 32.f;
constexpr float FP8_SW = 64.f, FP8_SH = 8.f, FP8_SA = 8.f;
constexpr int LDS_BYTES = 147456;
constexpr int LDS_MISC = 131072;
constexpr int LDS_BARW = LDS_BYTES - 16;

constexpr size_t MiB = (size_t)1 << 20;
constexpr size_t WS_CTL = 0, CTL_ZERO_BYTES = 65536;
constexpr size_t WS_MODV = 1 * MiB;
constexpr size_t WS_BTIN = 2 * MiB;
constexpr size_t WS_BTBR = 13 * MiB;
constexpr size_t WS_BTOUT = 15 * MiB;
constexpr size_t WS_GATES = 17 * MiB;
constexpr size_t WS_ROPE = 21 * MiB + 512 * 1024;
constexpr size_t WS_COMB = 22 * MiB;
constexpr size_t WS_LTOK = 24 * MiB;
constexpr size_t WS_LW = 32 * MiB;
constexpr size_t WS_H = 40 * MiB;
constexpr size_t WS_ONA = 40 * MiB;
constexpr size_t WS_Y = 40 * MiB;
constexpr size_t WS_PLAT = 184 * MiB;
constexpr size_t WS_PCTX = 824 * MiB;
constexpr size_t WS_VTL = 852 * MiB;
constexpr size_t WS_VTC = 916 * MiB;
constexpr size_t WS_H8 = 924 * MiB;
constexpr size_t WS_BTIN8 = 996 * MiB;
constexpr size_t DO_WD = 160 * MiB;
constexpr size_t WS_AHI = 232 * MiB;
constexpr size_t WS_YS = 504 * MiB;
constexpr size_t WS_H2 = 504 * MiB;
constexpr size_t WS_WGL = 924 * MiB;
constexpr size_t WS_END = 1020 * MiB;
constexpr size_t DO_MKT = 132 * MiB, DO_MKTC = 164 * MiB, DO_MVT = 168 * MiB, DO_MVTC = 232 * MiB;
constexpr int PA_HID = 1152;
constexpr int A_LO_ROWS = 131072;
constexpr int CW_GCNT = 4096;

__device__ __forceinline__ unsigned cvt_pk_bf16(float lo, float hi) { unsigned r; asm volatile("v_cvt_pk_bf16_f32 %0, %1, %2" : "=v"(r) : "v"(lo), "v"(hi)); return r; }
__device__ __forceinline__ bf16_t f2bf(float f) { return (bf16_t)(cvt_pk_bf16(f, 0.f) & 0xffffu); }
__device__ __forceinline__ float bf_lo(unsigned u) { return __uint_as_float(u << 16); }
__device__ __forceinline__ float bf_hi(unsigned u) { return __uint_as_float(u & 0xffff0000u); }
__device__ __forceinline__ float bf2f(bf16_t b) { return __uint_as_float(((unsigned)b) << 16); }
__device__ __forceinline__ unsigned pack_fp8x4(float a, float b, float c, float d) {
    a = __builtin_amdgcn_fmed3f(a, -448.f, 448.f); b = __builtin_amdgcn_fmed3f(b, -448.f, 448.f); c = __builtin_amdgcn_fmed3f(c, -448.f, 448.f); d = __builtin_amdgcn_fmed3f(d, -448.f, 448.f);
    unsigned p = 0u; p = __builtin_amdgcn_cvt_pk_fp8_f32(a, b, p, false); p = __builtin_amdgcn_cvt_pk_fp8_f32(c, d, p, true); return p;
}
template <int N> __device__ __forceinline__ float dpp_ror(float v) { return __builtin_bit_cast(float, __builtin_amdgcn_update_dpp(0, __builtin_bit_cast(int, v), 0x120 + N, 0xf, 0xf, false)); }
__device__ __forceinline__ float wave_sum(float v) {
    v += dpp_ror<8>(v); v += dpp_ror<4>(v); v += dpp_ror<2>(v); v += dpp_ror<1>(v);
    v += __shfl_xor(v, 16); v += __shfl_xor(v, 32);
    return v;
}
__device__ __forceinline__ float sigmoidf_(float x) { return __builtin_amdgcn_rcpf(1.f + __builtin_amdgcn_exp2f(x * -1.4426950408889634f)); }

#define XB_TMO      128
#define XB_XCNT(j)  (256  + 64 * (j))
#define XB_XSUB(j)  (1280 + 64 * (j))
#define XB_XGEN(j)  (2304 + 64 * (j))
#define XB_TOP      3328
#define XB_TOPGEN   3392
#define XCD_BAR_WORDS 3456
#define XB_SPIN_CAP (1u << 18)
__device__ __forceinline__ unsigned xb_ld(unsigned* p)              { return __hip_atomic_load(p, __ATOMIC_RELAXED, __HIP_MEMORY_SCOPE_AGENT); }
__device__ __forceinline__ unsigned xb_add(unsigned* p, unsigned v) { return __hip_atomic_fetch_add(p, v, __ATOMIC_RELAXED, __HIP_MEMORY_SCOPE_AGENT); }
__device__ __forceinline__ unsigned xb_xcc_id() { return (unsigned)__builtin_amdgcn_s_getreg((3 << 11) | 20) & 0xFu; }
#define XB_SPIN(cond, bar) do { unsigned _sp = 0; while (cond) { __builtin_amdgcn_s_sleep(1); \
    if ((++_sp & 255u) == 0u) { if (xb_ld(&(bar)[XB_TMO])) break; if (_sp > XB_SPIN_CAP) { atomicAdd(&(bar)[XB_TMO], 1u); break; } } } } while (0)
struct XcdBarrier { unsigned* bar; unsigned x; volatile LAS unsigned* st; };
__device__ __forceinline__ XcdBarrier xcd_barrier_post(unsigned* bar, volatile LAS unsigned* st) {
    XcdBarrier b; b.bar = bar; b.x = xb_xcc_id(); b.st = st;
    if (threadIdx.x == 0) (void)xb_add(&bar[XB_XCNT(b.x)], 1u);
    return b;
}
__device__ __forceinline__ void xcd_barrier_complete(unsigned* bar, unsigned x, unsigned& nloc, unsigned& nx) {
    const unsigned G = gridDim.x * gridDim.y * gridDim.z;
    unsigned sum, cnt, mine, sp = 0u;
    for (;;) {
        sum = 0u; cnt = 0u; mine = 0u;
#pragma unroll
        for (unsigned j = 0; j < 16; ++j) { const unsigned c = xb_ld(&bar[XB_XCNT(j)]); sum += c; cnt += (c > 0u) ? 1u : 0u; mine = (j == x) ? c : mine; }
        if (sum == G) break;
        __builtin_amdgcn_s_sleep(1);
        if ((++sp & 255u) == 0u) { if (xb_ld(&bar[XB_TMO])) break; if (sp > XB_SPIN_CAP) { atomicAdd(&bar[XB_TMO], 1u); break; } }
    }
    nloc = mine > 0u ? mine : 1u; nx = cnt > 0u ? cnt : 1u;
}
__device__ __forceinline__ void xcd_barrier(const XcdBarrier& b) {
    asm volatile("s_waitcnt vmcnt(0)" ::: "memory");
    __syncthreads();
    if (threadIdx.x == 0) {
        unsigned* bar = b.bar;
        __builtin_amdgcn_s_waitcnt(0);
        unsigned nloc = b.st[0], nx = b.st[1];
        if (nloc == 0u) { xcd_barrier_complete(bar, b.x, nloc, nx); b.st[0] = nloc; b.st[1] = nx; }
        const unsigned old = xb_add(&bar[XB_XSUB(b.x)], 1u);
        const unsigned gen = old / nloc;
        if (old + 1u == (gen + 1u) * nloc) {
            __builtin_amdgcn_fence(__ATOMIC_RELEASE, "agent");
            asm volatile("s_waitcnt vmcnt(0)" ::: "memory");
            const unsigned og = xb_add(&bar[XB_TOP], 1u);
            const unsigned tg = og / nx;
            if (og + 1u == (tg + 1u) * nx) xb_add(&bar[XB_TOPGEN], 1u);
            else XB_SPIN(xb_ld(&bar[XB_TOPGEN]) == tg, bar);
            __builtin_amdgcn_fence(__ATOMIC_ACQUIRE, "agent");
            xb_add(&bar[XB_XGEN(b.x)], 1u);
            asm volatile("s_waitcnt vmcnt(0)" ::: "memory");
        } else {
            XB_SPIN((int)(xb_ld(&bar[XB_XGEN(b.x)]) - gen) <= 0, bar);
            __builtin_amdgcn_fence(__ATOMIC_ACQUIRE, "agent");
            asm volatile("s_waitcnt vmcnt(0)" ::: "memory");
        }
    }
    __syncthreads();
}

struct XbTok { unsigned role, gen, tg; };
__device__ __forceinline__ XbTok xcd_arrive(const XcdBarrier& b) {
    asm volatile("s_waitcnt vmcnt(0)" ::: "memory");
    __syncthreads();
    XbTok t; t.role = 0u; t.gen = 0u; t.tg = 0u;
    if (threadIdx.x == 0) {
        unsigned* bar = b.bar;
        __builtin_amdgcn_s_waitcnt(0);
        unsigned nloc = b.st[0], nx = b.st[1];
        if (nloc == 0u) { xcd_barrier_complete(bar, b.x, nloc, nx); b.st[0] = nloc; b.st[1] = nx; }
        const unsigned old = xb_add(&bar[XB_XSUB(b.x)], 1u);
        t.gen = old / nloc;
        if (old + 1u == (t.gen + 1u) * nloc) {
            __builtin_amdgcn_fence(__ATOMIC_RELEASE, "agent");
            asm volatile("s_waitcnt vmcnt(0)" ::: "memory");
            const unsigned og = xb_add(&bar[XB_TOP], 1u);
            t.tg = og / nx; t.role = 1u;
            if (og + 1u == (t.tg + 1u) * nx) { xb_add(&bar[XB_TOPGEN], 1u); t.role = 3u; }
        }
    }
    return t;
}
__device__ __forceinline__ void xcd_wait(const XcdBarrier& b, const XbTok& t) {
    if (threadIdx.x == 0) {
        unsigned* bar = b.bar;
        if (t.role != 0u) {
            if (t.role == 1u) XB_SPIN(xb_ld(&bar[XB_TOPGEN]) == t.tg, bar);
            __builtin_amdgcn_fence(__ATOMIC_ACQUIRE, "agent");
            xb_add(&bar[XB_XGEN(b.x)], 1u);
            asm volatile("s_waitcnt vmcnt(0)" ::: "memory");
        } else {
            XB_SPIN(xb_ld(&bar[XB_TOPGEN]) == t.gen, bar);
            __builtin_amdgcn_fence(__ATOMIC_ACQUIRE, "agent");
            asm volatile("s_waitcnt vmcnt(0)" ::: "memory");
        }
    }
    __syncthreads();
}

namespace pg8 {
constexpr int BM = 256, BK = 64, HALF = 128, HTB = HALF * BK * 2, STAGE_BYTES = 8 * HTB, NXCD = 8, WGM = 8;
__host__ __device__ __forceinline__ int lds_byte(int r, int c) { const int st = (r >> 4) * 2 + (c >> 5), rr = r & 15, cc = c & 31, ob = rr * 64 + cc * 2; return st * 1024 + (ob ^ (((ob >> 9) & 1) << 5)); }
__host__ __device__ __forceinline__ void stage_rc(int b, int& R, int& C) { const int st = b / 1024, sb = b % 1024, swz = sb ^ (((sb >> 9) & 1) << 5); R = (st >> 1) * 16 + swz / 64; C = (st & 1) * 32 + (swz % 64) / 2; }
__host__ __device__ __forceinline__ int perm32(int rho) { const int n = rho >> 4, i = rho & 15; return 8 * (i >> 2) + 4 * n + (i & 3); }

struct Unit { int pm, pn, e, tile, rb; };

struct PlainSched {
    static constexpr bool GATHER = false, ROWDMA = false, VARK = false;
    const void* A; const void* Bt; int Kb;
    int nM, nN, nwg, G, c;
    __device__ void init(const void* A_, const void* Bt_, int M, int N, int Kb_, int G_, int c_) { A = A_; Bt = Bt_; Kb = Kb_; nM = M / BM; nN = N / BM; nwg = nM * nN; G = G_; c = c_; }
    __device__ bool next(int i, Unit& u) const {
        const long L = (long)i * G + c; if (L >= nwg) return false;
        int wgid = (int)L; { const int q = nwg / NXCD, r = nwg % NXCD, xcd = wgid % NXCD, off = wgid / NXCD; wgid = (xcd < r ? xcd * (q + 1) : r * (q + 1) + (xcd - r) * q) + off; }
        const int nig = WGM * nN, gid = wgid / nig, fm = gid * WGM, gsz = (nM - fm) < WGM ? (nM - fm) : WGM;
        u.pm = fm + ((wgid % nig) % gsz); u.pn = (wgid % nig) / gsz; u.e = 0; u.tile = u.pm; u.rb = 0; return true;
    }
    __device__ __forceinline__ const char* a_ptr(const Unit& u) const { return (const char*)A + (size_t)u.pm * ((size_t)BM * Kb); }
    __device__ __forceinline__ const char* b_ptr(const Unit& u) const { return (const char*)Bt + (size_t)u.pn * ((size_t)BM * Kb); }
    __device__ __forceinline__ void a_offsets(const Unit&, unsigned (&v)[2][2]) const {
#pragma unroll
        for (int h = 0; h < 2; ++h)
#pragma unroll
            for (int i = 0; i < 2; ++i) { int R, C; stage_rc((int)threadIdx.x * 16 + i * 8192, R, C); v[h][i] = (unsigned)((R + HALF * h) * Kb + C * 2); }
    }
};

struct PlainSchedO : PlainSched {
    static constexpr bool GATHER = true, ROWDMA = false;
    __device__ __forceinline__ void a_offsets_h(const Unit&, int h, unsigned (&v)[2]) const {
#pragma unroll
        for (int i = 0; i < 2; ++i) { int R, C; stage_rc((int)threadIdx.x * 16 + i * 8192, R, C); unsigned o = (unsigned)((R + HALF * h) * Kb + C * 2); asm volatile("" : "+v"(o)); v[i] = o; }
    }
    __device__ __forceinline__ void a_offsets(const Unit& u, unsigned (&v)[2][2]) const { a_offsets_h(u, 0, v[0]); a_offsets_h(u, 1, v[1]); }
};
struct InSched16 : PlainSched {
    __device__ bool next(int i, Unit& u) const { if (!PlainSched::next(i, u)) return false; u.pn = in_map16(u.pn); return true; }
};
struct InSched8 : PlainSchedO {
    __device__ bool next(int i, Unit& u) const { if (!PlainSched::next(i, u)) return false; u.pn = in_map8(u.pn); return true; }
};
struct MixSched {
    static constexpr bool GATHER = false, ROWDMA = false, VARK = true;
    const char* O; const char* Wbr; const char* M; const char* Wout; int Kb, nM, G, c;
    __device__ bool next(int i, Unit& u) const {
        const int rt = i / 12, j = i - rt * 12, pm = c + rt * G; if (pm >= nM) return false;
        u.pm = pm; u.tile = pm; u.rb = 0;
        if (j < 8) { u.pn = j >> 1; u.e = j & 1; } else { u.pn = j - 8; u.e = 2; }
        return true;
    }
    __device__ __forceinline__ int nt(const Unit& u) const { return u.e == 2 ? 16 : 8; }
    __device__ __forceinline__ const char* a_ptr(const Unit& u) const { return (u.e == 2 ? M : O + u.e * 1024) + (size_t)u.pm * ((size_t)BM * 2048); }
    __device__ __forceinline__ const char* b_ptr(const Unit& u) const { return (u.e == 2 ? Wout : Wbr + u.e * 1024) + (size_t)u.pn * ((size_t)BM * 2048); }
    __device__ __forceinline__ void a_offsets(const Unit&, unsigned (&v)[2][2]) const {
#pragma unroll
        for (int h = 0; h < 2; ++h)
#pragma unroll
            for (int i = 0; i < 2; ++i) { int R, C; stage_rc((int)threadIdx.x * 16 + i * 8192, R, C); v[h][i] = (unsigned)((R + HALF * h) * 2048 + C * 2); }
    }
};
constexpr int MOE_TEXP = 2560;
struct MoeSched {
    static constexpr bool VARK = false;
    const LAS int* tstart;
    const LAS int* cnt;
    const char* Abase; const char* Abase_hi;
    const char* Bbase; size_t bstride;
    int Kb, T0, T1, slot, nslot, pn;
    __device__ void deal(int NT, int npn, int G, int blk) {
        const int X = (G % (8 * npn) == 0) ? 8 : 1, per = G / X, x = blk % X, c = blk / X;
        T0 = (int)((long)x * NT / X); T1 = (int)((long)(x + 1) * NT / X); pn = c % npn; slot = c / npn; nslot = per / npn;
    }
    __device__ bool next(int i, Unit& u) const {
        const int T = T0 + slot + nslot * i; if (T >= T1) return false;
        u.pn = pn; u.tile = T; u.rb = i & 1;
        const int e = __builtin_amdgcn_readfirstlane(tstart[MOE_TEXP + T]);
        u.e = e; u.pm = __builtin_amdgcn_readfirstlane(T - tstart[e]); return true;
    }
    __device__ __forceinline__ const char* b_ptr(const Unit& u) const { return Bbase + (size_t)u.e * bstride + (size_t)u.pn * ((size_t)BM * Kb); }
};
struct MoeSchedG : MoeSched {
    static constexpr bool GATHER = true, ROWDMA = true;
    const int* ltok; LAS int* rowtok;
    const float* bgate; const float* blin; LAS float* biasl;
    __device__ __forceinline__ const char* a_ptr(const Unit&) const { return Abase; }
    __device__ __forceinline__ void prefetch_rows(const Unit& u, int wid, int lane) const {
        if (wid < 4) __builtin_amdgcn_global_load_lds((const __attribute__((address_space(1))) unsigned*)(ltok + (size_t)u.e * NTOK + u.pm * BM + wid * 64) + lane, (LAS unsigned*)(rowtok + u.rb * BM + wid * 64), 4, 0, 0);
        else { const float* src = (wid < 6 ? bgate : blin) + (size_t)u.e * D + u.pn * 128 + (wid & 1) * 64;
            __builtin_amdgcn_global_load_lds((const __attribute__((address_space(1))) unsigned*)src + lane, (LAS unsigned*)(biasl + u.rb * 256 + (wid - 4) * 64), 4, 0, 0); }
    }
    __device__ __forceinline__ void a_offsets_h(const Unit& u, int h, unsigned (&v)[2]) const {
        const int n = cnt[u.e];
#pragma unroll
        for (int i = 0; i < 2; ++i) { int R, C; stage_rc((int)threadIdx.x * 16 + i * 8192, R, C); const int r = R + HALF * h; const int val = rowtok[u.rb * BM + r];
            const int tok = (u.pm * BM + r < n) ? (val >> 2) : 0; v[i] = (unsigned)(tok * Kb + C * 2); }
    }
    __device__ __forceinline__ void a_offsets(const Unit& u, unsigned (&v)[2][2]) const { a_offsets_h(u, 0, v[0]); a_offsets_h(u, 1, v[1]); }
};
struct MoeSchedD : MoeSched {
    static constexpr bool GATHER = true, ROWDMA = true;
    const int* ltok; const float* lw; const float* bdown; LAS unsigned* edl;
    __device__ __forceinline__ void prefetch_rows(const Unit& u, int wid, int lane) const {
        const size_t ro = (size_t)u.e * NTOK + u.pm * BM + (wid & 3) * 64;
        if (wid < 4) { __builtin_amdgcn_global_load_lds((const __attribute__((address_space(1))) unsigned*)(ltok + ro) + lane, edl + u.rb * 768 + wid * 64, 4, 0, 0);
            __builtin_amdgcn_global_load_lds((const __attribute__((address_space(1))) unsigned*)(bdown + (size_t)u.e * D + u.pn * 256 + wid * 64) + lane, edl + u.rb * 768 + 512 + wid * 64, 4, 0, 0); }
        else __builtin_amdgcn_global_load_lds((const __attribute__((address_space(1))) unsigned*)(lw + ro) + lane, edl + u.rb * 768 + 256 + (wid - 4) * 64, 4, 0, 0);
    }
    __device__ __forceinline__ const char* a_ptr(const Unit& u) const { const int r0 = __builtin_amdgcn_readfirstlane(u.tile) * BM; const bool lo_ = r0 < A_LO_ROWS;
        const char* base = lo_ ? Abase : Abase_hi; const int rr = lo_ ? r0 : r0 - A_LO_ROWS; return base + (size_t)rr * PA_HID; }
    __device__ __forceinline__ void a_offsets_h(const Unit&, int h, unsigned (&v)[2]) const {
#pragma unroll
        for (int i = 0; i < 2; ++i) { int R, C; stage_rc((int)threadIdx.x * 16 + i * 8192, R, C); unsigned o = (unsigned)((R + HALF * h) * PA_HID + C * 2); asm volatile("" : "+v"(o)); v[i] = o; }
    }
    __device__ __forceinline__ void a_offsets(const Unit& u, unsigned (&v)[2][2]) const { a_offsets_h(u, 0, v[0]); a_offsets_h(u, 1, v[1]); }
};

typedef f32x4 Acc[2][2][4][2];
template <class Epi, class Sched, bool FP8 = false>
__device__ __forceinline__ void gemm_phase(LAS unsigned char* lds, const int Kb, const Sched& S, const Epi& E) {
    const int tid = threadIdx.x, wid = __builtin_amdgcn_readfirstlane(tid >> 6), lane = tid & 63, wr = wid >> 2, wc = wid & 3, fr = lane & 15, fq = lane >> 4;
    const int nt = Kb / (BK * 2);
    unsigned voffB[2];
#pragma unroll
    for (int i = 0; i < 2; ++i) { int R, C; stage_rc(tid * 16 + i * 8192, R, C); const int Rb = (R & ~31) + perm32(R & 31);
        voffB[i] = (unsigned)(Rb * Kb + C * 2); }
    const size_t kstep = (size_t)(BK * 2);
    const size_t hstep = (size_t)HALF * Kb;
    const unsigned ldsw = (unsigned)wid * 1024u;
    const int aoff = lds_byte(wr * 64 + fr, fq * 8), boff = lds_byte(wc * 32 + fr, fq * 8);
#define PG8_SA(b, h) (((b) * 2 + (h)) * HTB)
#define PG8_SB(b, h) ((4 + (b) * 2 + (h)) * HTB)
#define PG8_GP(gbase, v) ((const __attribute__((address_space(1))) unsigned*)((const __attribute__((address_space(1))) char*)(gbase) + (v)))
#define PG8_STAGE(bufoff, gbase, voff) do { _Pragma("unroll") for (int _i = 0; _i < 2; ++_i) \
        __builtin_amdgcn_global_load_lds(PG8_GP(gbase, (voff)[_i]), (LAS unsigned*)(lds + (bufoff) + ldsw + _i * 8192), 16, 0, 0); } while (0)
#define PG8_STAGE2(bufoff, gbase, v0, v1) do { \
        __builtin_amdgcn_global_load_lds(PG8_GP(gbase, v0), (LAS unsigned*)(lds + (bufoff) + ldsw), 16, 0, 0); \
        __builtin_amdgcn_global_load_lds(PG8_GP(gbase, v1), (LAS unsigned*)(lds + (bufoff) + ldsw + 8192), 16, 0, 0); } while (0)
#define PG8_LDA(dst, b, h) do { _Pragma("unroll") for (int m = 0; m < 4; ++m) _Pragma("unroll") for (int k = 0; k < 2; ++k) dst[m][k] = *(const LAS bf16x8*)(lds + PG8_SA(b, h) + aoff + m * 2048 + k * 1024); } while (0)
#define PG8_LDB(dst, b, h) do { _Pragma("unroll") for (int n = 0; n < 2; ++n) _Pragma("unroll") for (int k = 0; k < 2; ++k) dst[n][k] = *(const LAS bf16x8*)(lds + PG8_SB(b, h) + boff + n * 2048 + k * 1024); } while (0)
#define PG8_MMA(ai, bj, At, Bt) do { __builtin_amdgcn_s_setprio(1); _Pragma("unroll") for (int m = 0; m < 4; ++m) _Pragma("unroll") for (int n = 0; n < 2; ++n) { \
        if constexpr (FP8) { const i32x8 a8 = __builtin_shufflevector(__builtin_bit_cast(i32x4, At[m][0]), __builtin_bit_cast(i32x4, At[m][1]), 0, 1, 2, 3, 4, 5, 6, 7); \
            const i32x8 b8 = __builtin_shufflevector(__builtin_bit_cast(i32x4, Bt[n][0]), __builtin_bit_cast(i32x4, Bt[n][1]), 0, 1, 2, 3, 4, 5, 6, 7); \
            acc[ai][bj][m][n] = __builtin_amdgcn_mfma_scale_f32_16x16x128_f8f6f4(b8, a8, acc[ai][bj][m][n], 0, 0, 0, 0x7f7f7f7f, 0, 0x7f7f7f7f); } \
        else { _Pragma("unroll") for (int k = 0; k < 2; ++k) acc[ai][bj][m][n] = __builtin_amdgcn_mfma_f32_16x16x32_bf16(Bt[n][k], At[m][k], acc[ai][bj][m][n], 0, 0, 0); } } \
        __builtin_amdgcn_s_setprio(0); } while (0)
#define PG8_WAIT_V(n) asm volatile("s_waitcnt vmcnt(" #n ")" ::: "memory")
#define PG8_WAIT_L(n) asm volatile("s_waitcnt lgkmcnt(" #n ")" ::: "memory")
#define PG8_BAR __builtin_amdgcn_s_barrier()
#define PG8_SCHED __builtin_amdgcn_sched_barrier(0)
    Unit cur, nxt; int ui = 0;
    if (!S.next(0, cur)) return;
    int ntu = nt; if constexpr (Sched::VARK) ntu = S.nt(cur);
    Acc acc;
#pragma unroll
    for (int a = 0; a < 2; ++a)
#pragma unroll
        for (int b = 0; b < 2; ++b)
#pragma unroll
            for (int m = 0; m < 4; ++m)
#pragma unroll
                for (int n = 0; n < 2; ++n) acc[a][b][m][n] = (f32x4){0.f, 0.f, 0.f, 0.f};
    bf16x8 At[4][2], B0[2][2], B1[2][2];
    unsigned vA[2][2];
    if constexpr (Sched::ROWDMA) { S.prefetch_rows(cur, wid, lane); PG8_WAIT_V(0); PG8_BAR; }
    S.a_offsets(cur, vA);
    const char* cA = S.a_ptr(cur); const char* cB = S.b_ptr(cur);
    PG8_STAGE(PG8_SB(0, 0), cB, voffB); PG8_STAGE(PG8_SB(0, 1), cB + hstep, voffB); PG8_STAGE2(PG8_SA(0, 0), cA, vA[0][0], vA[0][1]); PG8_STAGE2(PG8_SA(0, 1), cA, vA[1][0], vA[1][1]);
    if (wr == 1) PG8_BAR;
    PG8_WAIT_V(2); PG8_BAR;
    PG8_STAGE(PG8_SB(1, 0), cB + kstep, voffB); PG8_STAGE2(PG8_SA(1, 0), cA + kstep, vA[0][0], vA[0][1]); PG8_STAGE(PG8_SB(1, 1), cB + hstep + kstep, voffB);
    PG8_WAIT_V(6); PG8_BAR;
    for (;;) {
        const bool has_next = S.next(ui + 1, nxt);
        const char* nA = has_next ? S.a_ptr(nxt) : cA; const char* nB = has_next ? S.b_ptr(nxt) : cB;
        const bool newrows = has_next && nxt.tile != cur.tile;
        if constexpr (Sched::ROWDMA) { if (newrows) S.prefetch_rows(nxt, wid, lane); }
#pragma unroll 1
        for (int t = 0; t < ntu; t += 2) {
            const bool last = (t == ntu - 2);
            const char* a1 = cA + (size_t)(t + 1) * kstep;
            const char* a2 = last ? nA : cA + (size_t)(t + 2) * kstep; const char* b2 = last ? nB : cB + (size_t)(t + 2) * kstep;
            const char* a3 = a2 + kstep; const char* b3 = b2 + kstep;
            if constexpr (Sched::GATHER) { if (last && newrows) S.a_offsets_h(nxt, 0, vA[0]); }
            PG8_LDB(B0, 0, 0); PG8_LDB(B1, 0, 1); PG8_SCHED; PG8_LDA(At, 0, 0); PG8_STAGE2(PG8_SA(1, 1), a1, vA[1][0], vA[1][1]);
            if constexpr (Sched::GATHER) { if (last && newrows) S.a_offsets_h(nxt, 1, vA[1]); }
            PG8_WAIT_V(8); PG8_WAIT_L(0); PG8_BAR; PG8_MMA(0, 0, At, B0); PG8_MMA(0, 1, At, B1); PG8_BAR; PG8_SCHED;
            PG8_LDA(At, 0, 1); PG8_STAGE(PG8_SB(0, 0), b2, voffB); PG8_STAGE(PG8_SB(0, 1), b2 + hstep, voffB); PG8_STAGE2(PG8_SA(0, 0), a2, vA[0][0], vA[0][1]);
            PG8_WAIT_V(8); PG8_WAIT_L(0); PG8_BAR; PG8_MMA(1, 0, At, B0); PG8_MMA(1, 1, At, B1); PG8_BAR; PG8_SCHED;
            PG8_LDB(B0, 1, 0); PG8_LDB(B1, 1, 1); PG8_SCHED; PG8_LDA(At, 1, 0); PG8_STAGE2(PG8_SA(0, 1), a2, vA[1][0], vA[1][1]);
            PG8_WAIT_V(8); PG8_WAIT_L(0); PG8_BAR; PG8_MMA(0, 0, At, B0); PG8_MMA(0, 1, At, B1); PG8_BAR; PG8_SCHED;
            PG8_LDA(At, 1, 1); PG8_STAGE(PG8_SB(1, 0), b3, voffB); PG8_STAGE(PG8_SB(1, 1), b3 + hstep, voffB); PG8_STAGE2(PG8_SA(1, 0), a3, vA[0][0], vA[0][1]);
            PG8_WAIT_V(8); PG8_WAIT_L(0); PG8_BAR; PG8_MMA(1, 0, At, B0); PG8_MMA(1, 1, At, B1); PG8_BAR; PG8_SCHED;
        }
        if (wr == 0) PG8_BAR;
        { int tl = (int)threadIdx.x; asm volatile("" : "+v"(tl));
          E(acc, cur, wr, wc, tl & 15, (tl & 63) >> 4); }
        if (!has_next) break;
#pragma unroll
        for (int a = 0; a < 2; ++a)
#pragma unroll
            for (int b = 0; b < 2; ++b)
#pragma unroll
                for (int m = 0; m < 4; ++m)
#pragma unroll
                    for (int n = 0; n < 2; ++n) acc[a][b][m][n] = (f32x4){0.f, 0.f, 0.f, 0.f};
        cur = nxt; cA = nA; cB = nB; ++ui;
        if constexpr (Sched::VARK) ntu = S.nt(cur);
        if (wr == 1) PG8_BAR;
    }
    PG8_WAIT_V(0);
    PG8_BAR;
#undef PG8_SA
#undef PG8_SB
#undef PG8_STAGE
#undef PG8_STAGE2
#undef PG8_LDA
#undef PG8_LDB
#undef PG8_MMA
#undef PG8_WAIT_V
#undef PG8_WAIT_L
#undef PG8_BAR
#undef PG8_SCHED
}
}

struct Args { const float* in[25]; float* out; unsigned char* ws; int ph_lo, ph_hi; };
struct Frame {
    LAS unsigned char* lds; int wave, G, blk;
    static __device__ __forceinline__ int tid() { return (int)threadIdx.x; }
    static __device__ __forceinline__ int lane() { return (int)(threadIdx.x & 63u); }
    static __device__ __forceinline__ const __attribute__((address_space(4))) Args* ka() { return (const __attribute__((address_space(4))) Args*)__builtin_amdgcn_kernarg_segment_ptr(); }
    __device__ __forceinline__ const float* x() const { return ka()->in[0]; }
    __device__ __forceinline__ const float* c() const { return ka()->in[1]; }
    __device__ __forceinline__ const float* ctx() const { return ka()->in[2]; }
    __device__ __forceinline__ const float* c_ctx() const { return ka()->in[3]; }
    __device__ __forceinline__ const float* w_ada() const { return ka()->in[4]; }
    __device__ __forceinline__ const float* b_ada() const { return ka()->in[5]; }
    __device__ __forceinline__ const float* g_mix_pre() const { return ka()->in[6]; }
    __device__ __forceinline__ const float* g_mix_post() const { return ka()->in[7]; }
    __device__ __forceinline__ const float* g_ffn_pre() const { return ka()->in[8]; }
    __device__ __forceinline__ const float* g_ffn_post() const { return ka()->in[9]; }
    __device__ __forceinline__ const float* w_in() const { return ka()->in[10]; }
    __device__ __forceinline__ const float* b_gates() const { return ka()->in[11]; }
    __device__ __forceinline__ const float* rpb() const { return ka()->in[12]; }
    __device__ __forceinline__ const float* g_head() const { return ka()->in[13]; }
    __device__ __forceinline__ const float* w_br_na() const { return ka()->in[14]; }
    __device__ __forceinline__ const float* w_br_ml() const { return ka()->in[15]; }
    __device__ __forceinline__ const float* w_out() const { return ka()->in[16]; }
    __device__ __forceinline__ const float* w_router() const { return ka()->in[17]; }
    __device__ __forceinline__ const float* b_router() const { return ka()->in[18]; }
    __device__ __forceinline__ const float* w_gate() const { return ka()->in[19]; }
    __device__ __forceinline__ const float* b_gate() const { return ka()->in[20]; }
    __device__ __forceinline__ const float* w_lin() const { return ka()->in[21]; }
    __device__ __forceinline__ const float* b_lin() const { return ka()->in[22]; }
    __device__ __forceinline__ const float* w_down() const { return ka()->in[23]; }
    __device__ __forceinline__ const float* b_down() const { return ka()->in[24]; }
    float* out_; unsigned char* ws_;
    __device__ __forceinline__ float* out() const { return out_; }
    __device__ __forceinline__ unsigned char* ws() const { return ws_; }
    __device__ __forceinline__ unsigned* ctl() const { return (unsigned*)(ws_ + WS_CTL); }
};
#define WSP(T, off) ((T*)(F.ws() + (off)))

template <bool F8>
struct EpiInProj {
    static constexpr bool MID = false;
    static constexpr float DSC = F8 ? 1.f / (FP8_SHI * FP8_SW) : 1.f;
    bf16_t* P; int ldp; bf16_t* Vt; int S; float* gates; LAS bf16_t* scr_base;
    bf16_t* Kt; bf16_t* Mvt; const float* rope; bool lat;
    __device__ __forceinline__ void store_t(LAS bf16_t* scr, const float (&v)[8], bf16_t* dst, int lane, int fr, int fq) const {
#pragma unroll
        for (int j = 0; j < 8; ++j) scr[(8 * fq + j) * 24 + fr] = f2bf(v[j]);
        const int rdim = lane >> 1, rhalf = lane & 1;
        const u32x4 tv = *(const LAS u32x4*)(scr + rdim * 24 + 8 * rhalf);
        *(u32x4*)(dst + (size_t)rdim * S + 8 * rhalf) = tv;
    }
    __device__ __forceinline__ void operator()(const pg8::Acc& acc, const pg8::Unit& u, int wr, int wc, int fr, int fq) const {
        const int row0 = u.pm * 256 + wr * 64 + fr, pn = u.pn;
        const int lane = fr + 16 * fq; LAS bf16_t* scr = scr_base + (wr * 4 + wc) * (32 * 24);
        if (pn == 2 || pn == 3 || pn == 5 || pn == 6) {
            const bool na = pn < 4;
#pragma unroll
            for (int ai = 0; ai < 2; ++ai)
#pragma unroll
                for (int m = 0; m < 4; ++m) { const int rowb = u.pm * 256 + wr * 64 + ai * 128 + m * 16; const int b = rowb / S, tin = rowb - b * S;
#pragma unroll
                    for (int bj = 0; bj < 2; ++bj) { float v[8];
#pragma unroll
                        for (int n = 0; n < 2; ++n)
#pragma unroll
                            for (int i = 0; i < 4; ++i) v[4 * n + i] = acc[ai][bj][m][n][i] * DSC;
                        if (na) { const int col0 = (pn - 2) * 256 + bj * 128 + wc * 32; const int head = col0 >> 6, dim0 = col0 & 63;
                            store_t(scr, v, Vt + ((size_t)(b * 8 + head) * 64 + dim0) * S + tin, lane, fr, fq); }
                        else { const int head = 2 * (pn - 5) + bj;
                            store_t(scr, v, Mvt + ((size_t)(b * 4 + head) * 128 + wc * 32) * S + tin, lane, fr, fq); } } }
        } else if (!F8 && pn == 7) {
            if (wc == 0 && fq < 2) {
#pragma unroll
                for (int ai = 0; ai < 2; ++ai)
#pragma unroll
                    for (int m = 0; m < 4; ++m) { const int row = row0 + ai * 128 + m * 16; float* dst = gates + (size_t)row * 16 + 8 * fq;
                        *(f32x4*)dst = acc[ai][0][m][0]; *(f32x4*)(dst + 4) = acc[ai][0][m][1]; }
            }
        } else if (pn == 4 || pn == 10) {
            const int cb = (pn < 7 ? pn : pn - 1) * 256 + wc * 32 + 8 * fq; const bool isk = pn == 4; const float ksc = (isk ? 0.125f : 1.f) * DSC;
#pragma unroll
            for (int am = 0; am < 4; ++am) { const int ai = am >> 1, m0 = 2 * (am & 1);
                f32x4 csv[4][2], snv[4][2];
#pragma unroll
                for (int m = m0; m < m0 + 2; ++m) { const int rowb = u.pm * 256 + wr * 64 + ai * 128 + m * 16; const int b = rowb / S, tin = rowb - b * S, tinl = tin + fr;
                    const int pos = (wc & 1) ? 32 + (tinl & 63) : (tinl >> 6);
                    csv[m][0] = (f32x4){1.f, 1.f, 1.f, 1.f}; csv[m][1] = csv[m][0]; snv[m][0] = (f32x4){0.f, 0.f, 0.f, 0.f}; snv[m][1] = snv[m][0];
                    if (lat) { const float* tp = rope + pos * 16 + 8 * (fq & 1); csv[m][0] = *(const f32x4*)tp; csv[m][1] = *(const f32x4*)(tp + 4); snv[m][0] = *(const f32x4*)(tp + 96 * 16); snv[m][1] = *(const f32x4*)(tp + 96 * 16 + 4); } }
#pragma unroll
                for (int m = m0; m < m0 + 2; ++m) { asm volatile("" : "+v"(csv[m][0])); asm volatile("" : "+v"(csv[m][1])); asm volatile("" : "+v"(snv[m][0])); asm volatile("" : "+v"(snv[m][1])); }
#pragma unroll
                for (int m = m0; m < m0 + 2; ++m) { const int rowb = u.pm * 256 + wr * 64 + ai * 128 + m * 16; const int b = rowb / S, tin = rowb - b * S;
                    bf16_t* rowp = P + (size_t)(row0 + ai * 128 + m * 16) * ldp + cb;
                    f32x4 cs0 = csv[m][0], cs1 = csv[m][1], sn0 = snv[m][0], sn1 = snv[m][1];
                    if (lat && fq < 2) { sn0 = -sn0; sn1 = -sn1; }
#pragma unroll
                    for (int bj = 0; bj < 2; ++bj) { float v[8];
#pragma unroll
                        for (int n = 0; n < 2; ++n)
#pragma unroll
                            for (int i = 0; i < 4; ++i) { float own = acc[ai][bj][m][n][i];
                                if (lat) { const float oth = __shfl_xor(own, 32); own = own * (n ? cs1[i] : cs0[i]) + oth * (n ? sn1[i] : sn0[i]); }
                                v[4 * n + i] = own * ksc; }
                        u32x4 pk; pk[0] = cvt_pk_bf16(v[0], v[1]); pk[1] = cvt_pk_bf16(v[2], v[3]); pk[2] = cvt_pk_bf16(v[4], v[5]); pk[3] = cvt_pk_bf16(v[6], v[7]);
                        *(u32x4*)(rowp + bj * 128) = pk;
                        if (isk) { const int head = 2 * bj + (wc >> 1); store_t(scr, v, Kt + ((size_t)(b * 4 + head) * 64 + 32 * (wc & 1)) * S + tin, lane, fr, fq); } } }
            }
        } else if (pn >= 13) {
            const int gb = 2 * PC_GNA + (pn - 13) * 256 + wc * 32 + 8 * fq;
#pragma unroll
            for (int ai = 0; ai < 2; ++ai)
#pragma unroll
                for (int m = 0; m < 4; ++m) { unsigned char* rowp = (unsigned char*)(P + (size_t)(row0 + ai * 128 + m * 16) * ldp) + gb;
#pragma unroll
                    for (int bj = 0; bj < 2; ++bj) { float g[8];
#pragma unroll
                        for (int n = 0; n < 2; ++n)
#pragma unroll
                            for (int i = 0; i < 4; ++i) g[4 * n + i] = FP8_SG * __builtin_amdgcn_rcpf(1.f + __builtin_amdgcn_exp2f(acc[ai][bj][m][n][i] * (-1.4426950408889634f * DSC)));
                        *(u32x2*)(rowp + bj * 128) = (u32x2){pack_fp8x4(g[0], g[1], g[2], g[3]), pack_fp8x4(g[4], g[5], g[6], g[7])}; } }
        } else {
            const int cb = (pn < 7 ? pn : pn - 1) * 256 + wc * 32 + 8 * fq;
#pragma unroll
            for (int ai = 0; ai < 2; ++ai)
#pragma unroll
                for (int m = 0; m < 4; ++m) { bf16_t* rowp = P + (size_t)(row0 + ai * 128 + m * 16) * ldp + cb;
#pragma unroll
                    for (int bj = 0; bj < 2; ++bj) { const f32x4 v0 = acc[ai][bj][m][0] * DSC, v1 = acc[ai][bj][m][1] * DSC;
                        u32x4 pk; pk[0] = cvt_pk_bf16(v0[0], v0[1]); pk[1] = cvt_pk_bf16(v0[2], v0[3]); pk[2] = cvt_pk_bf16(v1[0], v1[1]); pk[3] = cvt_pk_bf16(v1[2], v1[3]);
                        *(u32x4*)(rowp + bj * 128) = pk; } }
        }
    }
};
struct EpiBranchA {
    static constexpr bool MID = false;
    const bf16_t* P; bf16_t* T;
    __device__ __forceinline__ void operator()(const pg8::Acc& acc, const pg8::Unit& u, int wr, int wc, int fr, int fq) const {
        const int row0 = u.pm * 256 + wr * 64 + fr, cb = u.pn * 256 + wc * 32 + 8 * fq;
#pragma unroll
        for (int ai = 0; ai < 2; ++ai)
#pragma unroll
            for (int m = 0; m < 4; ++m) { const size_t row = (size_t)(row0 + ai * 128 + m * 16);
#pragma unroll
                for (int bj = 0; bj < 2; ++bj) { const u32x4 gm = *(const u32x4*)(P + row * LDP + cb + PC_GNA + bj * 128);
                    float v[8];
#pragma unroll
                    for (int q = 0; q < 4; ++q) { const f32x2 gq = (f32x2){bf_lo(gm[q]), bf_hi(gm[q])} * -1.4426950408889634f; f32x2 e; e[0] = __builtin_amdgcn_exp2f(gq[0]); e[1] = __builtin_amdgcn_exp2f(gq[1]);
                        const f32x2 dn = e + 1.f; f32x2 r; r[0] = __builtin_amdgcn_rcpf(dn[0]); r[1] = __builtin_amdgcn_rcpf(dn[1]);
                        const f32x2 o = (f32x2){acc[ai][bj][m][q >> 1][(q & 1) * 2], acc[ai][bj][m][q >> 1][(q & 1) * 2 + 1]} * r; v[2 * q] = o[0]; v[2 * q + 1] = o[1]; }
                    u32x4 pk; pk[0] = cvt_pk_bf16(v[0], v[1]); pk[1] = cvt_pk_bf16(v[2], v[3]); pk[2] = cvt_pk_bf16(v[4], v[5]); pk[3] = cvt_pk_bf16(v[6], v[7]);
                    *(u32x4*)(T + row * D + cb + bj * 128) = pk; } }
    }
};
struct EpiBranchB {
    static constexpr bool MID = false;
    const bf16_t* P; const bf16_t* T; bf16_t* O;
    __device__ __forceinline__ void operator()(const pg8::Acc& acc, const pg8::Unit& u, int wr, int wc, int fr, int fq) const {
        const int row0 = u.pm * 256 + wr * 64 + fr, cb = u.pn * 256 + wc * 32 + 8 * fq;
#pragma unroll
        for (int ai = 0; ai < 2; ++ai)
#pragma unroll
            for (int m = 0; m < 4; ++m) { const size_t row = (size_t)(row0 + ai * 128 + m * 16);
#pragma unroll
                for (int bj = 0; bj < 2; ++bj) { const u32x4 gm = *(const u32x4*)(P + row * LDP + cb + PC_GML + bj * 128); const u32x4 tv = *(const u32x4*)(T + row * D + cb + bj * 128);
                    float v[8];
#pragma unroll
                    for (int q = 0; q < 4; ++q) { const f32x2 gq = (f32x2){bf_lo(gm[q]), bf_hi(gm[q])} * -1.4426950408889634f; f32x2 e; e[0] = __builtin_amdgcn_exp2f(gq[0]); e[1] = __builtin_amdgcn_exp2f(gq[1]);
                        const f32x2 dn = e + 1.f; f32x2 r; r[0] = __builtin_amdgcn_rcpf(dn[0]); r[1] = __builtin_amdgcn_rcpf(dn[1]);
                        const f32x2 o = (f32x2){acc[ai][bj][m][q >> 1][(q & 1) * 2], acc[ai][bj][m][q >> 1][(q & 1) * 2 + 1]} * r + (f32x2){bf_lo(tv[q]), bf_hi(tv[q])}; v[2 * q] = o[0]; v[2 * q + 1] = o[1]; }
                    u32x4 pk; pk[0] = cvt_pk_bf16(v[0], v[1]); pk[1] = cvt_pk_bf16(v[2], v[3]); pk[2] = cvt_pk_bf16(v[4], v[5]); pk[3] = cvt_pk_bf16(v[6], v[7]);
                    *(u32x4*)(O + row * D + cb + bj * 128) = pk; } }
    }
};
struct EpiMix {
    static constexpr bool MID = false;
    const bf16_t* P; bf16_t* Tw; bf16_t* M; bf16_t* Y;
    __device__ __forceinline__ void operator()(const pg8::Acc& acc, const pg8::Unit& u, int wr, int wc, int fr, int fq) const {
        const int rl0 = wr * 64 + fr, cl = wc * 32 + 8 * fq, row0 = u.pm * 256 + rl0, cb = u.pn * 256 + cl;
        if (u.e == 2) {
#pragma unroll
            for (int ai = 0; ai < 2; ++ai)
#pragma unroll
                for (int m = 0; m < 4; ++m) { bf16_t* rowp = Y + (size_t)(row0 + ai * 128 + m * 16) * D + cb;
#pragma unroll
                    for (int bj = 0; bj < 2; ++bj) { const f32x4 v0 = acc[ai][bj][m][0], v1 = acc[ai][bj][m][1];
                        u32x4 pk; pk[0] = cvt_pk_bf16(v0[0], v0[1]); pk[1] = cvt_pk_bf16(v0[2], v0[3]); pk[2] = cvt_pk_bf16(v1[0], v1[1]); pk[3] = cvt_pk_bf16(v1[2], v1[3]);
                        *(u32x4*)(rowp + bj * 128) = pk; } }
        } else {
            const bool second = u.e != 0; const int gc = 2 * PC_GNA + (second ? 1024 : 0);
            u32x2 gmv[2][4][2];
#pragma unroll
            for (int m = 0; m < 4; ++m)
#pragma unroll
                for (int bj = 0; bj < 2; ++bj) gmv[0][m][bj] = *(const u32x2*)((const unsigned char*)(P + (size_t)(u.pm * 256 + rl0 + m * 16) * LDP) + gc + cb + bj * 128);
#pragma unroll
            for (int ai = 0; ai < 2; ++ai) {
                u32x4 tvv[4][2];
#pragma unroll
                for (int m = 0; m < 4; ++m) { const int rl = rl0 + ai * 128 + m * 16;
#pragma unroll
                    for (int bj = 0; bj < 2; ++bj) { tvv[m][bj] = (u32x4){0u, 0u, 0u, 0u}; if (second) tvv[m][bj] = *(const u32x4*)(Tw + rl * 256 + cl + bj * 128); } }
                if (ai == 0) {
#pragma unroll
                    for (int m = 0; m < 4; ++m)
#pragma unroll
                        for (int bj = 0; bj < 2; ++bj) gmv[1][m][bj] = *(const u32x2*)((const unsigned char*)(P + (size_t)(u.pm * 256 + rl0 + 128 + m * 16) * LDP) + gc + cb + bj * 128); }
#pragma unroll
                for (int m = 0; m < 4; ++m)
#pragma unroll
                    for (int bj = 0; bj < 2; ++bj) { asm volatile("" : "+v"(gmv[ai][m][bj])); asm volatile("" : "+v"(tvv[m][bj])); }
#pragma unroll
                for (int m = 0; m < 4; ++m) { const int rl = rl0 + ai * 128 + m * 16; const size_t row = (size_t)(u.pm * 256 + rl);
#pragma unroll
                    for (int bj = 0; bj < 2; ++bj) { const u32x2 gm = gmv[ai][m][bj]; const u32x4 tv = tvv[m][bj];
                        bf16_t* tp = Tw + rl * 256 + cl + bj * 128;
                        float v[8];
#pragma unroll
                        for (int q = 0; q < 4; ++q) { const f32x2 r = ((q & 1) ? __builtin_amdgcn_cvt_pk_f32_fp8((int)gm[q >> 1], true) : __builtin_amdgcn_cvt_pk_f32_fp8((int)gm[q >> 1], false)) * (1.f / FP8_SG);
                            const f32x2 o = (f32x2){acc[ai][bj][m][q >> 1][(q & 1) * 2], acc[ai][bj][m][q >> 1][(q & 1) * 2 + 1]} * r + (f32x2){bf_lo(tv[q]), bf_hi(tv[q])}; v[2 * q] = o[0]; v[2 * q + 1] = o[1]; }
                        u32x4 pk; pk[0] = cvt_pk_bf16(v[0], v[1]); pk[1] = cvt_pk_bf16(v[2], v[3]); pk[2] = cvt_pk_bf16(v[4], v[5]); pk[3] = cvt_pk_bf16(v[6], v[7]);
                        if (second) *(u32x4*)(M + row * D + cb + bj * 128) = pk; else *(u32x4*)tp = pk; } }
            }
            if (second) asm volatile("s_waitcnt vmcnt(0)" ::: "memory");
        }
    }
};
struct EpiPlain {
    static constexpr bool MID = false;
    bf16_t* O; int ldc;
    __device__ __forceinline__ void operator()(const pg8::Acc& acc, const pg8::Unit& u, int wr, int wc, int fr, int fq) const {
        const int row0 = u.pm * 256 + wr * 64 + fr, cb = u.pn * 256 + wc * 32 + 8 * fq;
#pragma unroll
        for (int ai = 0; ai < 2; ++ai)
#pragma unroll
            for (int m = 0; m < 4; ++m) { bf16_t* rowp = O + (size_t)(row0 + ai * 128 + m * 16) * ldc + cb;
#pragma unroll
                for (int bj = 0; bj < 2; ++bj) { const f32x4 v0 = acc[ai][bj][m][0], v1 = acc[ai][bj][m][1];
                    u32x4 pk; pk[0] = cvt_pk_bf16(v0[0], v0[1]); pk[1] = cvt_pk_bf16(v0[2], v0[3]); pk[2] = cvt_pk_bf16(v1[0], v1[1]); pk[3] = cvt_pk_bf16(v1[2], v1[3]);
                    *(u32x4*)(rowp + bj * 128) = pk; } }
    }
};
struct EpiSwiglu {
    static constexpr bool MID = false;
    unsigned char* Alo; unsigned char* Ahi; const LAS float* biasl;
    __device__ __forceinline__ void operator()(const pg8::Acc& acc, const pg8::Unit& u, int wr, int wc, int fr, int fq) const {
        constexpr float dsc = 1.f / (FP8_SW * FP8_SH);
        const int r0 = u.tile * 256; unsigned char* base = r0 < A_LO_ROWS ? Alo + (size_t)r0 * PA_HID : Ahi + (size_t)(r0 - A_LO_ROWS) * PA_HID;
        const int rl0 = wr * 64 + fr, cb = u.pn * 128 + wc * 32 + 8 * fq;
        const LAS float* pg = biasl + u.rb * 256 + wc * 32 + 8 * fq; const LAS float* pl = pg + 128;
        const f32x4 g0 = *(const LAS f32x4*)pg * FP8_SA, g1 = *(const LAS f32x4*)(pg + 4) * FP8_SA, l0 = *(const LAS f32x4*)pl + 1.f, l1 = *(const LAS f32x4*)(pl + 4) + 1.f;
        constexpr float dg = dsc * FP8_SA, ce = -2.4554669595930157f / FP8_SA;
#pragma unroll
        for (int ai = 0; ai < 2; ++ai)
#pragma unroll
            for (int m = 0; m < 4; ++m) { float v[8];
#pragma unroll
                for (int n = 0; n < 2; ++n)
#pragma unroll
                    for (int p = 0; p < 2; ++p) { const f32x4 bgv = n ? g1 : g0, blv = n ? l1 : l0;
                        f32x2 G = (f32x2){acc[ai][0][m][n][2 * p], acc[ai][0][m][n][2 * p + 1]} * dg + (f32x2){bgv[2 * p], bgv[2 * p + 1]};
                        f32x2 L = (f32x2){acc[ai][1][m][n][2 * p], acc[ai][1][m][n][2 * p + 1]} * dsc + (f32x2){blv[2 * p], blv[2 * p + 1]};
                        G[0] = fminf(G[0], 7.f * FP8_SA); G[1] = fminf(G[1], 7.f * FP8_SA); L[0] = __builtin_amdgcn_fmed3f(L[0], -6.f, 8.f); L[1] = __builtin_amdgcn_fmed3f(L[1], -6.f, 8.f);
                        const f32x2 T = G * ce; f32x2 E; E[0] = __builtin_amdgcn_exp2f(T[0]); E[1] = __builtin_amdgcn_exp2f(T[1]);
                        const f32x2 Dn = E + 1.f; f32x2 R; R[0] = __builtin_amdgcn_rcpf(Dn[0]); R[1] = __builtin_amdgcn_rcpf(Dn[1]);
                        const f32x2 O = (G * R) * L; v[4 * n + 2 * p] = O[0]; v[4 * n + 2 * p + 1] = O[1]; }
                unsigned p0 = 0u, p1 = 0u;
                p0 = __builtin_amdgcn_cvt_pk_fp8_f32(v[0], v[1], p0, false); p0 = __builtin_amdgcn_cvt_pk_fp8_f32(v[2], v[3], p0, true);
                p1 = __builtin_amdgcn_cvt_pk_fp8_f32(v[4], v[5], p1, false); p1 = __builtin_amdgcn_cvt_pk_fp8_f32(v[6], v[7], p1, true);
                *(u32x2*)(base + (size_t)(rl0 + ai * 128 + m * 16) * PA_HID + cb) = (u32x2){p0, p1}; }
    }
};
struct EpiDown {
    static constexpr bool MID = false;
    unsigned char* Ys; const LAS unsigned* edl; const LAS int* cnt;
    __device__ __forceinline__ void operator()(const pg8::Acc& acc, const pg8::Unit& u, int wr, int wc, int fr, int fq) const {
        constexpr float dsc = 1.f / (FP8_SW * FP8_SA);
        const int n = __builtin_amdgcn_readfirstlane(cnt[u.e]), li0 = u.pm * 256 + wr * 64 + fr, cb = u.pn * 256 + wc * 32 + 8 * fq;
        const LAS unsigned* ed = edl + u.rb * 768; const LAS float* pb = (const LAS float*)(ed + 512) + wc * 32 + 8 * fq;
        f32x4 bv[2][2];
#pragma unroll
        for (int bj = 0; bj < 2; ++bj) { bv[bj][0] = *(const LAS f32x4*)(pb + bj * 128); bv[bj][1] = *(const LAS f32x4*)(pb + bj * 128 + 4); }
        int slv[2][4]; float wvv[2][4];
#pragma unroll
        for (int ai = 0; ai < 2; ++ai)
#pragma unroll
            for (int m = 0; m < 4; ++m) { const int rl = wr * 64 + fr + ai * 128 + m * 16; slv[ai][m] = (int)ed[rl]; wvv[ai][m] = __uint_as_float(ed[256 + rl]); }
#pragma unroll
        for (int ai = 0; ai < 2; ++ai)
#pragma unroll
            for (int m = 0; m < 4; ++m) { const int li = li0 + ai * 128 + m * 16;
                if (li < n) { const int slot = slv[ai][m]; const float w = wvv[ai][m];
                    unsigned char* rowp = Ys + (size_t)slot * D + cb;
#pragma unroll
                    for (int bj = 0; bj < 2; ++bj) { const float ws = w * FP8_SY; f32x4 v0 = (acc[ai][bj][m][0] * dsc + bv[bj][0]) * ws, v1 = (acc[ai][bj][m][1] * dsc + bv[bj][1]) * ws;
#pragma unroll
                        for (int i = 0; i < 4; ++i) { v0[i] = __builtin_amdgcn_fmed3f(v0[i], -448.f, 448.f); v1[i] = __builtin_amdgcn_fmed3f(v1[i], -448.f, 448.f); }
                        unsigned p0 = 0u, p1 = 0u;
                        p0 = __builtin_amdgcn_cvt_pk_fp8_f32(v0[0], v0[1], p0, false); p0 = __builtin_amdgcn_cvt_pk_fp8_f32(v0[2], v0[3], p0, true);
                        p1 = __builtin_amdgcn_cvt_pk_fp8_f32(v1[0], v1[1], p1, false); p1 = __builtin_amdgcn_cvt_pk_fp8_f32(v1[2], v1[3], p1, true);
                        *(u32x2*)(rowp + bj * 128) = (u32x2){p0, p1}; } } }
    }
};

__device__ __forceinline__ void phase_ada(const Frame& F) {
    LAS float* tab = (LAS float*)F.lds;
    float* modv = WSP(float, WS_MODV);
    for (int cg = F.blk; cg < 256; cg += F.G) {
        const int j0 = cg * 24, cc = F.tid() % 24, kg = F.tid() / 24;
        float acc[33];
#pragma unroll
        for (int b = 0; b < 33; ++b) acc[b] = 0.f;
        for (int half = 0; half < 2; ++half) {
            __syncthreads();
            {
                float vv[33]; const int k = F.tid();
#pragma unroll
                for (int b = 0; b < 33; ++b) vv[b] = (b < 32) ? F.c()[b * D + half * 512 + k] : F.c_ctx()[half * 512 + k];
#pragma unroll
                for (int b = 0; b < 33; ++b) tab[k * 36 + b] = vv[b] * sigmoidf_(vv[b]); }
            __syncthreads();
            if (kg < 21) {
                float wv[25];
#pragma unroll
                for (int i = 0; i < 25; ++i) { const int k = kg + 21 * i; wv[i] = (k < 512) ? F.w_ada()[(size_t)(half * 512 + k) * 6144 + j0 + cc] : 0.f; }
#pragma unroll
                for (int i = 0; i < 25; ++i) { const int k = (kg + 21 * i < 512) ? kg + 21 * i : 0; const float w = wv[i];
                    const LAS f32x4* tp = (const LAS f32x4*)(tab + k * 36);
#pragma unroll
                    for (int q = 0; q < 8; ++q) { const f32x4 sv = tp[q]; acc[4 * q] += sv[0] * w; acc[4 * q + 1] += sv[1] * w; acc[4 * q + 2] += sv[2] * w; acc[4 * q + 3] += sv[3] * w; }
                    acc[32] += tab[k * 36 + 32] * w;
                }
            }
        }
        __syncthreads();
        LAS float* part = (LAS float*)F.lds;
        if (kg < 21) {
#pragma unroll
            for (int b = 0; b < 33; ++b) part[(kg * 24 + cc) * 33 + b] = acc[b];
        }
        __syncthreads();
        for (int o = F.tid(); o < 24 * 33; o += 512) { const int c2 = o / 33, b = o % 33; float s = F.b_ada()[j0 + c2];
            for (int g = 0; g < 21; ++g) s += part[(g * 24 + c2) * 33 + b];
            modv[(size_t)b * 6144 + j0 + c2] = s; }
        __syncthreads();
    }
}

__device__ __forceinline__ void cvt_tile(const Frame& F, LAS bf16_t* t, const float* src, int ld, int valid, bf16_t* dst, int dld) {
    const int tid = F.tid();
    __syncthreads();
    f32x4 vq[4];
#pragma unroll
    for (int p = 0; p < 4; ++p) { const int k = (tid >> 4) + 32 * p, c = 4 * (tid & 15); const int cc = c < valid ? c : 0;
        vq[p] = *(const f32x4*)(src + (size_t)k * ld + cc); }
#pragma unroll
    for (int p = 0; p < 4; ++p) asm volatile("" : "+v"(vq[p]));
#pragma unroll
    for (int p = 0; p < 4; ++p) { const int k = (tid >> 4) + 32 * p, c = 4 * (tid & 15);
        const f32x4 v = (c < valid) ? vq[p] : (f32x4){0.f, 0.f, 0.f, 0.f};
        *(LAS unsigned*)(t + k * 66 + c) = cvt_pk_bf16(v[0], v[1]); *(LAS unsigned*)(t + k * 66 + c + 2) = cvt_pk_bf16(v[2], v[3]); }
    __syncthreads();
    const int n = tid >> 3, kg = tid & 7;
    unsigned pk[8];
#pragma unroll
    for (int q = 0; q < 8; ++q) { const unsigned lo = t[(16 * kg + 2 * q) * 66 + n], hi = t[(16 * kg + 2 * q + 1) * 66 + n]; pk[q] = lo | (hi << 16); }
    u32x4* d = (u32x4*)(dst + (size_t)n * dld + 16 * kg);
    d[0] = (u32x4){pk[0], pk[1], pk[2], pk[3]}; d[1] = (u32x4){pk[4], pk[5], pk[6], pk[7]};
}
__device__ __forceinline__ void cvt_tile8(const Frame& F, LAS float* t, const float* src, int ld, unsigned char* dst, int dld, float scale) {
    const int tid = F.tid();
    __syncthreads();
#pragma unroll
    for (int p = 0; p < 4; ++p) { const int k = (tid >> 4) + 32 * p, c = 4 * (tid & 15);
        const f32x4 v = *(const f32x4*)(src + (size_t)k * ld + c);
        t[k * 65 + c] = v[0]; t[k * 65 + c + 1] = v[1]; t[k * 65 + c + 2] = v[2]; t[k * 65 + c + 3] = v[3]; }
    __syncthreads();
    const int n = tid >> 3, kg = tid & 7;
    u32x4 pk;
#pragma unroll
    for (int q = 0; q < 4; ++q) pk[q] = pack_fp8x4(t[(16 * kg + 4 * q) * 65 + n] * scale, t[(16 * kg + 4 * q + 1) * 65 + n] * scale, t[(16 * kg + 4 * q + 2) * 65 + n] * scale, t[(16 * kg + 4 * q + 3) * 65 + n] * scale);
    *(u32x4*)(dst + (size_t)n * dld + 16 * kg) = pk;
}
__device__ __forceinline__ void phase_cvt_small(const Frame& F) {
    if (F.blk == 0) { float* rope = WSP(float, WS_ROPE);
        for (int i = F.tid(); i < 96 * 16; i += 512) { const int p = i >> 4, j = i & 15; const float pos = (p < 32) ? (float)p : (float)(p - 32);
            const float inv = powf(10000.f, -(float)j / 16.f); float sn, cs; sincosf(pos * inv, &sn, &cs); rope[i] = cs; rope[96 * 16 + i] = sn; } }
    LAS bf16_t* t = (LAS bf16_t*)F.lds;
    bf16_t* btin = WSP(bf16_t, WS_BTIN); bf16_t* btbr = WSP(bf16_t, WS_BTBR); bf16_t* btout = WSP(bf16_t, WS_BTOUT);
    for (int task = F.blk; task < 928; task += F.G) {
        if (task < 672) { const int nc = task >> 3, kt = task & 7, n0 = nc * 64; int c0, valid;
            if (n0 < 1792) { c0 = n0; valid = 64; } else if (n0 == 1792) { c0 = 1792; valid = 16; } else if (n0 < 2048) { c0 = 0; valid = 0; } else { c0 = n0 - 240; valid = 64; }
            if (n0 < N_IN16) cvt_tile(F, t, F.w_in() + (size_t)(kt * 128) * W_IN_COLS + c0, W_IN_COLS, valid, btin + (size_t)n0 * D + kt * 128, D);
            if (in_is8(n0 >> 8)) cvt_tile8(F, (LAS float*)F.lds, F.w_in() + (size_t)(kt * 128) * W_IN_COLS + c0, W_IN_COLS, WSP(unsigned char, WS_BTIN8) + (size_t)n0 * D + kt * 128, D, FP8_SW);
        } else if (task < 800) { const int q = task - 672, nc = q >> 3, kt = q & 7;
            const float* src = (kt < 4) ? F.w_br_na() + (size_t)(kt * 128) * D + nc * 64 : F.w_br_ml() + (size_t)((kt - 4) * 128) * D + nc * 64;
            cvt_tile(F, t, src, D, 64, btbr + (size_t)(nc * 64) * D + kt * 128, D);
        } else { const int q = task - 800, nc = q >> 3, kt = q & 7;
            cvt_tile(F, t, F.w_out() + (size_t)(kt * 128) * D + nc * 64, D, 64, btout + (size_t)(nc * 64) * D + kt * 128, D); }
    }
    __syncthreads();
}
__device__ __forceinline__ void cvt_exp_task(const Frame& F, int task, const float*& src, unsigned char*& dst) {
    unsigned char* wgl = WSP(unsigned char, WS_WGL); unsigned char* wd = (unsigned char*)F.out() + DO_WD;
    if (task < NEXP * 256) { const int e = task >> 8, q = task & 255; const int nc = q >> 3, kt = q & 7, n0 = nc * 64;
        const int pn = n0 >> 8, bj = (n0 >> 7) & 1, j = 128 * pn + (n0 & 127);
        src = (bj ? F.w_lin() : F.w_gate()) + (size_t)e * D * D + (size_t)(kt * 128) * D + j; dst = wgl + (size_t)e * 2048 * D + (size_t)n0 * D + kt * 128;
    } else { const int t2 = task - NEXP * 256; const int e = t2 >> 7, q2 = t2 & 127, nc = q2 >> 3, kt = q2 & 7;
        src = F.w_down() + (size_t)e * D * D + (size_t)(kt * 128) * D + nc * 64; dst = wd + (size_t)e * D * D + (size_t)(nc * 64) * D + kt * 128; }
}
__device__ __forceinline__ void phase_cvt_experts(const Frame& F, const int T0, const int NTASK) {
    LAS float* t = (LAS float*)F.lds;
    const int tid = F.tid(), k0 = tid >> 4, c = 4 * (tid & 15), n = tid >> 3, kg = tid & 7;
#define CVT_LOAD(r, task_) do { const float* src_; unsigned char* dst_; cvt_exp_task(F, (task_), src_, dst_); (void)dst_; \
        _Pragma("unroll") for (int p = 0; p < 4; ++p) (r)[p] = __builtin_nontemporal_load((const f32x4*)(src_ + (size_t)(k0 + 32 * p) * D + c)); } while (0)
#define CVT_EMIT(r, task_) do { __syncthreads(); \
        _Pragma("unroll") for (int p = 0; p < 4; ++p) { LAS float* tp = t + (k0 + 32 * p) * 65 + c; tp[0] = (r)[p][0]; tp[1] = (r)[p][1]; tp[2] = (r)[p][2]; tp[3] = (r)[p][3]; } \
        const float* src_; unsigned char* dcur; cvt_exp_task(F, (task_), src_, dcur); (void)src_; \
        { const int tn_ = ((task_) + 2 * F.G < NTASK) ? (task_) + 2 * F.G : (task_); CVT_LOAD(r, tn_); }     \
        __syncthreads(); u32x4 pk; \
        _Pragma("unroll") for (int q = 0; q < 4; ++q) pk[q] = pack_fp8x4(t[(16 * kg + 4 * q) * 65 + n] * FP8_SW, t[(16 * kg + 4 * q + 1) * 65 + n] * FP8_SW, t[(16 * kg + 4 * q + 2) * 65 + n] * FP8_SW, t[(16 * kg + 4 * q + 3) * 65 + n] * FP8_SW); \
        *(u32x4*)(dcur + (size_t)n * D + 16 * kg) = pk; } while (0)
    f32x4 rA[4], rB[4];
    int task = T0 + F.blk;
    if (task < NTASK) {
        CVT_LOAD(rA, task);
        { const int t1_ = (task + F.G < NTASK) ? task + F.G : task; CVT_LOAD(rB, t1_); }
        for (;;) {
            CVT_EMIT(rA, task);
            if (task + F.G >= NTASK) break;
            CVT_EMIT(rB, task + F.G);
            task += 2 * F.G; if (task >= NTASK) break;
        }
    }
#undef CVT_LOAD
#undef CVT_EMIT
    __syncthreads();
}

__device__ __forceinline__ void phase_norm1(const Frame& F) {
    const float* modv = WSP(float, WS_MODV); bf16_t* H = WSP(bf16_t, WS_H); unsigned char* H8 = WSP(unsigned char, WS_H8);
    constexpr int NGRP = (NTOK + NCTX) / 32;
    const int lane = F.lane();
    { float* comb = WSP(float, WS_COMB);
      for (int i = F.blk * 512 + F.tid(); i < 32 * 4096; i += F.G * 512) { const int b = i >> 12, which = (i >> 10) & 3, k = i & 1023; const float* mb = modv + (size_t)b * 6144;
          comb[i] = which == 0 ? mb[2048 + k] * F.g_mix_post()[k] : which == 1 ? F.g_ffn_pre()[k] * (mb[4096 + k] + 1.f) : which == 2 ? mb[3072 + k] : mb[5120 + k] * F.g_ffn_post()[k]; } }
    int curb = -1; f32x4 al[4], be[4];
    for (int grp = F.blk; grp < NGRP; grp += F.G) {
        const int r0 = grp * 32 + F.wave * 4;
        const int b = (r0 < NTOK) ? r0 / SEQ : 32;
        if (b != curb) { curb = b;
#pragma unroll
            for (int j = 0; j < 4; ++j) { const int k = 256 * j + 4 * lane; const f32x4 g = *(const f32x4*)(F.g_mix_pre() + k), sc = *(const f32x4*)(modv + (size_t)b * 6144 + 1024 + k);
                al[j] = g * (sc + 1.f); be[j] = *(const f32x4*)(modv + (size_t)b * 6144 + k); } }
        const float* src = (r0 < NTOK) ? F.x() + (size_t)r0 * D : F.ctx() + (size_t)(r0 - NTOK) * D;
        f32x4 v[4][4];
#pragma unroll
        for (int t = 0; t < 4; ++t)
#pragma unroll
            for (int j = 0; j < 4; ++j) v[t][j] = __builtin_nontemporal_load((const f32x4*)(src + (size_t)t * D + 256 * j + 4 * lane));
#pragma unroll
        for (int t = 0; t < 4; ++t) { float ss = 0.f;
#pragma unroll
            for (int j = 0; j < 4; ++j) ss += v[t][j][0] * v[t][j][0] + v[t][j][1] * v[t][j][1] + v[t][j][2] * v[t][j][2] + v[t][j][3] * v[t][j][3];
            ss = wave_sum(ss); const float rs = rsqrtf(ss * (1.f / D) + EPS);
#pragma unroll
            for (int j = 0; j < 4; ++j) { const f32x4 o = v[t][j] * rs * al[j] + be[j]; u32x2 pk; pk[0] = cvt_pk_bf16(o[0], o[1]); pk[1] = cvt_pk_bf16(o[2], o[3]);
                __builtin_nontemporal_store(pk, (u32x2*)(H + (size_t)(r0 + t) * D + 256 * j + 4 * lane));
                if (r0 < NTOK) __builtin_nontemporal_store(pack_fp8x4(o[0] * FP8_SHI, o[1] * FP8_SHI, o[2] * FP8_SHI, o[3] * FP8_SHI), (unsigned*)(H8 + (size_t)(r0 + t) * D + 256 * j + 4 * lane)); } }
    }
}

namespace at3 {
constexpr int PT = 72;
constexpr int O_K = 0, O_V = O_K + 2 * 64 * PT * 2, O_RP = O_V + 2 * 64 * PT * 2, O_END = O_RP + 8 * 15 * 31 * 4;
static_assert(O_END <= LDS_BARW, "attention LDS");
}
__device__ __forceinline__ f32x16 mfma32(const bf16x8 a, const bf16x8 b, const f32x16 c) { return __builtin_amdgcn_mfma_f32_32x32x16_bf16(a, b, c, 0, 0, 0); }
__device__ __forceinline__ void phase_attn(const Frame& F) {
    using namespace at3;
    constexpr float LOG2E = 1.4426950408889634f, SC = 0.125f * LOG2E;
    LAS bf16_t* Ks = (LAS bf16_t*)(F.lds + O_K); LAS bf16_t* Vs = (LAS bf16_t*)(F.lds + O_V); LAS float* rp = (LAS float*)(F.lds + O_RP);
    __syncthreads();
    { float rv[8];
#pragma unroll
      for (int r = 0; r < 8; ++r) { const int i = F.tid() + 512 * r; rv[r] = (i < 8 * 15 * 31) ? F.rpb()[i] : 0.f; }
#pragma unroll
      for (int r = 0; r < 8; ++r) { const int i = F.tid() + 512 * r; if (i < 8 * 15 * 31) rp[i] = rv[r] * LOG2E; } }
    const bf16_t* PL = WSP(bf16_t, WS_PLAT); const bf16_t* PCx = WSP(bf16_t, WS_PCTX); const bf16_t* VTL = WSP(bf16_t, WS_VTL); const bf16_t* VTC = WSP(bf16_t, WS_VTC);
    bf16_t* OC = WSP(bf16_t, WS_ONA);
    const int tid = F.tid(), lane = F.lane(), w = F.wave, l31 = lane & 31, h5 = lane >> 5, ch = w & 1, qc = 32 * ch + l31;
    const int srow = tid >> 3, sc16 = tid & 7;
    unsigned mbits = 0u; { const int cs = min(max(qc - 8, 0), 48);
#pragma unroll
        for (int kh = 0; kh < 2; ++kh)
#pragma unroll
            for (int i = 0; i < 16; ++i) { const int kc = 32 * kh + (i & 3) + 8 * (i >> 2) + 4 * h5; if (kc >= cs && kc < cs + 16) mbits |= 1u << (16 * kh + i); } }
    const int dcl = 4 * h5 - qc + 15;
    const int vcu = (F.G % 8 == 0) ? (F.blk % 8) * (F.G / 8) + F.blk / 8 : F.blk;
    int pass_ = 0;
    for (int idx = vcu; idx < NB * 8 * 8; idx += F.G, ++pass_) {
        const int rq = (idx + ((F.G % 8 == 0) ? pass_ : 0)) & 7, h = (idx >> 3) & 7, b = idx >> 6, r0 = 4 * rq, r = r0 + (w >> 1);
        const int rs = min(max(r - 4, 0), 24), kr_lo = min(max(r0 - 4, 0), 24), kr_hi = min(max(r0 - 1, 0), 24) + 7, ntile = 4 + (kr_hi - kr_lo + 1);
        const int qtok = b * SEQ + r * 64 + qc;
#define AT3_LOAD(t_, kreg, vreg) do { const bf16_t* kp_; const bf16_t* vp_; \
        if ((t_) < 4) { kp_ = PCx + (size_t)(b * CTXL + 64 * (t_) + srow) * LDPC + PC_NAK + 64 * h + 8 * sc16; vp_ = VTC + ((size_t)(b * 8 + h) * 64 + srow) * CTXL + 64 * (t_) + 8 * sc16; } \
        else { const int kr_ = kr_lo + (t_) - 4; kp_ = PL + (size_t)(b * SEQ + kr_ * 64 + srow) * LDP + PC_NAK + 64 * h + 8 * sc16; vp_ = VTL + ((size_t)(b * 8 + h) * 64 + srow) * SEQ + kr_ * 64 + 8 * sc16; } \
        asm volatile("global_load_dwordx4 %0, %1, off" : "=&v"(kreg) : "v"(kp_) : "memory"); asm volatile("global_load_dwordx4 %0, %1, off" : "=&v"(vreg) : "v"(vp_) : "memory"); } while (0)
#define AT3_WAIT(n, kreg, vreg) asm volatile("s_waitcnt vmcnt(" #n ")" : "+v"(kreg), "+v"(vreg) :: "memory")
        u32x4 kA, vA, kB, vB;
        AT3_LOAD(0, kA, vA);
        AT3_LOAD(1, kB, vB);
        bf16x8 qf[4];
#pragma unroll
        for (int ks = 0; ks < 4; ++ks) qf[ks] = __builtin_bit_cast(bf16x8, *(const u32x4*)(PL + (size_t)qtok * LDP + PC_NAQ + 64 * h + 16 * ks + 8 * h5));
#pragma unroll
        for (int ks = 0; ks < 4; ++ks) { const u32x4 qr = __builtin_bit_cast(u32x4, qf[ks]);
            union { bf16x8 v; unsigned u[4]; } qs;
#pragma unroll
            for (int z = 0; z < 4; ++z) qs.u[z] = cvt_pk_bf16(bf_lo(qr[z]) * SC, bf_hi(qr[z]) * SC);
            qf[ks] = qs.v; }
        f32x16 o[2];
#pragma unroll
        for (int dt = 0; dt < 2; ++dt)
#pragma unroll
            for (int i = 0; i < 16; ++i) o[dt][i] = 0.f;
        float m = -3.0e38f, ls = 0.f;
#define AT3_TILE(NEED, LOCAL) do { \
                f32x16 sa[2]; _Pragma("unroll") for (int kh = 0; kh < 2; ++kh) _Pragma("unroll") for (int i = 0; i < 16; ++i) sa[kh][i] = 0.f; \
                _Pragma("unroll") for (int ks = 0; ks < 4; ++ks) _Pragma("unroll") for (int kh = 0; kh < 2; ++kh)     \
                    sa[kh] = mfma32(*(const LAS bf16x8*)(Kb + (32 * kh + l31) * PT + 16 * ks + 8 * h5), qf[ks], sa[kh]); \
                f32x2 v2[2][8]; float mx = -3.0e38f; f32x2 bs2[2][8]; \
                if (LOCAL) { _Pragma("unroll") for (int kh = 0; kh < 2; ++kh) _Pragma("unroll") for (int z = 0; z < 8; ++z) if (NEED(kh, z >> 1)) {     \
                    bs2[kh][z][0] = rph[32 * kh + 2 * (z & 1) + 8 * (z >> 1)]; bs2[kh][z][1] = rph[32 * kh + 2 * (z & 1) + 1 + 8 * (z >> 1)]; } } \
                _Pragma("unroll") for (int kh = 0; kh < 2; ++kh) _Pragma("unroll") for (int z = 0; z < 8; ++z) { if (NEED(kh, z >> 1)) { float s0 = sa[kh][2 * z], s1 = sa[kh][2 * z + 1]; \
                    if (LOCAL) { s0 += bs2[kh][z][0]; s1 += bs2[kh][z][1]; s0 = ((mbits >> (16 * kh + 2 * z)) & 1u) ? s0 : -1.0e30f; s1 = ((mbits >> (16 * kh + 2 * z + 1)) & 1u) ? s1 : -1.0e30f; } \
                    v2[kh][z] = (f32x2){s0, s1}; mx = fmaxf(mx, fmaxf(s0, s1)); } else v2[kh][z] = (f32x2){0.f, 0.f}; } \
                if (__any(mx > m)) { mx = fmaxf(mx, __shfl_xor(mx, 32)); const float mn = fmaxf(m, mx), al = __builtin_amdgcn_exp2f(m - mn); ls *= al; m = mn;     \
                    _Pragma("unroll") for (int dt = 0; dt < 2; ++dt) _Pragma("unroll") for (int i = 0; i < 16; ++i) o[dt][i] *= al; } \
                f32x2 ps2 = (f32x2){0.f, 0.f}; const f32x2 m2 = (f32x2){m, m}; \
                _Pragma("unroll") for (int kh = 0; kh < 2; ++kh) _Pragma("unroll") for (int z = 0; z < 8; ++z) if (NEED(kh, z >> 1)) { const f32x2 d = v2[kh][z] - m2; \
                    v2[kh][z][0] = __builtin_amdgcn_exp2f(d[0]); v2[kh][z][1] = __builtin_amdgcn_exp2f(d[1]); ps2 += v2[kh][z]; } \
                ls += ps2[0] + ps2[1]; \
                _Pragma("unroll") for (int kh = 0; kh < 2; ++kh) _Pragma("unroll") for (int s2 = 0; s2 < 2; ++s2) if (NEED(kh, 2 * s2) || NEED(kh, 2 * s2 + 1)) { \
                    union { bf16x8 v; unsigned u[4]; } pf; \
                    _Pragma("unroll") for (int z = 0; z < 4; ++z) pf.u[z] = cvt_pk_bf16(v2[kh][4 * s2 + z][0], v2[kh][4 * s2 + z][1]); \
                    _Pragma("unroll") for (int dt = 0; dt < 2; ++dt) { union { bf16x8 v; u32x2 u[2]; } vf; \
                        vf.u[0] = *(const LAS u32x2*)(Vb + (32 * dt + l31) * PT + 32 * kh + 16 * s2 + 4 * h5); vf.u[1] = *(const LAS u32x2*)(Vb + (32 * dt + l31) * PT + 32 * kh + 16 * s2 + 8 + 4 * h5); \
                        o[dt] = mfma32(vf.v, pf.v, o[dt]); } } } while (0)
#define AT3_ALL(kh, jg) true
#define AT3_N0(kh, jg) ((kh) == 0 || (jg) == 0)
#define AT3_N1(kh, jg) ((kh) == 1 || (jg) == 3)
#define AT3_STEP(t, kw, vw) do { \
            const LAS bf16_t* Kb = Ks + ((t) & 1) * 64 * PT; const LAS bf16_t* Vb = Vs + ((t) & 1) * 64 * PT; \
            const bool loc = (t) >= 4; const int kr = kr_lo + (t) - 4; \
            if (!loc) { const LAS float* rph = rp; AT3_TILE(AT3_ALL, false); } \
            else if (kr >= rs && kr < rs + 8) { \
                const LAS float* rph = rp + (h * 15 + (kr - r + 7)) * 31 + dcl; \
                if (ch == 0) AT3_TILE(AT3_N0, true); else AT3_TILE(AT3_N1, true); \
            } \
            if ((t) + 1 < ntile) { LAS bf16_t* Kn = Ks + (((t) + 1) & 1) * 64 * PT; LAS bf16_t* Vn = Vs + (((t) + 1) & 1) * 64 * PT; \
                AT3_WAIT(2, kw, vw); *(LAS u32x4*)(Kn + srow * PT + 8 * sc16) = kw; *(LAS u32x4*)(Vn + srow * PT + 8 * sc16) = vw; } \
            { const int tn_ = min((t) + 3, ntile - 1); AT3_LOAD(tn_, kw, vw); }     \
            __syncthreads(); } while (0)
        __syncthreads();
        AT3_WAIT(2, kA, vA); *(LAS u32x4*)(Ks + srow * PT + 8 * sc16) = kA; *(LAS u32x4*)(Vs + srow * PT + 8 * sc16) = vA;
        AT3_LOAD(2, kA, vA);
        __syncthreads();
        for (int t = 0;;) {
            AT3_STEP(t, kB, vB);
            if (t + 1 >= ntile) break;
            AT3_STEP(t + 1, kA, vA);
            t += 2; if (t >= ntile) break;
        }
#undef AT3_STEP
#undef AT3_TILE
#undef AT3_ALL
#undef AT3_N0
#undef AT3_N1
#undef AT3_LOAD
#undef AT3_WAIT
        asm volatile("s_waitcnt vmcnt(0)" ::: "memory");
        ls += __shfl_xor(ls, 32); const float inv = __builtin_amdgcn_rcpf(ls);
#pragma unroll
        for (int dt = 0; dt < 2; ++dt)
#pragma unroll
            for (int jj = 0; jj < 4; ++jj) { u32x2 pk; pk[0] = cvt_pk_bf16(o[dt][4 * jj] * inv, o[dt][4 * jj + 1] * inv); pk[1] = cvt_pk_bf16(o[dt][4 * jj + 2] * inv, o[dt][4 * jj + 3] * inv);
                *(u32x2*)(OC + (size_t)qtok * 1024 + 64 * h + 32 * dt + 8 * jj + 4 * h5) = pk; }
    }
}

namespace ml {
constexpr int PT = 72;
constexpr int NPOS = 36 * 64;
constexpr int A_KW = 0, A_VT = A_KW + 2 * 64 * PT * 2, A_A = A_VT + 2 * 128 * PT * 2;
constexpr int A_M = A_A + NPOS * 4, A_WI = A_M + NPOS * 4, A_FL = A_WI + NPOS * 4, A_WS = A_FL + NPOS * 4, A_B = A_WS + NPOS * 4, A_PM = A_B + NPOS * 4;
constexpr int A_N = A_PM + NPOS * 4;
constexpr int A_MC = A_N + 256;
constexpr int A_END = A_MC + 1024;
static_assert(A_END <= LDS_BARW, "mlstm pass A LDS");
constexpr int B_K = 0, B_VT = B_K + 64 * PT * 2, B_CF = B_VT + 128 * PT * 2, B_CB = B_CF + 144 * PT * 2, B_SLOT = B_CB + 144 * PT * 2;
static_assert(2 * B_SLOT <= LDS_BARW, "mlstm pass B LDS");
constexpr int CT_ROWS = 132, CT_STRIDE = CT_ROWS * 64;
}
constexpr size_t DO_CT = 0;

__device__ __forceinline__ void phase_mlstm_states(const Frame& F) {
    using namespace ml;
    LAS unsigned char* L = F.lds;
    LAS bf16_t* Kw = (LAS bf16_t*)(L + A_KW); LAS bf16_t* Vt = (LAS bf16_t*)(L + A_VT);
    LAS float* Aa = (LAS float*)(L + A_A); LAS float* Mm = (LAS float*)(L + A_M); LAS float* Wi = (LAS float*)(L + A_WI); LAS float* Fl = (LAS float*)(L + A_FL);
    LAS float* Ws = (LAS float*)(L + A_WS); LAS float* Bb = (LAS float*)(L + A_B); LAS float* Pm = (LAS float*)(L + A_PM);
    LAS float* nS = (LAS float*)(L + A_N); LAS float* mc = (LAS float*)(L + A_MC);
    const float* gates = WSP(float, WS_GATES); float* PP = WSP(float, WS_LTOK);
    const bf16_t* MKT = (const bf16_t*)((const char*)F.out() + DO_MKT); const bf16_t* MKTC = (const bf16_t*)((const char*)F.out() + DO_MKTC);
    const bf16_t* MVT = (const bf16_t*)((const char*)F.out() + DO_MVT); const bf16_t* MVTC = (const bf16_t*)((const char*)F.out() + DO_MVTC);
    bf16_t* CT = (bf16_t*)((char*)F.out() + DO_CT);
    const int tid = F.tid(), lane = F.lane(), w = F.wave, l31 = lane & 31, lh = lane >> 5;
    for (int task = F.blk; task < NB * 4 * 2; task += F.G) {
        const int dir = task & 1, h = (task >> 1) & 3, b = task >> 3;
        __syncthreads();
        const float bi = F.b_gates()[(2 * dir) * 4 + h], bfg = F.b_gates()[(2 * dir + 1) * 4 + h];
        float gri[5], grf[5];
#pragma unroll
        for (int q = 0; q < 5; ++q) { const int ci = min(w + 8 * q, 35); int grow;
            if (ci < 4) grow = NTOK + b * CTXL + 64 * (dir ? 3 - ci : ci) + (dir ? 63 - lane : lane);
            else grow = b * SEQ + 64 * (dir ? 31 - (ci - 4) : (ci - 4)) + (dir ? 63 - lane : lane);
            gri[q] = gates[(size_t)grow * 16 + (2 * dir) * 4 + h]; grf[q] = gates[(size_t)grow * 16 + (2 * dir + 1) * 4 + h]; }
#pragma unroll
        for (int q = 0; q < 5; ++q) { const int ci = w + 8 * q; if (ci >= 36) break;
            const float ri = gri[q] + bi, rf = grf[q] + bfg;
            const float li = 15.f * tanhf(ri * (1.f / 15.f)), gf = 15.f * tanhf(rf * (1.f / 15.f));
            const float lf = fminf(gf, 0.f) - log1pf(__expf(-fabsf(gf)));
            float bc = lf;
#pragma unroll
            for (int o = 1; o < 64; o <<= 1) { const float t = __shfl_up(bc, o); if (lane >= o) bc += t; }
            const float a = li - bc; float pm = a;
#pragma unroll
            for (int o = 1; o < 64; o <<= 1) { const float t = __shfl_up(pm, o); if (lane >= o) pm = fmaxf(pm, t); }
            Aa[ci * 64 + lane] = a; Bb[ci * 64 + lane] = bc; Pm[ci * 64 + lane] = pm;
            if (lane == 63) { mc[64 + ci] = bc; mc[128 + ci] = bc + pm; }
        }
        for (int i = tid; i < 64; i += 512) nS[i] = 0.f;
        __syncthreads();
        if (tid == 0) { float m = 0.f; mc[0] = 0.f; for (int ci = 0; ci < 36; ++ci) { const float mn = fmaxf(mc[64 + ci] + m, mc[128 + ci]); mc[192 + ci] = __expf(mc[64 + ci] + m - mn); m = mn; mc[ci + 1] = m; } }
        __syncthreads();
        float* pp = PP + (size_t)((b * 4 + h) * 2 + dir) * 4 * SEQ;
        for (int p = tid; p < NPOS; p += 512) { const int ci = p >> 6, sp = p & 63; const float m0 = mc[ci], m1 = mc[ci + 1], bL = mc[64 + ci];
            const float M = fmaxf(m0, Pm[p]), wi = __expf(m0 - M), fl = __expf(-(Bb[p] + M)); Ws[p] = __expf(bL + Aa[p] - m1);
            if (ci >= 4) { const int cj = dir ? 31 - (ci - 4) : ci - 4, tk = 64 * cj + (dir ? 63 - sp : sp);
                pp[tk] = Aa[p]; pp[SEQ + tk] = M; pp[2 * SEQ + tk] = wi; pp[3 * SEQ + tk] = fl; } }
        __syncthreads();
        f32x16 cacc;
#pragma unroll
        for (int i = 0; i < 16; ++i) cacc[i] = 0.f;
        const int kd = tid >> 3, kj = tid & 7;
        const int ve = tid >> 2, vj = tid & 3;
        const int tm = w >> 2, te = w & 3;
#define MLA_SRC(c, kp, vp) do { if ((c) < 4) { const int tb_ = 64 * (dir ? 3 - (c) : (c)); kp = MKTC + ((size_t)(b * 4 + h) * 64 + kd) * CTXL + tb_ + 8 * kj; vp = MVTC + ((size_t)(b * 4 + h) * 128 + ve) * CTXL + tb_ + 16 * vj; } \
        else { const int tb_ = 64 * (dir ? 31 - ((c) - 4) : (c) - 4); kp = MKT + ((size_t)(b * 4 + h) * 64 + kd) * SEQ + tb_ + 8 * kj; vp = MVT + ((size_t)(b * 4 + h) * 128 + ve) * SEQ + tb_ + 16 * vj; } } while (0)
        u32x4 kr, v0, v1, kr2, v02, v12;
        { const bf16_t* kp; const bf16_t* vp; MLA_SRC(0, kp, vp); kr = __builtin_nontemporal_load((const u32x4*)kp); v0 = __builtin_nontemporal_load((const u32x4*)vp); v1 = __builtin_nontemporal_load((const u32x4*)(vp + 8));
          MLA_SRC(1, kp, vp); kr2 = __builtin_nontemporal_load((const u32x4*)kp); v02 = __builtin_nontemporal_load((const u32x4*)vp); v12 = __builtin_nontemporal_load((const u32x4*)(vp + 8)); }
        for (int ci = 0; ci < 36; ++ci) {
            LAS bf16_t* Kwb = Kw + (ci & 1) * 64 * PT; LAS bf16_t* Vtb = Vt + (ci & 1) * 128 * PT;
            {
                u32x4 kp4;
#pragma unroll
                for (int q = 0; q < 4; ++q) { const int j0 = 8 * kj + 2 * q; const float w0 = Ws[ci * 64 + (dir ? 63 - j0 : j0)], w1 = Ws[ci * 64 + (dir ? 62 - j0 : j0 + 1)];
                    kp4[q] = cvt_pk_bf16(bf_lo(kr[q]) * w0, bf_hi(kr[q]) * w1); }
                *(LAS u32x4*)(Kwb + kd * PT + 8 * kj) = kp4;
                *(LAS u32x4*)(Vtb + ve * PT + 16 * vj) = v0; *(LAS u32x4*)(Vtb + ve * PT + 16 * vj + 8) = v1;
            }
            kr = kr2; v0 = v02; v1 = v12;
            if (ci + 2 < 36) { const bf16_t* kp; const bf16_t* vp; MLA_SRC(ci + 2, kp, vp); kr2 = __builtin_nontemporal_load((const u32x4*)kp); v02 = __builtin_nontemporal_load((const u32x4*)vp); v12 = __builtin_nontemporal_load((const u32x4*)(vp + 8)); }
            __syncthreads();
            if (ci >= 4) {
                const int cj = dir ? 31 - (ci - 4) : ci - 4; bf16_t* cg = CT + ((size_t)(((b * 4 + h) * 2 + dir) * 32 + cj)) * CT_STRIDE;
#pragma unroll
                for (int j = 0; j < 4; ++j) { u32x2 pk; pk[0] = cvt_pk_bf16(cacc[4 * j], cacc[4 * j + 1]); pk[1] = cvt_pk_bf16(cacc[4 * j + 2], cacc[4 * j + 3]);
                    *(u32x2*)(cg + (size_t)(32 * te + l31) * 64 + 32 * tm + 8 * j + 4 * lh) = pk; }
                if (w == 0) cg[128 * 64 + lane] = f2bf(nS[lane]);
            }
            {
                const float wc = mc[192 + ci];
#pragma unroll
                for (int i = 0; i < 16; ++i) cacc[i] *= wc;
#pragma unroll
                for (int ks = 0; ks < 4; ++ks) { const bf16x8 a = *(const LAS bf16x8*)(Kwb + (32 * tm + l31) * PT + 16 * ks + 8 * lh), bq = *(const LAS bf16x8*)(Vtb + (32 * te + l31) * PT + 16 * ks + 8 * lh);
                    cacc = mfma32(a, bq, cacc); }
                if (w == 0) { float kn = 0.f;
#pragma unroll
                    for (int q = 0; q < 8; ++q) { const u32x4 kv = *(const LAS u32x4*)(Kwb + lane * PT + 8 * q);
#pragma unroll
                        for (int z = 0; z < 4; ++z) kn += bf_lo(kv[z]) + bf_hi(kv[z]); }
                    nS[lane] = wc * nS[lane] + kn; }
            }
        }
#undef MLA_SRC
    }
}

__device__ __forceinline__ void phase_mlstm_out(const Frame& F) {
    using namespace ml;
    const bf16_t* PL = WSP(bf16_t, WS_PLAT); const float* PP = WSP(float, WS_LTOK); bf16_t* OC = WSP(bf16_t, WS_ONA) + 512;
    const bf16_t* MVT = (const bf16_t*)((const char*)F.out() + DO_MVT); const bf16_t* CT = (const bf16_t*)((const char*)F.out() + DO_CT);
    const int tid = F.tid(), lane = F.lane(), w = F.wave, slot = w >> 2, tt = w & 3, l15 = lane & 15, g = lane >> 4, t2 = tid & 255;
    LAS bf16_t* Ks = (LAS bf16_t*)(F.lds + slot * B_SLOT + B_K); LAS bf16_t* Vt = (LAS bf16_t*)(F.lds + slot * B_SLOT + B_VT);
    LAS bf16_t* Cf = (LAS bf16_t*)(F.lds + slot * B_SLOT + B_CF); LAS bf16_t* Cb = (LAS bf16_t*)(F.lds + slot * B_SLOT + B_CB);
    __syncthreads();
    for (int i = t2; i < 15 * PT / 2; i += 256) { ((LAS unsigned*)(Cf + 129 * PT))[i] = 0u; ((LAS unsigned*)(Cb + 129 * PT))[i] = 0u; }
    static_assert(2 * B_SLOT + 2048 <= LDS_BARW, "mlstm pass B LDS (head-norm gains)");
    LAS float* ghl = (LAS float*)(F.lds + 2 * B_SLOT);
    if (tid < 512) ghl[tid] = F.g_head()[tid];
    constexpr int NTASK = NB * 4 * 32;
    u32x4 rk[2], rv[4], rf[5], rb[5];
#define MLB_LOAD(task_) do { const int c_ = (task_) & 31, h_ = ((task_) >> 5) & 3, b_ = (task_) >> 7; \
        _Pragma("unroll") for (int i = 0; i < 2; ++i) { const int c = t2 + 256 * i; rk[i] = *(const u32x4*)(PL + (size_t)(b_ * SEQ + 64 * c_ + (c >> 3)) * LDP + PC_MLK + 64 * h_ + 8 * (c & 7)); } \
        _Pragma("unroll") for (int i = 0; i < 4; ++i) { const int c = t2 + 256 * i; rv[i] = __builtin_nontemporal_load((const u32x4*)(MVT + ((size_t)(b_ * 4 + h_) * 128 + (c >> 3)) * SEQ + 64 * c_ + 8 * (c & 7))); } \
        const bf16_t* cf_ = CT + (size_t)(((b_ * 4 + h_) * 2 + 0) * 32 + c_) * CT_STRIDE; const bf16_t* cb_ = cf_ + (size_t)32 * CT_STRIDE; \
        _Pragma("unroll") for (int i = 0; i < 5; ++i) { const int c = t2 + 256 * i; if (c < 129 * 8) { rf[i] = __builtin_nontemporal_load((const u32x4*)(cf_ + 8 * c)); rb[i] = __builtin_nontemporal_load((const u32x4*)(cb_ + 8 * c)); } } } while (0)
    int task = 2 * F.blk + slot;
    if (task < NTASK) MLB_LOAD(task);
    for (; task - slot < NTASK; task += 2 * F.G) {
        const bool live = task < NTASK;
        const int tkc = live ? task : NTASK - 1;
        const int cj = tkc & 31, h = (tkc >> 5) & 3, b = tkc >> 7;
        const int tokq = b * SEQ + 64 * cj + 16 * tt + l15;
        bf16x8 qf[2];
#pragma unroll
        for (int ks = 0; ks < 2; ++ks) qf[ks] = *(const bf16x8*)(PL + (size_t)tokq * LDP + PC_MLQ + 64 * h + 32 * ks + 8 * g);
        float Mq2[2], wiq2[2], flq2[2]; f32x4 av2[2][4]; u32x2 op2[8];
#pragma unroll
        for (int dir = 0; dir < 2; ++dir) { const float* pp = PP + (size_t)((b * 4 + h) * 2 + dir) * 4 * SEQ + 64 * cj;
            Mq2[dir] = pp[SEQ + 16 * tt + l15]; wiq2[dir] = pp[2 * SEQ + 16 * tt + l15]; flq2[dir] = pp[3 * SEQ + 16 * tt + l15];
#pragma unroll
            for (int st = 0; st < 4; ++st) av2[dir][st] = *(const f32x4*)(pp + 16 * st + 4 * g); }
#pragma unroll
        for (int et = 0; et < 8; ++et) op2[et] = *(const u32x2*)(PL + (size_t)tokq * LDP + PC_MLO + 128 * h + 16 * et + 4 * g);
        asm volatile("" ::: "memory");
        __syncthreads();
        if (live) {
#pragma unroll
            for (int i = 0; i < 2; ++i) { const int c = t2 + 256 * i; *(LAS u32x4*)(Ks + (c >> 3) * PT + 8 * (c & 7)) = rk[i]; }
#pragma unroll
            for (int i = 0; i < 4; ++i) { const int c = t2 + 256 * i; *(LAS u32x4*)(Vt + (c >> 3) * PT + 8 * (c & 7)) = rv[i]; }
#pragma unroll
            for (int i = 0; i < 5; ++i) { const int c = t2 + 256 * i; if (c < 129 * 8) { *(LAS u32x4*)(Cf + (c >> 3) * PT + 8 * (c & 7)) = rf[i]; *(LAS u32x4*)(Cb + (c >> 3) * PT + 8 * (c & 7)) = rb[i]; } }
        }
        { const int tn_ = (task + 2 * F.G < NTASK) ? task + 2 * F.G : tkc; MLB_LOAD(tn_); }
        asm volatile("" ::: "memory");
        __syncthreads();
        if (!live) continue;
        f32x4 raw[4];
#pragma unroll
        for (int st = 0; st < 4; ++st) { f32x4 acc = (f32x4){0.f, 0.f, 0.f, 0.f};
#pragma unroll
            for (int ks = 0; ks < 2; ++ks) acc = __builtin_amdgcn_mfma_f32_16x16x32_bf16(*(const LAS bf16x8*)(Ks + (16 * st + l15) * PT + 32 * ks + 8 * g), qf[ks], acc, 0, 0, 0);
            raw[st] = acc; }
        f32x4 hsum[8];
#pragma unroll
        for (int dir = 0; dir < 2; ++dir) {
            const float Mq = Mq2[dir], wiq = wiq2[dir], flq = flq2[dir];
            const LAS bf16_t* Cd = dir ? Cb : Cf;
            f32x4 o[9];
#pragma unroll
            for (int et = 0; et < 9; ++et) { f32x4 acc = (f32x4){0.f, 0.f, 0.f, 0.f};
#pragma unroll
                for (int ks = 0; ks < 2; ++ks) acc = __builtin_amdgcn_mfma_f32_16x16x32_bf16(*(const LAS bf16x8*)(Cd + (16 * et + l15) * PT + 32 * ks + 8 * g), qf[ks], acc, 0, 0, 0);
                o[et] = acc * wiq; }
            float dsum = 0.f;
#pragma unroll
            for (int pr = 0; pr < 2; ++pr) {
                float p[8];
#pragma unroll
                for (int z = 0; z < 2; ++z) { const int st = 2 * pr + z; const f32x4 av = av2[dir][st];
#pragma unroll
                    for (int i = 0; i < 4; ++i) { const int sk = 16 * st + 4 * g + i, tq = 16 * tt + l15; const bool ok = dir ? (sk >= tq) : (sk <= tq);
                        const float wgt = ok ? __expf(av[i] - Mq) : 0.f; p[4 * z + i] = raw[st][i] * wgt; dsum += p[4 * z + i]; } }
                union { bf16x8 v; unsigned u[4]; } pf;
                pf.u[0] = cvt_pk_bf16(p[0], p[1]); pf.u[1] = cvt_pk_bf16(p[2], p[3]); pf.u[2] = cvt_pk_bf16(p[4], p[5]); pf.u[3] = cvt_pk_bf16(p[6], p[7]);
#pragma unroll
                for (int et = 0; et < 8; ++et) { union { bf16x8 v; u32x2 u[2]; } vf;
                    vf.u[0] = *(const LAS u32x2*)(Vt + (16 * et + l15) * PT + 32 * pr + 4 * g); vf.u[1] = *(const LAS u32x2*)(Vt + (16 * et + l15) * PT + 32 * pr + 16 + 4 * g);
                    o[et] = __builtin_amdgcn_mfma_f32_16x16x32_bf16(vf.v, pf.v, o[et], 0, 0, 0); }
            }
            dsum += __shfl_xor(dsum, 16); dsum += __shfl_xor(dsum, 32);
            const float dint = __shfl(o[8][0], l15);
            const float inv = __builtin_amdgcn_rcpf(fmaxf(fabsf(dint + dsum), flq));
#pragma unroll
            for (int et = 0; et < 8; ++et) hsum[et] = dir ? hsum[et] + o[et] * inv : o[et] * inv;
        }
        float ss = 0.f;
#pragma unroll
        for (int et = 0; et < 8; ++et) ss += hsum[et][0] * hsum[et][0] + hsum[et][1] * hsum[et][1] + hsum[et][2] * hsum[et][2] + hsum[et][3] * hsum[et][3];
        ss += __shfl_xor(ss, 16); ss += __shfl_xor(ss, 32);
        const float rs = rsqrtf(ss * (1.f / 128.f) + EPS);
#pragma unroll
        for (int et = 0; et < 8; ++et) { const f32x4 gh = *(const LAS f32x4*)(ghl + 128 * h + 16 * et + 4 * g);
            const u32x2 op = op2[et];
            u32x2 pk; pk[0] = cvt_pk_bf16(sigmoidf_(bf_lo(op[0])) * hsum[et][0] * rs * gh[0], sigmoidf_(bf_hi(op[0])) * hsum[et][1] * rs * gh[1]);
            pk[1] = cvt_pk_bf16(sigmoidf_(bf_lo(op[1])) * hsum[et][2] * rs * gh[2], sigmoidf_(bf_hi(op[1])) * hsum[et][3] * rs * gh[3]);
            *(u32x2*)(OC + (size_t)tokq * 1024 + 128 * h + 16 * et + 4 * g) = pk; }
    }
#undef MLB_LOAD
}

__device__ __forceinline__ f32x4 ldg4(const void* ubase, unsigned voff) { return *(const f32x4*)((const char*)ubase + voff); }
__device__ __forceinline__ u32x2 ldg2(const void* ubase, unsigned voff) { return *(const u32x2*)((const char*)ubase + voff); }
__device__ __forceinline__ f32x4 ldg4_nt(const void* ubase, unsigned voff) { return __builtin_nontemporal_load((const f32x4*)((const char*)ubase + voff)); }
__device__ __forceinline__ u32x2 ldg2_nt(const void* ubase, unsigned voff) { return __builtin_nontemporal_load((const u32x2*)((const char*)ubase + voff)); }
__device__ __forceinline__ void compute_x1(const Frame& F, int row, int b, const float* modv, const bf16_t* Y, unsigned lo16, f32x4 (&x1)[4]) {
    const bf16_t* yr = Y + (size_t)row * D; const float* xr = F.x() + (size_t)row * D; const float* gtr = modv + (size_t)b * 6144 + 2048;
    float ss = 0.f; f32x4 y[4];
#pragma unroll
    for (int j = 0; j < 4; ++j) { const u32x2 yp = ldg2_nt(yr + 256 * j, lo16 >> 1); y[j] = (f32x4){bf_lo(yp[0]), bf_hi(yp[0]), bf_lo(yp[1]), bf_hi(yp[1])};
        ss += y[j][0] * y[j][0] + y[j][1] * y[j][1] + y[j][2] * y[j][2] + y[j][3] * y[j][3]; }
    ss = wave_sum(ss); const float rs = rsqrtf(ss * (1.f / D) + EPS);
#pragma unroll
    for (int j = 0; j < 4; ++j) { const f32x4 xv = ldg4_nt(xr + 256 * j, lo16), gp = ldg4(F.g_mix_post() + 256 * j, lo16), gt = ldg4(gtr + 256 * j, lo16);
        x1[j] = xv + gt * (y[j] * rs * gp); }
}

template <int N> __device__ __forceinline__ void bfly(float (&v)[32], int lane) {
    const bool up = (lane & N) != 0;
#pragma unroll
    for (int i = 0; i < N; ++i) { const float send = up ? v[i] : v[i + N], keep = up ? v[i + N] : v[i]; v[i] = keep + __shfl_xor(send, N); }
    if constexpr (N > 1) bfly<N / 2>(v, lane);
}
__device__ __forceinline__ void phase_postmix(const Frame& F) {
    LAS float* Wl = (LAS float*)F.lds;
    LAS int* asg_e = (LAS int*)(F.lds + LDS_MISC); LAS float* asg_w = (LAS float*)(F.lds + LDS_MISC + 4096);
    LAS int* lcnt = (LAS int*)(F.lds + LDS_MISC + 8192); LAS int* gbase = lcnt + 32; LAS int* rank = (LAS int*)(F.lds + LDS_MISC + 8192 + 256);
    const float* modv = WSP(float, WS_MODV); const bf16_t* Y = WSP(bf16_t, WS_Y); bf16_t* Y1 = WSP(bf16_t, WS_Y); unsigned char* H2 = WSP(unsigned char, WS_H2);
    int* ltok = WSP(int, WS_LTOK); float* lw = WSP(float, WS_LW); unsigned* gcnt = F.ctl() + CW_GCNT;
    __syncthreads();
    {
        f32x4 wq[16];
#pragma unroll
        for (int r = 0; r < 16; ++r) wq[r] = *(const f32x4*)(F.w_router() + 4 * (F.tid() + 512 * r));
#pragma unroll
        for (int r = 0; r < 16; ++r) { const int q = F.tid() + 512 * r, k = q >> 3, eg = q & 7; const int j = k >> 8, ln = (k & 255) >> 2, ii = k & 3;
            *(LAS f32x4*)(Wl + (((j * 4 + ii) * 8 + eg) * 64 + ln) * 4) = wq[r]; } }
    if (F.tid() < 32) lcnt[F.tid()] = 0;
    __syncthreads();
    const int lane = F.lane();
    float brq[4];
#pragma unroll
    for (int q = 0; q < 4; ++q) brq[q] = F.b_router()[q * 8 + (lane & 7)];
    for (int gb0 = 0; gb0 < NTOK / 32; gb0 += 8 * F.G) {
        for (int it = 0; it < 8; ++it) {
            const int grp = gb0 + it * F.G + F.blk;
            if (grp >= NTOK / 32) { if (lane < 16) asg_e[(it * 32 + F.wave * 4) * 4 + lane] = -1; continue; }
            const int rl0 = it * 32 + F.wave * 4, row0 = grp * 32 + F.wave * 4; const int b = row0 / SEQ;
            f32x4 hv[4][4];
            {
                unsigned lo16 = (unsigned)lane * 16u; asm volatile("" : "+v"(lo16));
                const float* cbv = WSP(float, WS_COMB) + (size_t)b * 4096;
                f32x4 cA[4], cB[4], cC[4]; u32x2 yv[4][4];
#pragma unroll
                for (int j = 0; j < 4; ++j) { cA[j] = ldg4(cbv + 256 * j, lo16); cB[j] = ldg4(cbv + 1024 + 256 * j, lo16); cC[j] = ldg4(cbv + 2048 + 256 * j, lo16); }
#pragma unroll
                for (int t = 0; t < 4; ++t)
#pragma unroll
                    for (int j = 0; j < 4; ++j) { yv[t][j] = ldg2_nt(Y + (size_t)(row0 + t) * D + 256 * j, lo16 >> 1); hv[t][j] = ldg4_nt(F.x() + (size_t)(row0 + t) * D + 256 * j, lo16); }
#pragma unroll
                for (int j = 0; j < 4; ++j) { asm volatile("" : "+v"(cA[j])); asm volatile("" : "+v"(cB[j])); asm volatile("" : "+v"(cC[j])); }
#pragma unroll
                for (int t = 0; t < 4; ++t)
#pragma unroll
                    for (int j = 0; j < 4; ++j) { asm volatile("" : "+v"(yv[t][j])); asm volatile("" : "+v"(hv[t][j])); }
#pragma unroll
                for (int t = 0; t < 4; ++t) {
                    f32x4 y[4]; float sy = 0.f;
#pragma unroll
                    for (int j = 0; j < 4; ++j) { y[j] = (f32x4){bf_lo(yv[t][j][0]), bf_hi(yv[t][j][0]), bf_lo(yv[t][j][1]), bf_hi(yv[t][j][1])};
                        sy += y[j][0] * y[j][0] + y[j][1] * y[j][1] + y[j][2] * y[j][2] + y[j][3] * y[j][3]; }
                    sy = wave_sum(sy); const float rsy = rsqrtf(sy * (1.f / D) + EPS);
                    float ss = 0.f;
#pragma unroll
                    for (int j = 0; j < 4; ++j) { const f32x4 x1 = hv[t][j] + cA[j] * (y[j] * rsy); hv[t][j] = x1;
                        ss += x1[0] * x1[0] + x1[1] * x1[1] + x1[2] * x1[2] + x1[3] * x1[3];
                        u32x2 xb; xb[0] = cvt_pk_bf16(x1[0], x1[1]); xb[1] = cvt_pk_bf16(x1[2], x1[3]);
                        *(u32x2*)((char*)(Y1 + (size_t)(row0 + t) * D + 256 * j) + (lo16 >> 1)) = xb; }
                    ss = wave_sum(ss); const float rs = rsqrtf(ss * (1.f / D) + EPS);
                    unsigned char* hr = H2 + (size_t)(row0 + t) * D;
#pragma unroll
                    for (int j = 0; j < 4; ++j) { hv[t][j] = hv[t][j] * rs * cB[j] + cC[j];
                        *(unsigned*)(hr + 256 * j + (lo16 >> 2)) = pack_fp8x4(hv[t][j][0] * FP8_SH, hv[t][j][1] * FP8_SH, hv[t][j][2] * FP8_SH, hv[t][j][3] * FP8_SH); } }
            }
            asm volatile("" ::: "memory");
            float Lq[4] = {0.f, 0.f, 0.f, 0.f};
#pragma unroll 1
            for (int qd = 0; qd < 4; ++qd) {
                f32x2 a2[16];
#pragma unroll
                for (int i = 0; i < 16; ++i) a2[i] = (f32x2){0.f, 0.f};
#pragma unroll
                for (int j = 0; j < 4; ++j)
#pragma unroll
                    for (int ii = 0; ii < 4; ii += 2)
#pragma unroll
                        for (int eg = 0; eg < 2; ++eg) {
                            const f32x4 w0 = *(const LAS f32x4*)(Wl + (((j * 4 + ii) * 8 + qd * 2 + eg) * 64 + lane) * 4), w1 = *(const LAS f32x4*)(Wl + (((j * 4 + ii + 1) * 8 + qd * 2 + eg) * 64 + lane) * 4);
                            const f32x2 w0a = (f32x2){w0[0], w0[1]}, w0b = (f32x2){w0[2], w0[3]}, w1a = (f32x2){w1[0], w1[1]}, w1b = (f32x2){w1[2], w1[3]};
#pragma unroll
                            for (int t = 0; t < 4; ++t) { const f32x2 hx = (f32x2){hv[t][j][ii], hv[t][j][ii + 1]};
                                asm("v_pk_fma_f32 %0, %1, %2, %0 op_sel_hi:[0,1,1]" : "+v"(a2[t * 4 + eg * 2]) : "v"(hx), "v"(w0a));
                                asm("v_pk_fma_f32 %0, %1, %2, %0 op_sel_hi:[0,1,1]" : "+v"(a2[t * 4 + eg * 2 + 1]) : "v"(hx), "v"(w0b));
                                asm("v_pk_fma_f32 %0, %1, %2, %0 op_sel:[1,0,0]" : "+v"(a2[t * 4 + eg * 2]) : "v"(hx), "v"(w1a));
                                asm("v_pk_fma_f32 %0, %1, %2, %0 op_sel:[1,0,0]" : "+v"(a2[t * 4 + eg * 2 + 1]) : "v"(hx), "v"(w1b)); } }
                float v[32];
#pragma unroll
                for (int i = 0; i < 16; ++i) { v[2 * i] = a2[i][0]; v[2 * i + 1] = a2[i][1]; }
                bfly<16>(v, lane);
                const float lg = v[0] + __shfl_xor(v[0], 32) + (qd == 0 ? brq[0] : qd == 1 ? brq[1] : qd == 2 ? brq[2] : brq[3]);
#pragma unroll
                for (int z = 0; z < 4; ++z) Lq[z] = (z == qd) ? lg : Lq[z];
            }
            float tv[4]; int tix[4];
#pragma unroll
            for (int k = 0; k < 4; ++k) {
                float bv = Lq[0]; int bi = (lane & 7);
#pragma unroll
                for (int qd = 1; qd < 4; ++qd) { if (Lq[qd] > bv) { bv = Lq[qd]; bi = qd * 8 + (lane & 7); } }
#pragma unroll
                for (int o = 1; o < 8; o <<= 1) { const float ov = __shfl_xor(bv, o); const int oi = __shfl_xor(bi, o); if (ov > bv || (ov == bv && oi < bi)) { bv = ov; bi = oi; } }
                tv[k] = bv; tix[k] = bi;
                if ((bi & 7) == (lane & 7)) {
#pragma unroll
                    for (int qd = 0; qd < 4; ++qd) if ((bi >> 3) == qd) Lq[qd] = -3.0e38f; }
            }
            const float e1 = __expf(tv[1] - tv[0]), e2 = __expf(tv[2] - tv[0]), e3 = __expf(tv[3] - tv[0]); const float inv = 1.f / (1.f + e1 + e2 + e3);
            const int kk = lane & 7;
            if (lane < 32 && kk < 4) { const int tq = lane >> 3; const float wk = (kk == 0 ? 1.f : kk == 1 ? e1 : kk == 2 ? e2 : e3) * inv; const int ek = (kk == 0 ? tix[0] : kk == 1 ? tix[1] : kk == 2 ? tix[2] : tix[3]);
                asg_e[(rl0 + tq) * 4 + kk] = ek; asg_w[(rl0 + tq) * 4 + kk] = wk; }
        }
        __syncthreads();
        for (int i = F.tid(); i < 1024; i += 512) { const int e = asg_e[i]; rank[i] = (e >= 0) ? atomicAdd((int*)&lcnt[e], 1) : 0; }
        __syncthreads();
        if (F.tid() < 32) { gbase[F.tid()] = (int)atomicAdd(&gcnt[F.tid()], (unsigned)lcnt[F.tid()]); lcnt[F.tid()] = 0; }
        __syncthreads();
        for (int i = F.tid(); i < 1024; i += 512) { const int e = asg_e[i]; if (e < 0) continue; const int pos = gbase[e] + rank[i];
            const int rl = i >> 2, tokn = (gb0 + (rl >> 5) * F.G + F.blk) * 32 + (rl & 31);
            ltok[(size_t)e * NTOK + pos] = tokn * 4 + (i & 3); lw[(size_t)e * NTOK + pos] = asg_w[i]; }
        __syncthreads();
    }
}

__device__ __forceinline__ int moe_table(const Frame& F, LAS int* tstart, LAS int* cnt) {
    __syncthreads();
    if (F.tid() == 0) { const unsigned* gcnt = F.ctl() + CW_GCNT; int acc = 0; for (int e = 0; e < NEXP; ++e) { const int n = (int)gcnt[e]; cnt[e] = n; tstart[e] = acc; acc += (n + 255) >> 8; } tstart[NEXP] = acc; }
    __syncthreads();
    { const int NT_ = tstart[NEXP];
      for (int T = F.tid(); T < NT_; T += 512) { int e = 0; for (int j = 1; j < NEXP; ++j) e = (T >= tstart[j]) ? j : e; tstart[pg8::MOE_TEXP + T] = e; } }
    __syncthreads();
    return __builtin_amdgcn_readfirstlane(tstart[NEXP]);
}

__device__ __forceinline__ void phase_final(const Frame& F) {
    const float* modv = WSP(float, WS_MODV); const bf16_t* Y = WSP(bf16_t, WS_Y); const unsigned char* Ys = WSP(unsigned char, WS_YS);
    const int lane = F.lane();
    for (int row0 = (F.blk * 8 + F.wave) * 2; row0 < NTOK; row0 += F.G * 16) {
        const int b = row0 / SEQ;
        const unsigned lo16 = (unsigned)lane * 16u;
        f32x4 gtv[4];
#pragma unroll
        for (int j = 0; j < 4; ++j) gtv[j] = *(const f32x4*)(WSP(float, WS_COMB) + (size_t)b * 4096 + 3072 + 256 * j + 4 * lane);
        int yp[2][4][4];
#pragma unroll
        for (int t = 0; t < 2; ++t)
#pragma unroll
            for (int j = 0; j < 4; ++j)
#pragma unroll
                for (int k = 0; k < 4; ++k) yp[t][j][k] = __builtin_nontemporal_load((const int*)(Ys + ((size_t)(row0 + t) * 4 + k) * D + 256 * j + 4 * lane));
        u32x2 x1b[2][4];
#pragma unroll
        for (int t = 0; t < 2; ++t)
#pragma unroll
            for (int j = 0; j < 4; ++j) x1b[t][j] = ldg2_nt(Y + (size_t)(row0 + t) * D + 256 * j, lo16 >> 1);
#pragma unroll
        for (int j = 0; j < 4; ++j) asm volatile("" : "+v"(gtv[j]));
#pragma unroll
        for (int t = 0; t < 2; ++t)
#pragma unroll
            for (int j = 0; j < 4; ++j) {
#pragma unroll
                for (int k = 0; k < 4; ++k) asm volatile("" : "+v"(yp[t][j][k]));
                asm volatile("" : "+v"(x1b[t][j])); }
#pragma unroll
        for (int t = 0; t < 2; ++t) {
            f32x4 f[4]; float ss = 0.f;
#pragma unroll
            for (int j = 0; j < 4; ++j) { f[j] = (f32x4){0.f, 0.f, 0.f, 0.f};
#pragma unroll
                for (int k = 0; k < 4; ++k) { const f32x2 a = __builtin_amdgcn_cvt_pk_f32_fp8(yp[t][j][k], false), c = __builtin_amdgcn_cvt_pk_f32_fp8(yp[t][j][k], true); f[j] += (f32x4){a[0], a[1], c[0], c[1]}; }
                f[j] *= (1.f / FP8_SY);
                ss += f[j][0] * f[j][0] + f[j][1] * f[j][1] + f[j][2] * f[j][2] + f[j][3] * f[j][3]; }
            ss = wave_sum(ss); const float rs = rsqrtf(ss * (1.f / D) + EPS);
#pragma unroll
            for (int j = 0; j < 4; ++j) { const int k = 256 * j + 4 * lane; const f32x4 gt = gtv[j];
                const f32x4 x1v = (f32x4){bf_lo(x1b[t][j][0]), bf_hi(x1b[t][j][0]), bf_lo(x1b[t][j][1]), bf_hi(x1b[t][j][1])};
                __builtin_nontemporal_store(x1v + gt * (f[j] * rs), (f32x4*)(F.out() + (size_t)(row0 + t) * D + k)); }
        }
    }
}

__device__ __forceinline__ void phase_g2(const Frame& F) {
        { pg8::InSched16 S; S.init(WSP(bf16_t, WS_H), WSP(bf16_t, WS_BTIN), NTOK, NT_IN16 * 256, 2 * D, F.G, F.blk);
          EpiInProj<false> E{WSP(bf16_t, WS_PLAT), LDP, WSP(bf16_t, WS_VTL), SEQ, WSP(float, WS_GATES), (LAS bf16_t*)(F.lds + LDS_MISC),
                      (bf16_t*)((char*)F.out() + DO_MKT), (bf16_t*)((char*)F.out() + DO_MVT), WSP(float, WS_ROPE), true};
          pg8::gemm_phase(F.lds, 2 * D, S, E); }
        { pg8::InSched8 S; S.init(WSP(unsigned char, WS_H8), WSP(unsigned char, WS_BTIN8), NTOK, NT_IN8 * 256, D, F.G, F.blk);
          EpiInProj<true> E{WSP(bf16_t, WS_PLAT), LDP, WSP(bf16_t, WS_VTL), SEQ, WSP(float, WS_GATES), (LAS bf16_t*)(F.lds + LDS_MISC),
                      (bf16_t*)((char*)F.out() + DO_MKT), (bf16_t*)((char*)F.out() + DO_MVT), WSP(float, WS_ROPE), true};
          pg8::gemm_phase<EpiInProj<true>, pg8::InSched8, true>(F.lds, D, S, E); }
        { pg8::PlainSched S; S.init(WSP(bf16_t, WS_H) + (size_t)NTOK * D, WSP(bf16_t, WS_BTIN), NCTX, 2048, 2 * D, F.G, F.blk);
          EpiInProj<false> E{WSP(bf16_t, WS_PCTX), LDPC, WSP(bf16_t, WS_VTC), CTXL, WSP(float, WS_GATES) + (size_t)NTOK * 16, (LAS bf16_t*)(F.lds + LDS_MISC),
                      (bf16_t*)((char*)F.out() + DO_MKTC), (bf16_t*)((char*)F.out() + DO_MVTC), WSP(float, WS_ROPE), false};
          pg8::gemm_phase(F.lds, 2 * D, S, E); }
    }
__device__ __forceinline__ void phase_g5(const Frame& F) {
        bf16_t* merged = (bf16_t*)F.out(); bf16_t* T = merged + (size_t)NTOK * D;
        pg8::MixSched S; S.O = (const char*)WSP(bf16_t, WS_ONA); S.Wbr = (const char*)WSP(bf16_t, WS_BTBR); S.M = (const char*)merged; S.Wout = (const char*)WSP(bf16_t, WS_BTOUT);
        S.Kb = 2 * D; S.nM = NTOK / 256; S.G = F.G; S.c = F.blk;
        EpiMix E{WSP(bf16_t, WS_PLAT), T + (size_t)F.blk * 65536, merged, WSP(bf16_t, WS_Y)};
        pg8::gemm_phase(F.lds, 2 * D, S, E);
    }
__device__ __forceinline__ void phase_g8(const Frame& F) {
        LAS int* tstart = (LAS int*)(F.lds + LDS_MISC); LAS int* cnt = tstart + 64; LAS int* rowtok = tstart + 128;
        const int NT = moe_table(F, tstart, cnt);
        pg8::MoeSchedG S; S.tstart = tstart; S.cnt = cnt; S.Abase = (const char*)WSP(unsigned char, WS_H2); S.Abase_hi = nullptr;
        S.Bbase = (const char*)WSP(unsigned char, WS_WGL); S.bstride = (size_t)2048 * D; S.Kb = D;
        S.deal(NT, 8, F.G, F.blk); S.ltok = WSP(int, WS_LTOK); S.rowtok = rowtok;
        LAS float* biasl = (LAS float*)(F.lds + LDS_MISC + 4096); S.bgate = F.b_gate(); S.blin = F.b_lin(); S.biasl = biasl;
        EpiSwiglu E{(unsigned char*)F.out(), WSP(unsigned char, WS_AHI), biasl};
        pg8::gemm_phase<EpiSwiglu, pg8::MoeSchedG, true>(F.lds, D, S, E);
    }
__device__ __forceinline__ void phase_g9(const Frame& F) {
        LAS int* tstart = (LAS int*)(F.lds + LDS_MISC); LAS int* cnt = tstart + 64;
        const int NT = moe_table(F, tstart, cnt);
        pg8::MoeSchedD S; S.tstart = tstart; S.cnt = cnt; S.Abase = (const char*)F.out(); S.Abase_hi = (const char*)WSP(unsigned char, WS_AHI);
        S.Bbase = (const char*)F.out() + DO_WD; S.bstride = (size_t)D * D; S.Kb = D;
        S.deal(NT, 4, F.G, F.blk);
        LAS unsigned* edl = (LAS unsigned*)(F.lds + LDS_MISC + 4096); S.ltok = WSP(int, WS_LTOK); S.lw = WSP(float, WS_LW); S.bdown = F.b_down(); S.edl = edl;
        EpiDown E{WSP(unsigned char, WS_YS), edl, cnt};
        pg8::gemm_phase<EpiDown, pg8::MoeSchedD, true>(F.lds, D, S, E);
    }
__global__ void __launch_bounds__(512, 2) fwd(Args args) {
    extern __shared__ __attribute__((aligned(16))) unsigned char lds_raw[];
    Frame F;
    F.lds = (LAS unsigned char*)lds_raw; F.wave = __builtin_amdgcn_readfirstlane(F.tid() >> 6); F.G = gridDim.x; F.blk = blockIdx.x; F.out_ = args.out; F.ws_ = args.ws;
    const int lo = args.ph_lo, hi = args.ph_hi;
    if (F.tid() < 4) ((LAS unsigned*)(F.lds + LDS_BARW))[F.tid()] = 0u;
    __syncthreads();
    XcdBarrier bar; bar.bar = F.ctl(); bar.x = 0; bar.st = nullptr;
    if (hi - lo > 1) bar = xcd_barrier_post(F.ctl(), (volatile LAS unsigned*)(F.lds + LDS_BARW));
#ifndef PH_MASK
#define PH_MASK 0x7ff
#endif
#define IN(k) (((PH_MASK >> (k)) & 1) && lo <= (k) && (k) < hi)
#define SEAM(k) do { if (IN(k) && IN((k) + 1)) xcd_barrier(bar); } while (0)
#ifndef REPEAT_MASK
#define REPEAT_MASK 0
#endif

#define REP(k) (((REPEAT_MASK) >> (k)) & 1)
    if (IN(0)) { phase_ada(F); if (IN(1)) { const XbTok tk = xcd_arrive(bar); phase_cvt_small(F); xcd_wait(bar, tk); } else phase_cvt_small(F); }
    if (IN(1)) { phase_norm1(F); if constexpr (REP(1)) { xcd_barrier(bar); phase_norm1(F); } }
    SEAM(1);
    if (IN(2)) { phase_g2(F); if constexpr (REP(2)) { xcd_barrier(bar); phase_g2(F); } }
    SEAM(2);
    if (IN(3)) {
        if (((F.blk >> 6) & 1) == 0) phase_cvt_experts(F, 0, NEXP * 256);
        phase_mlstm_states(F);
        XbTok tk3; tk3.role = 0u; tk3.gen = 0u; tk3.tg = 0u;
        if (IN(4)) tk3 = xcd_arrive(bar);
        phase_attn(F);
        if (((F.blk >> 6) & 1) != 0) phase_cvt_experts(F, 0, NEXP * 256);
        if (IN(4)) xcd_wait(bar, tk3);
    }
    if (IN(4)) { phase_mlstm_out(F); if constexpr (REP(4)) { xcd_barrier(bar); phase_mlstm_out(F); } }
    SEAM(4);
    if (IN(5)) { phase_g5(F); if constexpr (REP(5)) { xcd_barrier(bar); phase_g5(F); } }
    if (IN(5) && IN(7)) { const XbTok tk = xcd_arrive(bar); phase_cvt_experts(F, NEXP * 256, NEXP * 384); xcd_wait(bar, tk); phase_postmix(F); }
    else if (IN(7)) { phase_cvt_experts(F, NEXP * 256, NEXP * 384); phase_postmix(F); }
    SEAM(7);
    if (IN(8)) { phase_g8(F); if constexpr (REP(8)) { xcd_barrier(bar); phase_g8(F); } }
    SEAM(8);
    if (IN(9)) { phase_g9(F); if constexpr (REP(9)) { xcd_barrier(bar); phase_g9(F); } }
    SEAM(9);
    if (IN(10)) { phase_final(F); if constexpr (REP(10)) { xcd_barrier(bar); phase_final(F); } }
#undef IN
#undef SEAM
}

extern "C" void kernel_launch(void* const* d_in, const int* in_sizes, int n_in, void* d_out, int out_size, void* d_ws, size_t ws_size, hipStream_t stream) {
    static int grid = 0;
    if (grid == 0) {
        if (n_in != 25 || out_size != NTOK * D || ws_size < WS_END) { fprintf(stderr, "kernel_launch: unexpected shapes (n_in %d out %d ws %zu)\n", n_in, out_size, ws_size); grid = -1; return; }
        int dev = 0, cus = 0, per_cu = 0;
        if (hipGetDevice(&dev) != hipSuccess || hipDeviceGetAttribute(&cus, hipDeviceAttributeMultiprocessorCount, dev) != hipSuccess) { grid = -1; return; }
        if (hipFuncSetAttribute((const void*)fwd, hipFuncAttributeMaxDynamicSharedMemorySize, LDS_BYTES) != hipSuccess) { fprintf(stderr, "kernel_launch: hipFuncSetAttribute failed\n"); grid = -1; return; }
        if (hipOccupancyMaxActiveBlocksPerMultiprocessor(&per_cu, (const void*)fwd, 512, LDS_BYTES) != hipSuccess || per_cu < 1) fprintf(stderr, "kernel_launch: occupancy query says %d\n", per_cu);
        (void)hipGetLastError();
        grid = cus;
    }
    if (grid < 0) return;
    (void)hipMemsetAsync((char*)d_ws + WS_CTL, 0, CTL_ZERO_BYTES, stream);
    Args a{};
    for (int i = 0; i < 25; ++i) a.in[i] = (const float*)d_in[i];
    a.out = (float*)d_out; a.ws = (unsigned char*)d_ws;
#if MK_ONE_LAUNCH
    a.ph_lo = 0; a.ph_hi = NPHASE;
    hipLaunchKernelGGL(fwd, dim3(grid), dim3(512), LDS_BYTES, stream, a);
#else
    for (int p = 0; p < NPHASE; ++p) { a.ph_lo = p; a.ph_hi = p + 1; hipLaunchKernelGGL(fwd, dim3(grid), dim3(512), LDS_BYTES, stream, a); }
#endif
}
```
